# Optimizing an MI355X kernel written in HIP

```python
import math
import jax, jax.numpy as jnp
from jax import lax
import numpy as np

D_MODEL = 2048
BATCH = 1
SEQ = 8192
DEPTH = 2

GRID_W = 64
CTX_LEN = 256
EPS = 1e-6

A_HEADS = 8
A_HEAD_DIM = 64
A_V_DIM = 2 * A_HEAD_DIM
A_WIDTH = A_HEADS * A_V_DIM
QK_COLS = A_HEADS * 2 * A_HEAD_DIM
Q_BLOCK = 128
ROPE_THETA = 10000.0

B_GROUPS = 8
B_GROUP_W = 128
B_WIDTH = B_GROUPS * B_GROUP_W
CHUNK = 128

IN_COLS = 2 * QK_COLS + A_WIDTH + 2 * B_WIDTH
MIX_WIDTH = A_WIDTH + B_WIDTH

C_GROUPS = 4
C_GROUP_W = D_MODEL // C_GROUPS

N_EXPERTS = 16
CAPACITY_FACTOR = 2
F_EXPERT = D_MODEL // 2

N_EVEN = (DEPTH + 1) // 2
N_ODD = DEPTH // 2

kernel_name = "hybrid_diffattn_gmlp_fnet_ecmoe_dit"


def rms_norm(x, g):
    xf = x.astype(jnp.float32)
    y = xf * lax.rsqrt(jnp.mean(xf * xf, -1, keepdims=True) + EPS)
    return (y * g.astype(jnp.float32)).astype(x.dtype)


def layer_norm(x, g, b):
    xf = x.astype(jnp.float32)
    mu = jnp.mean(xf, -1, keepdims=True)
    var = jnp.mean(jnp.square(xf - mu), -1, keepdims=True)
    y = (xf - mu) * lax.rsqrt(var + EPS) * g.astype(jnp.float32) + b.astype(jnp.float32)
    return y.astype(x.dtype)


def modulate(h, shift, scale):
    return h * (1.0 + scale) + shift


def _rope_1d(x, pos):
    dim = x.shape[-1]
    inv = ROPE_THETA ** (-jnp.arange(0, dim, 2, dtype=jnp.float32) / dim)
    ang = pos.astype(jnp.float32)[:, None] * inv[None, :]
    cos = jnp.cos(ang)[None, :, None, None, :]
    sin = jnp.sin(ang)[None, :, None, None, :]
    x1, x2 = x[..., : dim // 2], x[..., dim // 2:]
    return jnp.concatenate([x1 * cos - x2 * sin, x2 * cos + x1 * sin], -1)


def axial_rope(x, row, col):
    half = A_HEAD_DIM // 2
    xf = x.astype(jnp.float32)
    out = jnp.concatenate([_rope_1d(xf[..., :half], row), _rope_1d(xf[..., half:], col)], -1)
    return out.astype(x.dtype)


def diff_attend(q, k, v, lam):
    s = jnp.einsum('bqhcd,bkhcd->bhcqk', q.astype(jnp.float32), k.astype(jnp.float32)) * (A_HEAD_DIM ** -0.5)
    p = jax.nn.softmax(s, axis=-1)
    a = p[:, :, 0] - lam * p[:, :, 1]
    return jnp.einsum('bhqk,bkhe->bqhe', a, v.astype(jnp.float32))


def split_projection(h, w_in):
    B_, n, _ = h.shape
    z = h @ w_in
    q = z[..., :QK_COLS].reshape(B_, n, A_HEADS, 2, A_HEAD_DIM)
    k = z[..., QK_COLS:2 * QK_COLS].reshape(B_, n, A_HEADS, 2, A_HEAD_DIM)
    v = z[..., 2 * QK_COLS:2 * QK_COLS + A_WIDTH].reshape(B_, n, A_HEADS, A_V_DIM)
    uv = jax.nn.gelu(z[..., 2 * QK_COLS + A_WIDTH:])
    return q, k, v, uv


def spatial_gate(uv, ln_g, ln_b, w_s, b_s):
    B_, n, _ = uv.shape
    u, v = uv[..., :B_WIDTH], uv[..., B_WIDTH:]
    v = v.reshape(B_, n // CHUNK, CHUNK, B_GROUPS, B_GROUP_W)
    v = layer_norm(v, ln_g.reshape(B_GROUPS, B_GROUP_W), ln_b.reshape(B_GROUPS, B_GROUP_W))
    mixed = jnp.einsum('gpq,bcqgd->bcpgd', w_s, v) + b_s.T[:, :, None]
    return u * mixed.reshape(B_, n, B_WIDTH)


def even_mixer(h_lat, h_ctx, row, col, w_in, w_out, lq1, lk1, lq2, lk2, g_subln,
               ln_g, ln_b, w_s, b_s, lam_init, need_ctx_out):
    f32 = jnp.float32
    lam = (jnp.exp(jnp.sum(lq1.astype(f32) * lk1.astype(f32)))
           - jnp.exp(jnp.sum(lq2.astype(f32) * lk2.astype(f32))) + lam_init)
    q_l, k_l, v_l, uv_l = split_projection(h_lat, w_in)
    q_c, k_c, v_c, uv_c = split_projection(h_ctx, w_in)
    q_l = axial_rope(q_l, row, col)
    k_l = axial_rope(k_l, row, col)
    k_all = jnp.concatenate([k_c, k_l], axis=1)
    v_all = jnp.concatenate([v_c, v_l], axis=1)
    B_, n = h_lat.shape[0], h_lat.shape[1]
    nb = n // Q_BLOCK
    qb = jnp.moveaxis(q_l.reshape(B_, nb, Q_BLOCK, A_HEADS, 2, A_HEAD_DIM), 1, 0)
    o = lax.map(lambda qi: diff_attend(qi, k_all, v_all, lam), qb)
    o = jnp.moveaxis(o, 0, 1).reshape(B_, n, A_HEADS, A_V_DIM)

    def finish(o_attn, uv):
        a = rms_norm(o_attn, g_subln) * (1.0 - lam_init)
        a = a.reshape(a.shape[0], a.shape[1], A_WIDTH).astype(uv.dtype)
        g = spatial_gate(uv, ln_g, ln_b, w_s, b_s)
        return jnp.concatenate([a, g], axis=-1) @ w_out

    y_lat = finish(o, uv_l)
    y_ctx = finish(diff_attend(q_c, k_c, v_c, lam), uv_c) if need_ctx_out else None
    return y_lat, y_ctx


def fourier_mix(h, w_o):
    B_, n, _ = h.shape
    hg = h.astype(jnp.float32).reshape(B_, n, C_GROUPS, C_GROUP_W)
    f = jnp.fft.fft2(hg, axes=(1, 3), norm="ortho").real
    return f.reshape(B_, n, D_MODEL).astype(h.dtype) @ w_o


def expert_choice_ffn(h, w_r, w_gate, w_up, w_down):
    B_, n, D = h.shape
    cap = CAPACITY_FACTOR * n // N_EXPERTS
    aff = jax.nn.softmax((h @ w_r).astype(jnp.float32), axis=-1)
    g, idx = lax.top_k(jnp.swapaxes(aff, 1, 2), cap)
    xs = jax.vmap(lambda hb, ib: hb[ib])(h, idx)
    a = jnp.einsum('becd,edf->becf', xs, w_gate)
    u = jnp.einsum('becd,edf->becf', xs, w_up)
    y = jnp.einsum('becf,efd->becd', jax.nn.silu(a) * u, w_down) * g[..., None].astype(h.dtype)
    return jax.vmap(lambda yb, ib: jnp.zeros((n, D), yb.dtype).at[ib.reshape(-1)].add(yb.reshape(-1, D)))(y, idx)


def setup_inputs(seed: int = 0) -> dict:
    key = jax.random.key(seed)
    ks = jax.random.split(key, 32)
    nrm = jax.random.normal
    D = D_MODEL
    return {
        "x": nrm(ks[0], (BATCH, SEQ, D), jnp.float32),
        "c": nrm(ks[1], (BATCH, D), jnp.float32),
        "ctx": nrm(ks[2], (BATCH, CTX_LEN, D), jnp.float32),
        "c_ctx": nrm(ks[3], (D,), jnp.float32),
        "w_mod": nrm(ks[4], (DEPTH, D, 6 * D), jnp.float32) * (0.5 * D ** -0.5),
        "b_mod": nrm(ks[5], (DEPTH, 6 * D), jnp.float32) * 0.02,
        "g_norm_mix": 1.0 + 0.02 * nrm(ks[6], (DEPTH, D), jnp.float32),
        "g_norm_ffn": 1.0 + 0.02 * nrm(ks[7], (DEPTH, D), jnp.float32),
        "w_in": nrm(ks[8], (N_EVEN, D, IN_COLS), jnp.float32) * D ** -0.5,
        "w_out": nrm(ks[9], (N_EVEN, MIX_WIDTH, D), jnp.float32) * MIX_WIDTH ** -0.5,
        "lam_q1": nrm(ks[10], (N_EVEN, A_HEAD_DIM), jnp.float32) * 0.1,
        "lam_k1": nrm(ks[11], (N_EVEN, A_HEAD_DIM), jnp.float32) * 0.1,
        "lam_q2": nrm(ks[12], (N_EVEN, A_HEAD_DIM), jnp.float32) * 0.1,
        "lam_k2": nrm(ks[13], (N_EVEN, A_HEAD_DIM), jnp.float32) * 0.1,
        "g_subln": 1.0 + 0.02 * nrm(ks[14], (N_EVEN, A_V_DIM), jnp.float32),
        "sgu_ln_g": 1.0 + 0.02 * nrm(ks[15], (N_EVEN, B_WIDTH), jnp.float32),
        "sgu_ln_b": 0.02 * nrm(ks[16], (N_EVEN, B_WIDTH), jnp.float32),
        "w_spatial": nrm(ks[17], (N_EVEN, B_GROUPS, CHUNK, CHUNK), jnp.float32) * CHUNK ** -0.5,
        "b_spatial": 1.0 + 0.02 * nrm(ks[18], (N_EVEN, B_GROUPS, CHUNK), jnp.float32),
        "w_fourier_out": nrm(ks[19], (N_ODD, D, D), jnp.float32) * D ** -0.5,
        "w_router": nrm(ks[20], (DEPTH, D, N_EXPERTS), jnp.float32) * D ** -0.5,
        "w_gate": nrm(ks[21], (DEPTH, N_EXPERTS, D, F_EXPERT), jnp.float32) * D ** -0.5,
        "w_up": nrm(ks[22], (DEPTH, N_EXPERTS, D, F_EXPERT), jnp.float32) * D ** -0.5,
        "w_down": nrm(ks[23], (DEPTH, N_EXPERTS, F_EXPERT, D), jnp.float32) * F_EXPERT ** -0.5,
        "g_final": 1.0 + 0.02 * nrm(ks[24], (D,), jnp.float32),
    }


def reference(x, c, ctx, c_ctx, w_mod, b_mod, g_norm_mix, g_norm_ffn, w_in, w_out,
              lam_q1, lam_k1, lam_q2, lam_k2, g_subln, sgu_ln_g, sgu_ln_b, w_spatial,
              b_spatial, w_fourier_out, w_router, w_gate, w_up, w_down, g_final):
    n = x.shape[1]
    rows = n // GRID_W
    row = jnp.repeat(jnp.arange(rows, dtype=jnp.int32), GRID_W)
    col = jnp.tile(jnp.arange(GRID_W, dtype=jnp.int32), rows)

    for i in range(DEPTH):
        last = i == DEPTH - 1
        j = i // 2
        m_lat = (jax.nn.silu(c) @ w_mod[i] + b_mod[i])[:, None, :]
        m_ctx = (jax.nn.silu(c_ctx) @ w_mod[i] + b_mod[i])[None, None, :]
        sm, cm, gm, sf, cf, gf = jnp.split(m_lat, 6, axis=-1)
        smc, cmc, gmc, sfc, cfc, gfc = jnp.split(m_ctx, 6, axis=-1)

        h_lat = modulate(rms_norm(x, g_norm_mix[i]), sm, cm)
        if i % 2 == 0:
            lam_init = 0.8 - 0.6 * math.exp(-0.3 * i)
            h_ctx = modulate(rms_norm(ctx, g_norm_mix[i]), smc, cmc)
            y_lat, y_ctx = even_mixer(h_lat, h_ctx, row, col, w_in[j], w_out[j],
                                      lam_q1[j], lam_k1[j], lam_q2[j], lam_k2[j], g_subln[j],
                                      sgu_ln_g[j], sgu_ln_b[j], w_spatial[j], b_spatial[j],
                                      lam_init, not last)
        else:
            y_lat = fourier_mix(h_lat, w_fourier_out[j])
            y_ctx = None if last else fourier_mix(modulate(rms_norm(ctx, g_norm_mix[i]), smc, cmc), w_fourier_out[j])

        x = x + gm * y_lat
        x = x + gf * expert_choice_ffn(modulate(rms_norm(x, g_norm_ffn[i]), sf, cf),
                                       w_router[i], w_gate[i], w_up[i], w_down[i])
        if not last:
            ctx = ctx + gmc * y_ctx
            ctx = ctx + gfc * expert_choice_ffn(modulate(rms_norm(ctx, g_norm_ffn[i]), sfc, cfc),
                                                w_router[i], w_gate[i], w_up[i], w_down[i])

    return rms_norm(x, g_final)
```

```cpp
#include <hip/hip_runtime.h>
#include <hip/hip_bf16.h>
#include <cstdio>
#include <cstdint>
#define ONE_LAUNCH 1

#define GAS __attribute__((address_space(1)))
#define LAS __attribute__((address_space(3)))
typedef unsigned short bf16_t;
typedef short bf16x8 __attribute__((ext_vector_type(8)));
typedef short s16x4 __attribute__((ext_vector_type(4)));
typedef float f32x2 __attribute__((ext_vector_type(2)));
typedef float f32x4 __attribute__((ext_vector_type(4)));
typedef float f32x16 __attribute__((ext_vector_type(16)));
typedef unsigned u32x2 __attribute__((ext_vector_type(2)));
typedef _Float16 f16x4 __attribute__((ext_vector_type(4)));
typedef unsigned u32x4 __attribute__((ext_vector_type(4)));
typedef _Float16 f16x8 __attribute__((ext_vector_type(8)));

constexpr int DM = 2048, SEQ = 8192, CTXL = 256, MC = SEQ + CTXL, INC = 5120, NE = 16, CAP = 1024, FE = 1024, MR = NE * CAP;
constexpr float EPS = 1e-6f;
constexpr int NWAVES = 8, NTHR = 512;
constexpr int NPH = 20;

constexpr size_t al256(size_t x) { return (x + 255) / 256 * 256; }
constexpr size_t WS_CTL = 0, CTL_BYTES = 65536;
constexpr size_t WS_MODL = WS_CTL + CTL_BYTES;
constexpr size_t WS_MODC = WS_MODL + 2 * 12288 * 4;
constexpr size_t WS_ROPE = WS_MODC + 4096 * 4;
constexpr size_t WS_CS = WS_ROPE + 2 * 128 * 16 * 4;
constexpr size_t WS_WIN = WS_CS + 1024 * 512 * 2;
constexpr size_t WS_WOUT = WS_WIN + (size_t)INC * DM * 2;
constexpr size_t WS_WFO = WS_WOUT + (size_t)DM * DM * 2;
constexpr size_t WGU_BYTES = (size_t)NE * 2048 * DM * 2, WD_BYTES = (size_t)NE * DM * FE * 2;
constexpr size_t WS_WGU = WS_WFO + (size_t)DM * DM * 2;
constexpr size_t WS_WD = WS_WGU + 2 * WGU_BYTES;
constexpr size_t WS_HCAT = WS_WD + 2 * WD_BYTES;
constexpr size_t WS_Q = WS_HCAT + (size_t)MC * DM * 2;
constexpr size_t WS_K = WS_Q + (size_t)MC * 1024 * 2;
constexpr size_t WS_V = WS_K + (size_t)MC * 1024 * 2;
constexpr size_t WS_UV = WS_V + (size_t)MC * 1024 * 2;
constexpr size_t WS_CAT = WS_UV + (size_t)MC * DM * 2;
constexpr size_t WS_X = WS_CAT + (size_t)SEQ * DM * 2;
constexpr size_t WS_H2 = WS_X + (size_t)SEQ * DM * 4;
constexpr size_t WS_AFF = WS_H2 + (size_t)SEQ * DM * 2;
constexpr size_t WS_IDX = WS_AFF + (size_t)NE * SEQ * 4;
constexpr size_t WS_GATE = WS_IDX + (size_t)MR * 4;
constexpr size_t WS_POS = WS_GATE + (size_t)MR * 4;
constexpr size_t WS_XS = WS_POS + (size_t)NE * SEQ * 4;
constexpr size_t WS_WRP = WS_XS;
constexpr size_t WS_WRB = WS_WRP + 2 * 2 * 4096 * 16;
constexpr size_t WS_ACT = WS_XS + (size_t)MR * DM * 2;
constexpr size_t WS_Y = WS_ACT + (size_t)MR * FE * 2;
constexpr size_t WS_WCT = WS_Y + (size_t)MR * DM * 2;
constexpr size_t WS_F = WS_WCT + (size_t)4096 * 8192 * 2;
constexpr size_t WS_A1 = WS_F + (size_t)SEQ * DM * 2;
constexpr size_t WS_A2 = WS_A1 + 128 * 128 * 2;
constexpr size_t WS_TW = WS_A2 + 128 * 256 * 2;
constexpr size_t WS_END = WS_TW + 64 * 128 * 2 * 4;

constexpr int LDS_BYTES = 147456, LDSCTL_OFF = 146944;

__device__ __forceinline__ unsigned f2bf(float f) { unsigned u = __builtin_bit_cast(unsigned, f); return (u + 0x7fffu + ((u >> 16) & 1u)) >> 16; }
__device__ __forceinline__ unsigned pk2(float lo, float hi) { unsigned r; asm("v_cvt_pk_bf16_f32 %0, %1, %2" : "=v"(r) : "v"(lo), "v"(hi)); return r; }
__device__ __forceinline__ float bflo(unsigned w) { return __builtin_bit_cast(float, w << 16); }
__device__ __forceinline__ float bfhi(unsigned w) { return __builtin_bit_cast(float, w & 0xffff0000u); }
__device__ __forceinline__ unsigned cvt_pk_bf16(float lo, float hi) { unsigned r; asm volatile("v_cvt_pk_bf16_f32 %0, %1, %2" : "=v"(r) : "v"(lo), "v"(hi)); return r; }
__device__ __forceinline__ float dpp_f(float v, int ctrl_sel) {
    const int x = __builtin_bit_cast(int, v);
    int r;
    switch (ctrl_sel) {
        case 0: r = __builtin_amdgcn_update_dpp(0, x, 0xB1, 0xF, 0xF, true); break;
        case 1: r = __builtin_amdgcn_update_dpp(0, x, 0x4E, 0xF, 0xF, true); break;
        case 2: r = __builtin_amdgcn_update_dpp(0, x, 0x141, 0xF, 0xF, true); break;
        default: r = __builtin_amdgcn_update_dpp(0, x, 0x140, 0xF, 0xF, true); break;
    }
    return __builtin_bit_cast(float, r);
}
__device__ __forceinline__ float wave_sum(float v) {
    v += dpp_f(v, 0); v += dpp_f(v, 1); v += dpp_f(v, 2); v += dpp_f(v, 3);
    { auto rr = __builtin_amdgcn_permlane16_swap(__float_as_uint(v), __float_as_uint(v), false, false); v = __uint_as_float(rr[0]) + __uint_as_float(rr[1]); }
    { auto rr = __builtin_amdgcn_permlane32_swap(__float_as_uint(v), __float_as_uint(v), false, false); v = __uint_as_float(rr[0]) + __uint_as_float(rr[1]); }
    return v;
}
__device__ __forceinline__ f32x4 ldx4(const _Float16* p) { return __builtin_convertvector(*(const f16x4*)p, f32x4); }
__device__ __forceinline__ void stx4(_Float16* p, f32x4 v) { *(f16x4*)p = __builtin_convertvector(v, f16x4); }
__device__ __forceinline__ float wave_max(float v) {
#pragma unroll
    for (int o = 1; o < 64; o <<= 1) v = fmaxf(v, __shfl_xor(v, o));
    return v;
}

#define XB_TMO      128
#define XB_XCNT(j)  (256  + 64 * (j))
#define XB_XSUB(j)  (1280 + 64 * (j))
#define XB_XGEN(j)  (2304 + 64 * (j))
#define XB_TOP      3328
#define XB_TOPGEN   3392
#define XCD_BAR_WORDS 3456
#define XB_SPIN_CAP (1u << 18)
__device__ __forceinline__ unsigned xb_ld(unsigned* p)              { return __hip_atomic_load(p, __ATOMIC_RELAXED, __HIP_MEMORY_SCOPE_AGENT); }
__device__ __forceinline__ unsigned xb_add(unsigned* p, unsigned v) { return __hip_atomic_fetch_add(p, v, __ATOMIC_RELAXED, __HIP_MEMORY_SCOPE_AGENT); }
__device__ __forceinline__ unsigned xb_xcc_id() { return (unsigned)__builtin_amdgcn_s_getreg((3 << 11) | 20) & 0xFu; }
#define XB_SPIN(cond, bar) do { unsigned _sp = 0; while (cond) { __builtin_amdgcn_s_sleep(1); \
    if ((++_sp & 255u) == 0u) { if (xb_ld(&(bar)[XB_TMO])) break; if (_sp > XB_SPIN_CAP) { atomicAdd(&(bar)[XB_TMO], 1u); break; } } } } while (0)
struct XcdBarrier { unsigned* bar; unsigned x; volatile LAS unsigned* st; };
__device__ __forceinline__ XcdBarrier xcd_barrier_post(unsigned* bar, volatile LAS unsigned* st) {
    XcdBarrier b; b.bar = bar; b.x = xb_xcc_id(); b.st = st;
    if (threadIdx.x == 0) (void)xb_add(&bar[XB_XCNT(b.x)], 1u);
    return b;
}
__device__ __forceinline__ void xcd_barrier_complete(unsigned* bar, unsigned x, unsigned& nloc, unsigned& nx) {
    const unsigned G = gridDim.x * gridDim.y * gridDim.z;
    unsigned sum, cnt, mine, sp = 0u;
    for (;;) {
        sum = 0u; cnt = 0u; mine = 0u;
#pragma unroll
        for (unsigned j = 0; j < 16; ++j) { const unsigned c = xb_ld(&bar[XB_XCNT(j)]); sum += c; cnt += (c > 0u) ? 1u : 0u; mine = (j == x) ? c : mine; }
        if (sum == G) break;
        __builtin_amdgcn_s_sleep(1);
        if ((++sp & 255u) == 0u) { if (xb_ld(&bar[XB_TMO])) break; if (sp > XB_SPIN_CAP) { atomicAdd(&bar[XB_TMO], 1u); break; } }
    }
    nloc = mine > 0u ? mine : 1u; nx = cnt > 0u ? cnt : 1u;
}
__device__ __forceinline__ void xcd_barrier(const XcdBarrier& b) {
    asm volatile("s_waitcnt vmcnt(0)" ::: "memory");
    __syncthreads();
    if (threadIdx.x == 0) {
        unsigned* bar = b.bar;
        __builtin_amdgcn_s_waitcnt(0);
        unsigned nloc = b.st[0], nx = b.st[1];
        if (nloc == 0u) { xcd_barrier_complete(bar, b.x, nloc, nx); b.st[0] = nloc; b.st[1] = nx; }
        const unsigned old = xb_add(&bar[XB_XSUB(b.x)], 1u);
        const unsigned gen = old / nloc;
        if (old + 1u == (gen + 1u) * nloc) {
            __builtin_amdgcn_fence(__ATOMIC_RELEASE, "agent");
            asm volatile("s_waitcnt vmcnt(0)" ::: "memory");
            const unsigned og = xb_add(&bar[XB_TOP], 1u);
            const unsigned tg = og / nx;
            if (og + 1u == (tg + 1u) * nx) xb_add(&bar[XB_TOPGEN], 1u);
            else XB_SPIN(xb_ld(&bar[XB_TOPGEN]) == tg, bar);
            __builtin_amdgcn_fence(__ATOMIC_ACQUIRE, "agent");
            xb_add(&bar[XB_XGEN(b.x)], 1u);
            asm volatile("s_waitcnt vmcnt(0)" ::: "memory");
        } else {
            XB_SPIN(xb_ld(&bar[XB_XGEN(b.x)]) == gen, bar);
            __builtin_amdgcn_fence(__ATOMIC_ACQUIRE, "agent");
            asm volatile("s_waitcnt vmcnt(0)" ::: "memory");
        }
    }
    __syncthreads();
}

namespace pg8 {
constexpr int BM = 256, BK = 64, HALF = 128, HTB = HALF * BK * 2, STAGE_BYTES = 8 * HTB, NXCD = 8, WGM = 8;
__host__ __device__ __forceinline__ int lds_byte(int r, int c) { const int st = (r >> 4) * 2 + (c >> 5), rr = r & 15, cc = c & 31, ob = rr * 64 + cc * 2; return st * 1024 + (ob ^ (((ob >> 9) & 1) << 5)); }
__host__ __device__ __forceinline__ void stage_rc(int b, int& R, int& C) { const int st = b / 1024, sb = b % 1024, swz = sb ^ (((sb >> 9) & 1) << 5); R = (st >> 1) * 16 + swz / 64; C = (st & 1) * 32 + (swz % 64) / 2; }
__host__ __device__ __forceinline__ int perm32(int rho) { const int n = rho >> 4, i = rho & 15; return 8 * (i >> 2) + 4 * n + (i & 3); }

struct Unit { int pm, pn, aux; };
struct Geo {
    const char* A; const char* B;
    unsigned lda2, ldb2, kA, kB;
    size_t hA, hB, tA, tB, aA, aB;
    int nt, amode, bmode;
    __device__ __forceinline__ size_t offA(const Unit& u) const { return (size_t)u.pm * tA + (size_t)u.aux * aA; }
    __device__ __forceinline__ size_t offB(const Unit& u) const { return (size_t)u.pn * tB + (size_t)u.aux * aB; }
};
__device__ __forceinline__ Geo geo_rowmajor(const void* A, int lda, const void* B, int ldb, int K) {
    Geo g; g.A = (const char*)A; g.B = (const char*)B; g.lda2 = lda * 2; g.ldb2 = ldb * 2; g.kA = 128; g.kB = 128;
    g.hA = (size_t)128 * lda * 2; g.hB = (size_t)128 * ldb * 2; g.tA = 2 * g.hA; g.tB = 2 * g.hB; g.aA = 0; g.aB = 0; g.nt = K / 64; g.amode = 0; g.bmode = 0; return g;
}

struct StaticOrder {
    int nM, nN, nwg, G, c;
    __device__ void init(int M, int N, int G_, int c_) { nM = M / BM; nN = N / BM; nwg = nM * nN; G = G_; c = c_; }
    __device__ bool next(int i, Unit& u) const {
        const long L = (long)i * G + c; if (L >= nwg) return false;
        int wgid = (int)L; { const int q = nwg / NXCD, r = nwg % NXCD, xcd = wgid % NXCD, off = wgid / NXCD; wgid = (xcd < r ? xcd * (q + 1) : r * (q + 1) + (xcd - r) * q) + off; }
        const int nig = WGM * nN, gid = wgid / nig, fm = gid * WGM, gsz = (nM - fm) < WGM ? (nM - fm) : WGM;
        u.pm = fm + ((wgid % nig) % gsz); u.pn = (wgid % nig) / gsz; u.aux = 0; return true;
    }
    __device__ __forceinline__ void a_ready(const Unit&) const {}
    __device__ __forceinline__ void done(const Unit&) const {}
};
struct WinOrder : StaticOrder {
    __device__ void init_win(int G_, int c_) { init(SEQ, INC, G_, c_); }
    __device__ int total() const { return nwg + 8; }
    __device__ bool next(int i, Unit& u) const {
        const long L = (long)i * G + c;
        if (L < nwg) { StaticOrder::next(i, u); u.pm += 1; return true; }
        if (L < nwg + 8) { u.pm = 0; u.pn = 4 + (int)(L - nwg); u.aux = 0; return true; }
        return false; }
};
struct MoeOrder : StaticOrder {
    __device__ bool next(int i, Unit& u) const { if (!StaticOrder::next(i, u)) return false; u.aux = u.pm >> 2; return true; }
};
struct StepAOrder {
    int G, c;
    __device__ bool next(int i, Unit& u) const { const int L = i * G + c; if (L >= 256) return false; u.aux = L >> 6; const int r = L & 63; u.pm = r & 1; u.pn = r >> 1; return true; }
    __device__ __forceinline__ void a_ready(const Unit&) const {}
    __device__ __forceinline__ void done(const Unit&) const {}
};

template <class Epi, class Sched, bool ALIGN_EPI, bool SP2, bool GATHER = false>
__device__ __forceinline__ void gemm_phase(LAS unsigned char* lds, const Geo g, const Sched& S, const Epi& E, const int* gidx = nullptr) {
    const int tid = threadIdx.x, wid = __builtin_amdgcn_readfirstlane(tid >> 6), lane = tid & 63, wr = wid >> 2, wc = wid & 3, fr = lane & 15, fq = lane >> 4;
    const int nt = g.nt;
    unsigned voffA[2], voffB[2], voffA1[2], nvA0[2], nvA1[2]; int gR[2]; unsigned gC[2];
#pragma unroll
    for (int i = 0; i < 2; ++i) { int R, C; stage_rc(tid * 16 + i * 8192, R, C); const int Rb = Epi::PERM ? ((R & ~31) + perm32(R & 31)) : R; gR[i] = R; gC[i] = (unsigned)C * 2u;
        voffA[i] = g.amode ? (unsigned)(C >> 3) * 131072u + (unsigned)R * 16u : (unsigned)R * g.lda2 + (unsigned)C * 2u;
        voffB[i] = (unsigned)(g.bmode ? ((Rb & 63) * 128 + (Rb >> 6)) : Rb) * g.ldb2 + (unsigned)C * 2u; }
    const size_t kA = g.kA, kB = g.kB, hA = g.hA, hB = g.hB;
    const unsigned ldsw = (unsigned)wid * 1024u;
    const int aoff = lds_byte(wr * 64 + fr, fq * 8), boff = lds_byte(wc * 32 + fr, fq * 8);
#define PG8_GIDX(dst0, dst1, u) do { _Pragma("unroll") for (int _i = 0; _i < 2; ++_i) { \
        dst0[_i] = (unsigned)gidx[(u).pm * BM + gR[_i]] * g.lda2 + gC[_i]; dst1[_i] = (unsigned)gidx[(u).pm * BM + HALF + gR[_i]] * g.lda2 + gC[_i]; } } while (0)
#define PG8_SA(b, h) (((b) * 2 + (h)) * HTB)
#define PG8_SB(b, h) ((4 + (b) * 2 + (h)) * HTB)
#define PG8_STAGE(bufoff, gbase, voff) do { _Pragma("unroll") for (int _i = 0; _i < 2; ++_i) \
        __builtin_amdgcn_global_load_lds((const unsigned*)((const char*)(gbase) + (voff)[_i]), (LAS unsigned*)(lds + (bufoff) + ldsw + _i * 8192), 16, 0, 0); } while (0)
#define PG8_LDA(dst, b, h) do { _Pragma("unroll") for (int m = 0; m < 4; ++m) _Pragma("unroll") for (int k = 0; k < 2; ++k) dst[m][k] = *(const LAS bf16x8*)(lds + PG8_SA(b, h) + aoff + m * 2048 + k * 1024); } while (0)
#define PG8_LDB(dst, b, h) do { _Pragma("unroll") for (int n = 0; n < 2; ++n) _Pragma("unroll") for (int k = 0; k < 2; ++k) dst[n][k] = *(const LAS bf16x8*)(lds + PG8_SB(b, h) + boff + n * 2048 + k * 1024); } while (0)
#define PG8_MMA(ai, bj, At, Bt) do { __builtin_amdgcn_s_setprio(1); _Pragma("unroll") for (int m = 0; m < 4; ++m) _Pragma("unroll") for (int n = 0; n < 2; ++n) _Pragma("unroll") for (int k = 0; k < 2; ++k) \
        acc[ai][bj][m][n] = __builtin_amdgcn_mfma_f32_16x16x32_bf16(Bt[n][k], At[m][k], acc[ai][bj][m][n], 0, 0, 0); __builtin_amdgcn_s_setprio(0); } while (0)
#define PG8_WAIT_V(n) asm volatile("s_waitcnt vmcnt(" #n ")" ::: "memory")
#define PG8_WAIT_L(n) asm volatile("s_waitcnt lgkmcnt(" #n ")" ::: "memory")
#define PG8_BAR __builtin_amdgcn_s_barrier()
#define PG8_SCHED __builtin_amdgcn_sched_barrier(0)
    Unit cur, nxt; int ui = 0;
    if (!S.next(0, cur)) return;
    f32x4 acc[2][2][4][2];
#pragma unroll
    for (int a = 0; a < 2; ++a)
#pragma unroll
        for (int b = 0; b < 2; ++b)
#pragma unroll
            for (int m = 0; m < 4; ++m)
#pragma unroll
                for (int n = 0; n < 2; ++n) acc[a][b][m][n] = (f32x4){0.f, 0.f, 0.f, 0.f};
    bf16x8 At[4][2], B0[2][2], B1[2][2];
    const char* cA = g.A + g.offA(cur); const char* cB = g.B + g.offB(cur);
    S.a_ready(cur);
    if constexpr (GATHER) { PG8_GIDX(voffA, voffA1, cur); } else { voffA1[0] = voffA[0]; voffA1[1] = voffA[1]; }
    if constexpr (SP2) {
        PG8_STAGE(PG8_SB(0, 0), cB, voffB); PG8_STAGE(PG8_SB(0, 1), cB + hB, voffB); PG8_STAGE(PG8_SA(0, 0), cA, voffA); PG8_STAGE(PG8_SA(0, 1), cA + hA, voffA1);
        if (wr == 1) PG8_BAR;
        PG8_WAIT_V(2); PG8_BAR;
        PG8_STAGE(PG8_SB(1, 0), cB + kB, voffB); PG8_STAGE(PG8_SA(1, 0), cA + kA, voffA); PG8_STAGE(PG8_SB(1, 1), cB + hB + kB, voffB);
        PG8_WAIT_V(6); PG8_BAR;
    } else {
        PG8_STAGE(PG8_SB(0, 0), cB, voffB); PG8_STAGE(PG8_SA(0, 0), cA, voffA); PG8_STAGE(PG8_SB(0, 1), cB + hB, voffB); PG8_STAGE(PG8_SA(0, 1), cA + hA, voffA1);
        if (wr == 1) PG8_BAR;
        PG8_WAIT_V(4); PG8_BAR;
        PG8_STAGE(PG8_SB(1, 0), cB + kB, voffB); PG8_STAGE(PG8_SA(1, 0), cA + kA, voffA); PG8_STAGE(PG8_SB(1, 1), cB + hB + kB, voffB);
        PG8_WAIT_V(6); PG8_BAR;
    }
    for (;;) {
        const bool has_next = S.next(ui + 1, nxt);
        const char* nA = has_next ? g.A + g.offA(nxt) : cA; const char* nB = has_next ? g.B + g.offB(nxt) : cB;
        if constexpr (GATHER) { if (has_next) { PG8_GIDX(nvA0, nvA1, nxt); } else { nvA0[0] = voffA[0]; nvA0[1] = voffA[1]; nvA1[0] = voffA1[0]; nvA1[1] = voffA1[1]; } }
        for (int t = 0; t < nt; t += 2) {
            const bool last = (t == nt - 2);
            unsigned sA0[2], sA1[2];
            if constexpr (GATHER) { sA0[0] = last ? nvA0[0] : voffA[0]; sA0[1] = last ? nvA0[1] : voffA[1]; sA1[0] = last ? nvA1[0] : voffA1[0]; sA1[1] = last ? nvA1[1] : voffA1[1]; }
            else { sA0[0] = voffA[0]; sA0[1] = voffA[1]; sA1[0] = voffA[0]; sA1[1] = voffA[1]; }
            const char* a1 = cA + (size_t)(t + 1) * kA;
            const char* a2 = last ? nA : cA + (size_t)(t + 2) * kA; const char* b2 = last ? nB : cB + (size_t)(t + 2) * kB;
            const char* a3 = a2 + kA; const char* b3 = b2 + kB;
            if (last && has_next) S.a_ready(nxt);
            if constexpr (SP2) {
            PG8_LDB(B0, 0, 0); PG8_LDB(B1, 0, 1); PG8_SCHED; PG8_LDA(At, 0, 0); PG8_STAGE(PG8_SA(1, 1), a1 + hA, voffA1);
            PG8_WAIT_V(8); PG8_WAIT_L(0); PG8_BAR; PG8_MMA(0, 0, At, B0); PG8_MMA(0, 1, At, B1); PG8_BAR; PG8_SCHED;
            PG8_LDA(At, 0, 1); PG8_STAGE(PG8_SB(0, 0), b2, voffB); PG8_STAGE(PG8_SB(0, 1), b2 + hB, voffB); PG8_STAGE(PG8_SA(0, 0), a2, sA0);
            PG8_WAIT_V(8); PG8_WAIT_L(0); PG8_BAR; PG8_MMA(1, 0, At, B0); PG8_MMA(1, 1, At, B1); PG8_BAR; PG8_SCHED;
            PG8_LDB(B0, 1, 0); PG8_LDB(B1, 1, 1); PG8_SCHED; PG8_LDA(At, 1, 0); PG8_STAGE(PG8_SA(0, 1), a2 + hA, sA1);
            PG8_WAIT_V(8); PG8_WAIT_L(0); PG8_BAR; PG8_MMA(0, 0, At, B0); PG8_MMA(0, 1, At, B1); PG8_BAR; PG8_SCHED;
            PG8_LDA(At, 1, 1); PG8_STAGE(PG8_SB(1, 0), b3, voffB); PG8_STAGE(PG8_SB(1, 1), b3 + hB, voffB); PG8_STAGE(PG8_SA(1, 0), a3, sA0);
            PG8_WAIT_V(8); PG8_WAIT_L(0); PG8_BAR; PG8_MMA(1, 0, At, B0); PG8_MMA(1, 1, At, B1); PG8_BAR; PG8_SCHED;
            } else {
            PG8_LDB(B0, 0, 0); PG8_SCHED; PG8_LDA(At, 0, 0); PG8_STAGE(PG8_SA(1, 1), a1 + hA, voffA1);
            PG8_WAIT_L(8); PG8_BAR; PG8_WAIT_L(0); PG8_MMA(0, 0, At, B0); PG8_BAR; PG8_SCHED;
            PG8_LDB(B1, 0, 1); PG8_STAGE(PG8_SB(0, 0), b2, voffB);
            PG8_BAR; PG8_WAIT_L(0); PG8_MMA(0, 1, At, B1); PG8_BAR;
            PG8_LDA(At, 0, 1); PG8_STAGE(PG8_SA(0, 0), a2, sA0);
            PG8_BAR; PG8_WAIT_L(0); PG8_MMA(1, 0, At, B0); PG8_BAR; PG8_SCHED;
            PG8_STAGE(PG8_SB(0, 1), b2 + hB, voffB);
            PG8_WAIT_V(6); PG8_BAR; PG8_MMA(1, 1, At, B1); PG8_BAR;
            PG8_LDB(B0, 1, 0); PG8_SCHED; PG8_LDA(At, 1, 0); PG8_STAGE(PG8_SA(0, 1), a2 + hA, sA1);
            PG8_WAIT_L(8); PG8_BAR; PG8_WAIT_L(0); PG8_MMA(0, 0, At, B0); PG8_BAR; PG8_SCHED;
            PG8_LDB(B1, 1, 1); PG8_STAGE(PG8_SB(1, 0), b3, voffB);
            PG8_BAR; PG8_WAIT_L(0); PG8_MMA(0, 1, At, B1); PG8_BAR;
            PG8_LDA(At, 1, 1); PG8_STAGE(PG8_SA(1, 0), a3, sA0);
            PG8_BAR; PG8_WAIT_L(0); PG8_MMA(1, 0, At, B0); PG8_BAR; PG8_SCHED;
            PG8_STAGE(PG8_SB(1, 1), b3 + hB, voffB);
            PG8_WAIT_V(6); PG8_BAR; PG8_MMA(1, 1, At, B1); PG8_BAR;
            }
        }
        if constexpr (ALIGN_EPI) { if (wr == 0) PG8_BAR; }
        E(acc, cur, wr, wc, fr, fq); S.done(cur);
        if (!has_next) break;
#pragma unroll
        for (int a = 0; a < 2; ++a)
#pragma unroll
            for (int b = 0; b < 2; ++b)
#pragma unroll
                for (int m = 0; m < 4; ++m)
#pragma unroll
                    for (int n = 0; n < 2; ++n) acc[a][b][m][n] = (f32x4){0.f, 0.f, 0.f, 0.f};
        cur = nxt; cA = nA; cB = nB; ++ui;
        if constexpr (GATHER) { voffA[0] = nvA0[0]; voffA[1] = nvA0[1]; voffA1[0] = nvA1[0]; voffA1[1] = nvA1[1]; }
        if constexpr (ALIGN_EPI) { if (wr == 1) PG8_BAR; }
    }
    PG8_WAIT_V(0);
    if constexpr (!ALIGN_EPI) { if (wr == 0) PG8_BAR; }
    PG8_BAR;
#undef PG8_GIDX
#undef PG8_SA
#undef PG8_SB
#undef PG8_STAGE
#undef PG8_LDA
#undef PG8_LDB
#undef PG8_MMA
#undef PG8_WAIT_V
#undef PG8_WAIT_L
#undef PG8_BAR
#undef PG8_SCHED
}

typedef f32x4 AccT[2][2][4][2];

__device__ __forceinline__ float gelu_tanh(float x) {
    const float z = x * (1.5957691216f + 0.0713548163f * x * x);
    return x * __builtin_amdgcn_rcpf(1.0f + __builtin_amdgcn_exp2f(-1.4426950409f * z));
}
__device__ __forceinline__ u32x2 pack4(f32x4 v) { u32x2 w; w.x = cvt_pk_bf16(v[0], v[1]); w.y = cvt_pk_bf16(v[2], v[3]); return w; }

constexpr float QSCALE = 0.125f * 1.4426950408889634f;
struct EpiWin {
    static constexpr bool PERM = false;
    bf16_t *Q, *K, *V, *UV; const float* ropec; const float* ropes;
    __device__ __forceinline__ void operator()(const AccT& acc, const Unit& u, int wr, int wc, int fr, int fq) const {
        const int sec = u.pn >> 2, row0 = u.pm * BM + wr * 64 + fr;
        if (sec < 2) {
            bf16_t* O = sec == 0 ? Q : K;
            const int colb = (u.pn & 3) * 256 + wc * 32 + 4 * fq; const bool rope = u.pm >= 1;
#pragma unroll
            for (int ai = 0; ai < 2; ++ai)
#pragma unroll
                for (int m = 0; m < 4; ++m) { const int r = row0 + ai * HALF + m * 16; f32x4 cs = (f32x4){1.f, 1.f, 1.f, 1.f}, sn = (f32x4){0.f, 0.f, 0.f, 0.f};
                    if (rope) { const int t = r - CTXL, pos = (wc & 1) ? (t & 63) : (t >> 6); cs = *(const f32x4*)(ropec + pos * 16 + 4 * fq); sn = *(const f32x4*)(ropes + pos * 16 + 4 * fq); }
                    bf16_t* rowp = O + (size_t)r * 1024 + colb;
#pragma unroll
                    for (int bj = 0; bj < 2; ++bj) { const f32x4 x1 = acc[ai][bj][m][0], x2 = acc[ai][bj][m][1];
                        f32x4 o1 = x1 * cs - x2 * sn, o2 = x2 * cs + x1 * sn;
                        if (sec == 0) { o1 = o1 * QSCALE; o2 = o2 * QSCALE; }
                        *(u32x2*)(rowp + bj * HALF) = pack4(o1); *(u32x2*)(rowp + bj * HALF + 16) = pack4(o2); } }
        } else if (sec == 2) {
            const int colb = (u.pn & 3) * 256 + wc * 32 + 4 * fq;
#pragma unroll
            for (int ai = 0; ai < 2; ++ai)
#pragma unroll
                for (int m = 0; m < 4; ++m) { bf16_t* rowp = V + (size_t)(row0 + ai * HALF + m * 16) * 1024 + colb;
#pragma unroll
                    for (int bj = 0; bj < 2; ++bj)
#pragma unroll
                        for (int n = 0; n < 2; ++n) *(u32x2*)(rowp + bj * HALF + n * 16) = pack4(acc[ai][bj][m][n]); }
        } else {
            const int colb = (u.pn - 12) * 256 + wc * 32 + 4 * fq;
#pragma unroll
            for (int ai = 0; ai < 2; ++ai)
#pragma unroll
                for (int m = 0; m < 4; ++m) { bf16_t* rowp = UV + (size_t)(row0 + ai * HALF + m * 16) * 2048 + colb;
#pragma unroll
                    for (int bj = 0; bj < 2; ++bj)
#pragma unroll
                        for (int n = 0; n < 2; ++n) { f32x4 v = acc[ai][bj][m][n];
#pragma unroll
                            for (int j = 0; j < 4; ++j) v[j] = gelu_tanh(v[j]);
                            *(u32x2*)(rowp + bj * HALF + n * 16) = pack4(v); } }
        }
    }
};
template <bool XIN_F32> struct EpiResid {
    static constexpr bool PERM = false;
    const void* Xin; _Float16* Xout; const float* gate;
    __device__ __forceinline__ void operator()(const AccT& acc, const Unit& u, int wr, int wc, int fr, int fq) const {
        const int row0 = u.pm * BM + wr * 64 + fr, col0 = u.pn * BM + wc * 32 + 4 * fq;
        f32x4 gv[2][2];
#pragma unroll
        for (int bj = 0; bj < 2; ++bj)
#pragma unroll
            for (int n = 0; n < 2; ++n) gv[bj][n] = *(const f32x4*)(gate + col0 + bj * HALF + n * 16);
#pragma unroll
        for (int ai = 0; ai < 2; ++ai)
#pragma unroll
            for (int m = 0; m < 4; ++m) { const size_t ro = (size_t)(row0 + ai * HALF + m * 16) * DM + col0;
#pragma unroll
                for (int bj = 0; bj < 2; ++bj)
#pragma unroll
                    for (int n = 0; n < 2; ++n) { const size_t o = ro + bj * HALF + n * 16;
                        const f32x4 xi = XIN_F32 ? *(const f32x4*)((const float*)Xin + o) : ldx4((const _Float16*)Xin + o);
                        stx4(Xout + o, xi + gv[bj][n] * acc[ai][bj][m][n]); } }
    }
};
struct EpiBf16 {
    static constexpr bool PERM = true;
    bf16_t* O; int ldc; int aux_rows;
    __device__ __forceinline__ void operator()(const AccT& acc, const Unit& u, int wr, int wc, int fr, int fq) const {
        const int row0 = u.aux * aux_rows + u.pm * BM + wr * 64 + fr, col0 = u.pn * BM + wc * 32 + 8 * fq;
#pragma unroll
        for (int ai = 0; ai < 2; ++ai)
#pragma unroll
            for (int m = 0; m < 4; ++m) { bf16_t* rowp = O + (size_t)(row0 + ai * HALF + m * 16) * ldc + col0;
#pragma unroll
                for (int bj = 0; bj < 2; ++bj) { const f32x4 v0 = acc[ai][bj][m][0], v1 = acc[ai][bj][m][1];
                    u32x4 w; w.x = cvt_pk_bf16(v0[0], v0[1]); w.y = cvt_pk_bf16(v0[2], v0[3]); w.z = cvt_pk_bf16(v1[0], v1[1]); w.w = cvt_pk_bf16(v1[2], v1[3]);
                    *(u32x4*)(rowp + bj * HALF) = w; } }
    }
};
struct EpiGateUp {
    static constexpr bool PERM = true;
    bf16_t* ACT;
    __device__ __forceinline__ void operator()(const AccT& acc, const Unit& u, int wr, int wc, int fr, int fq) const {
        const int row0 = u.pm * BM + wr * 64 + fr, col0 = u.pn * 128 + wc * 32 + 8 * fq;
#pragma unroll
        for (int ai = 0; ai < 2; ++ai)
#pragma unroll
            for (int m = 0; m < 4; ++m) { bf16_t* rowp = ACT + (size_t)(row0 + ai * HALF + m * 16) * FE + col0;
                f32x4 o[2];
#pragma unroll
                for (int n = 0; n < 2; ++n) { const f32x4 gt = acc[ai][0][m][n], up = acc[ai][1][m][n];
#pragma unroll
                    for (int j = 0; j < 4; ++j) o[n][j] = gt[j] * up[j] * __builtin_amdgcn_rcpf(1.0f + __builtin_amdgcn_exp2f(-1.4426950409f * gt[j])); }
                u32x4 w; w.x = cvt_pk_bf16(o[0][0], o[0][1]); w.y = cvt_pk_bf16(o[0][2], o[0][3]); w.z = cvt_pk_bf16(o[1][0], o[1][1]); w.w = cvt_pk_bf16(o[1][2], o[1][3]);
                *(u32x4*)rowp = w; }
    }
};
struct EpiDown {
    static constexpr bool PERM = true;
    bf16_t* Y; const float* gate;
    __device__ __forceinline__ void operator()(const AccT& acc, const Unit& u, int wr, int wc, int fr, int fq) const {
        const int row0 = u.pm * BM + wr * 64 + fr, col0 = u.pn * BM + wc * 32 + 8 * fq;
#pragma unroll
        for (int ai = 0; ai < 2; ++ai)
#pragma unroll
            for (int m = 0; m < 4; ++m) { const int r = row0 + ai * HALF + m * 16; const float gr = gate[r]; bf16_t* rowp = Y + (size_t)r * DM + col0;
#pragma unroll
                for (int bj = 0; bj < 2; ++bj) { const f32x4 v0 = acc[ai][bj][m][0] * gr, v1 = acc[ai][bj][m][1] * gr;
                    u32x4 w; w.x = cvt_pk_bf16(v0[0], v0[1]); w.y = cvt_pk_bf16(v0[2], v0[3]); w.z = cvt_pk_bf16(v1[0], v1[1]); w.w = cvt_pk_bf16(v1[2], v1[3]);
                    *(u32x4*)(rowp + bj * HALF) = w; } }
    }
};
}

namespace att {
__device__ __forceinline__ int crow(int r, int hi) { return (r & 3) + 8 * (r >> 2) + 4 * hi; }
__device__ __forceinline__ void sgu_unit(const bf16_t* __restrict__ UV, bf16_t* __restrict__ CAT, const float* __restrict__ w_sp, const float* __restrict__ b_sp,
                                         const float* __restrict__ ln_g, const float* __restrict__ ln_b, int chunk, int g, char* lds) {
  const int tid = threadIdx.x, wid = tid >> 6, lane = tid & 63, r32 = lane & 31, hi = lane >> 5;
  bf16_t* vT = (bf16_t*)lds;
  const int wp = wid >> 1, wd = wid & 1;
  unsigned pkv[16]; f32x4 wsv[16]; u32x4 uwv[4];
#pragma unroll
  for (int i = 0; i < 16; ++i) pkv[i] = *(const unsigned*)(UV + (size_t)(CTXL + chunk * 128 + wid * 16 + i) * DM + 1024 + g * 128 + 2 * lane);
  { const float* Wg = w_sp + (size_t)g * 128 * 128 + (size_t)(wp * 32 + r32) * 128 + hi * 8;
#pragma unroll
    for (int ks = 0; ks < 8; ++ks) { wsv[2 * ks] = *(const f32x4*)(Wg + ks * 16); wsv[2 * ks + 1] = *(const f32x4*)(Wg + ks * 16 + 4); } }
#pragma unroll
  for (int i = 0; i < 4; ++i) { const int ch = tid + 512 * i, p = ch >> 4, d0 = (ch & 15) * 8; uwv[i] = *(const u32x4*)(UV + (size_t)(CTXL + chunk * 128 + p) * DM + g * 128 + d0); }
  { const float lg0 = ln_g[g * 128 + 2 * lane], lg1 = ln_g[g * 128 + 2 * lane + 1], lb0 = ln_b[g * 128 + 2 * lane], lb1 = ln_b[g * 128 + 2 * lane + 1];
#pragma unroll
    for (int i = 0; i < 16; ++i) { const int pos = wid * 16 + i;
      const unsigned pk = pkv[i];
      const float a = bflo(pk), b = bfhi(pk);
      const float mean = wave_sum(a + b) * (1.0f / 128.0f); const float da = a - mean, db = b - mean;
      const float var = wave_sum(da * da + db * db) * (1.0f / 128.0f); const float rstd = 1.0f / sqrtf(var + EPS);
      vT[(2 * lane) * 136 + pos] = (bf16_t)f2bf(da * rstd * lg0 + lb0); vT[(2 * lane + 1) * 136 + pos] = (bf16_t)f2bf(db * rstd * lg1 + lb1); } }
  __syncthreads();
  f32x16 acc[2]; acc[0] = f32x16{}; acc[1] = f32x16{};
#pragma unroll
  for (int ks = 0; ks < 8; ++ks) { const f32x4 w0 = wsv[2 * ks], w1 = wsv[2 * ks + 1];
    u32x4 aw; aw.x = pk2(w0[0], w0[1]); aw.y = pk2(w0[2], w0[3]); aw.z = pk2(w1[0], w1[1]); aw.w = pk2(w1[2], w1[3]);
    const bf16x8 af = __builtin_bit_cast(bf16x8, aw);
#pragma unroll
    for (int nb = 0; nb < 2; ++nb) { const bf16x8 bf = *(const bf16x8*)(vT + (wd * 64 + nb * 32 + r32) * 136 + ks * 16 + hi * 8);
      acc[nb] = __builtin_amdgcn_mfma_f32_32x32x16_bf16(af, bf, acc[nb], 0, 0, 0); } }
  __syncthreads();
  float* mt = (float*)lds;
#pragma unroll
  for (int nb = 0; nb < 2; ++nb) { const int d = wd * 64 + nb * 32 + r32;
#pragma unroll
    for (int r = 0; r < 16; ++r) { const int p = wp * 32 + crow(r, hi); mt[p * 132 + d] = acc[nb][r] + b_sp[g * 128 + p]; } }
  __syncthreads();
#pragma unroll
  for (int i = 0; i < 4; ++i) { const int ch = tid + 512 * i, p = ch >> 4, d0 = (ch & 15) * 8, t = chunk * 128 + p;
    const u32x4 uw = uwv[i];
    const f32x4 m0 = *(const f32x4*)(mt + p * 132 + d0), m1 = *(const f32x4*)(mt + p * 132 + d0 + 4);
    u32x4 o; o.x = pk2(bflo(uw.x) * m0.x, bfhi(uw.x) * m0.y); o.y = pk2(bflo(uw.y) * m0.z, bfhi(uw.y) * m0.w);
    o.z = pk2(bflo(uw.z) * m1.x, bfhi(uw.z) * m1.y); o.w = pk2(bflo(uw.w) * m1.z, bfhi(uw.w) * m1.w);
    *(u32x4*)(CAT + (size_t)t * DM + 1024 + g * 128 + d0) = o; }
  __syncthreads();
}
}


namespace att2 {
using bf16x8_t = bf16x8;
constexpr int NW = 8, QBLK = 32, KVBLK = 64, NSLOT = 3, SLOTB = 16384, DMK = 1024, NT = MC / KVBLK;
constexpr int LDS_K = 0, LDS_V = NSLOT * SLOTB, LDS_WS = 2 * NSLOT * SLOTB, LDS_Q = LDS_WS + NW * 64 * 4, LDS_BYTES_ATT = LDS_Q + NW * 4096;
__device__ __forceinline__ int crow(int r, int hi) { return (r & 3) + 8 * (r >> 2) + 4 * hi; }
#define SBAR() __builtin_amdgcn_sched_barrier(0)
template <int IMM> __device__ __forceinline__ void glds16(const void* sbase, unsigned voff, unsigned lds_dst) { unsigned keep;
  asm volatile("s_mov_b32 %0, m0\n\ts_mov_b32 m0, %3\n\ts_nop 0\n\tglobal_load_lds_dwordx4 %1, %2 offset:%c4\n\ts_mov_b32 m0, %0" : "=&s"(keep) : "v"(voff), "s"(sbase), "s"(lds_dst), "i"(IMM) : "memory"); }
__device__ __forceinline__ float max3f(float a, float b, float c) { float r; asm("v_max3_f32 %0, %1, %2, %3" : "=v"(r) : "v"(a), "v"(b), "v"(c)); return r; }
__device__ __forceinline__ float max2f(float a, float b) { float r; asm("v_max_f32_e32 %0, %1, %2" : "=v"(r) : "v"(a), "v"(b)); return r; }
__device__ __forceinline__ float fadd_s(float a, float b) { float r; asm("v_add_f32_e32 %0, %1, %2" : "=v"(r) : "v"(a), "v"(b)); return r; }
__device__ __forceinline__ float fsub_s(float a, float b) { float r; asm("v_sub_f32_e32 %0, %1, %2" : "=v"(r) : "v"(a), "v"(b)); return r; }
typedef __bf16 bf16x2_t __attribute__((ext_vector_type(2)));
__device__ __forceinline__ unsigned cvtpk_s(float lo, float hi) { f32x2 v = {lo, hi}; bf16x2_t b = __builtin_convertvector(v, bf16x2_t); return __builtin_bit_cast(unsigned, b); }
#define WAIT_BAR(N) asm volatile("s_waitcnt vmcnt(" #N ") lgkmcnt(0)\n\ts_barrier" ::: "memory")
typedef LAS const char* lds_cptr;
typedef short v4i16_t __attribute__((ext_vector_type(4)));
__device__ __forceinline__ void kload8(bf16x8* kf, lds_cptr kp) {
  kf[0] = *(const LAS bf16x8*)(kp);        kf[1] = *(const LAS bf16x8*)(kp + 512);
  kf[2] = *(const LAS bf16x8*)(kp + 2048); kf[3] = *(const LAS bf16x8*)(kp + 2560);
  kf[4] = *(const LAS bf16x8*)(kp + 4096); kf[5] = *(const LAS bf16x8*)(kp + 4608);
  kf[6] = *(const LAS bf16x8*)(kp + 6144); kf[7] = *(const LAS bf16x8*)(kp + 6656);
}
__device__ __forceinline__ void kload2(bf16x8* kf, lds_cptr kp, int j) { kf[2 * j] = *(const LAS bf16x8*)(kp + j * 2048); kf[2 * j + 1] = *(const LAS bf16x8*)(kp + j * 2048 + 512); }
__device__ __forceinline__ s16x4 vtr(lds_cptr p) { return __builtin_bit_cast(s16x4, __builtin_amdgcn_ds_read_tr16_b64_v4i16((LAS v4i16_t*)p)); }
__device__ __forceinline__ float rowmax(const f32x16& p0, const f32x16& p1) {
  float a = max3f(p0[0], p0[1], p1[0]), b = max3f(p0[2], p0[3], p1[1]); a = max3f(a, p1[2], p1[3]);
#pragma unroll
  for (int r = 4; r < 16; r += 4) { a = max3f(a, p0[r], p0[r + 1]); b = max3f(b, p0[r + 2], p0[r + 3]); a = max3f(a, p1[r], p1[r + 1]); b = max3f(b, p1[r + 2], p1[r + 3]); }
  const float m = max2f(a, b);
  auto rr = __builtin_amdgcn_permlane32_swap(__float_as_uint(m), __float_as_uint(m), false, false);
  return max2f(__uint_as_float(rr[0]), __uint_as_float(rr[1]));
}
__device__ __forceinline__ void qkt(f32x16& p0, f32x16& p1, lds_cptr kb, const bf16x8* qr, const f32x16& negm) {
#pragma unroll
  for (int d0 = 0; d0 < 4; ++d0) {
    const bf16x8 b0 = *(const LAS bf16x8*)(kb + d0 * 2048);
    const bf16x8 b1 = *(const LAS bf16x8*)(kb + d0 * 2048 + 512);
    if (d0 == 0) { p0 = __builtin_amdgcn_mfma_f32_32x32x16_bf16(b0, qr[0], negm, 0, 0, 0); p1 = __builtin_amdgcn_mfma_f32_32x32x16_bf16(b1, qr[0], negm, 0, 0, 0); }
    else { p0 = __builtin_amdgcn_mfma_f32_32x32x16_bf16(b0, qr[d0], p0, 0, 0, 0); p1 = __builtin_amdgcn_mfma_f32_32x32x16_bf16(b1, qr[d0], p1, 0, 0, 0); } }
}
__device__ __forceinline__ void pv_last(f32x16* o, int vb, bf16x8 pa0, bf16x8 pa1, bf16x8 pa2, bf16x8 pa3) {
#pragma unroll
  for (int d0 = 0; d0 < 4; ++d0) { s16x4 lo[4], hi[4];
#pragma unroll
    for (int ks = 0; ks < 4; ++ks) {
      asm volatile("ds_read_b64_tr_b16 %0,%1 offset:%c2" : "=&v"(lo[ks]) : "v"(vb), "i"(d0 * 4096 + ks * 1024) : "memory");
      asm volatile("ds_read_b64_tr_b16 %0,%1 offset:%c2" : "=&v"(hi[ks]) : "v"(vb), "i"(d0 * 4096 + ks * 1024 + 512) : "memory"); }
    asm volatile("s_waitcnt lgkmcnt(0)" ::: "memory"); SBAR();
#define PK(k) (bf16x8){lo[k][0], lo[k][1], lo[k][2], lo[k][3], hi[k][0], hi[k][1], hi[k][2], hi[k][3]}
    o[d0] = __builtin_amdgcn_mfma_f32_32x32x16_bf16(pa0, PK(0), o[d0], 0, 0, 0);
    o[d0] = __builtin_amdgcn_mfma_f32_32x32x16_bf16(pa1, PK(1), o[d0], 0, 0, 0);
    o[d0] = __builtin_amdgcn_mfma_f32_32x32x16_bf16(pa2, PK(2), o[d0], 0, 0, 0);
    o[d0] = __builtin_amdgcn_mfma_f32_32x32x16_bf16(pa3, PK(3), o[d0], 0, 0, 0);
#undef PK
  }
}

template <int THRL>
__device__ __forceinline__ void attn_unit(const bf16_t* Q, const bf16_t* __restrict__ K, const bf16_t* __restrict__ V, bf16_t* __restrict__ CAT,
                                          int head, int qb, float lam, float out_scale, const float* __restrict__ g_subln, LAS unsigned char* shm) {
  const int tid = threadIdx.x, lane = tid & 63, r32 = lane & 31, hi = lane >> 5; const int wid = __builtin_amdgcn_readfirstlane(tid >> 6);
  const int comp = wid >> 2, wq = wid & 3;
  if (wid >= 4) __builtin_amdgcn_s_setprio(1);
  const bf16_t* Qw = Q + (size_t)(CTXL + qb * 128 + wq * QBLK) * DMK + head * 128 + comp * 64;
  const bf16_t* Kh = K + head * 128; const bf16_t* Vh = V + head * 128;
  const unsigned lds0 = (unsigned)(uintptr_t)shm;
  LAS float* wsf = (LAS float*)(shm + LDS_WS) + wid * 64;
  const unsigned kvoff = (unsigned)(lane * DMK + wid * 8) * 2u;
  const unsigned vvoff = (unsigned)((16 * (wid & 3) + (lane >> 2)) * DMK + (wid >> 2) * 32 + (lane & 3) * 8) * 2u;
  const unsigned kdst = lds0 + LDS_K + wid * 1024, vdst = lds0 + LDS_V + wid * 1024;
#define DMA_K(t, slot) do { const bf16_t* sb_ = Kh + (long)(t) * KVBLK * DMK; glds16<0>(sb_, kvoff, (unsigned)__builtin_amdgcn_readfirstlane(kdst + (slot))); glds16<0>(sb_ + 64, kvoff, (unsigned)__builtin_amdgcn_readfirstlane(kdst + 8192 + (slot))); } while (0)
#define DMAK1(t, slot) do { glds16<0>(Kh + (long)(t) * KVBLK * DMK, kvoff, (unsigned)__builtin_amdgcn_readfirstlane(kdst + (slot))); SBAR(); } while (0)
#define DMAK2(t, slot) do { glds16<0>(Kh + (long)(t) * KVBLK * DMK + 64, kvoff, (unsigned)__builtin_amdgcn_readfirstlane(kdst + 8192 + (slot))); SBAR(); } while (0)
#define DMAV1(t, slot) do { glds16<0>(Vh + (long)(t) * KVBLK * DMK, vvoff, (unsigned)__builtin_amdgcn_readfirstlane(vdst + (slot))); SBAR(); } while (0)
#define DMAV2(t, slot) do { glds16<0>(Vh + (long)(t) * KVBLK * DMK + 64, vvoff, (unsigned)__builtin_amdgcn_readfirstlane(vdst + 8192 + (slot))); SBAR(); } while (0)
#define DMA_V(t, slot) do { const bf16_t* sb_ = Vh + (long)(t) * KVBLK * DMK; glds16<0>(sb_, vvoff, (unsigned)__builtin_amdgcn_readfirstlane(vdst + (slot))); glds16<0>(sb_ + 64, vvoff, (unsigned)__builtin_amdgcn_readfirstlane(vdst + 8192 + (slot))); } while (0)
  const int vb0 = (int)(lds0 + LDS_V) + ((lane >> 4) & 1) * 32 + (lane & 3) * 8 + (4 * hi + ((lane & 15) >> 2)) * 64;
  bf16x8 kf[8];
  const lds_cptr shm3 = (lds_cptr)shm; const lds_cptr kp0 = shm3 + LDS_K + comp * 8192 + hi * 1024 + r32 * 16;
  const lds_cptr vp0 = shm3 + LDS_V + ((lane >> 4) & 1) * 32 + (lane & 3) * 8 + (4 * hi + ((lane & 15) >> 2)) * 64;
  DMA_K(0, 0); DMA_V(0, 0); DMA_K(1, SLOTB);
  bf16x8 qr[4];
#pragma unroll
  for (int d0 = 0; d0 < 4; ++d0) qr[d0] = *reinterpret_cast<const bf16x8*>(&Qw[(long)r32 * DMK + d0 * 16 + hi * 8]);
  float mhat = 0.f, l_reg = 0.f; f32x16 o[4]; o[0] = f32x16{}; o[1] = f32x16{}; o[2] = f32x16{}; o[3] = f32x16{}; f32x16 negm = f32x16{}; asm volatile("" : "+v"(negm));
  bool resc = false;
#define START(P0, P1) do { const float rm = rowmax(P0, P1); resc = false; \
    { const float dl = rm; mhat = fadd_s(mhat, dl); \
      _Pragma("unroll") for (int r = 0; r < 16; ++r) { P0[r] = fsub_s(P0[r], dl); P1[r] = fsub_s(P1[r], dl); } \
      _Pragma("unroll") for (int r = 0; r < 16; ++r) negm[r] = -mhat; asm volatile("" : "+v"(negm)); } \
    _Pragma("unroll") for (int r = 0; r < 16; ++r) P0[r] = __builtin_amdgcn_exp2f(P0[r]); } while (0)
#define RESC() do { if (resc) { asm volatile("s_waitcnt lgkmcnt(0)" ::: "memory"); \
      _Pragma("unroll") for (int d_ = 0; d_ < 4; ++d_) _Pragma("unroll") for (int r = 0; r < 16; ++r) o[d_][r] *= wsf[crow(r, hi)]; } } while (0)
  f32x16 pA0, pA1, pB0, pB1;
  int sl_prev = 0, sl_cur = 0, sl_next = SLOTB;
#define ROT() do { sl_prev = sl_cur; sl_cur = sl_next; sl_next = (sl_next == (NSLOT - 1) * SLOTB) ? 0 : sl_next + SLOTB; } while (0)
  DMA_K(2, 2 * SLOTB);
  WAIT_BAR(6);
  qkt(pA0, pA1, kp0, qr, negm); asm volatile("s_nop 15\n\ts_nop 7" : "+v"(pA0), "+v"(pA1));
  const lds_cptr qp = shm3 + LDS_Q + wid * 4096 + lane * 16;
#pragma unroll
  for (int d0 = 0; d0 < 4; ++d0) *(LAS bf16x8*)(shm + LDS_Q + wid * 4096 + lane * 16 + d0 * 1024) = qr[d0];
  START(pA0, pA1);
#pragma unroll
  for (int r = 0; r < 16; ++r) pA1[r] = __builtin_amdgcn_exp2f(pA1[r]);
  WAIT_BAR(0);
  DMA_K(3, 0); DMA_V(1, SLOTB);
  ROT();
  kload8(kf, kp0 + sl_cur);
  WAIT_BAR(4);
  s16x4 vlo[4], vhi[4]; u32x4 pw0, pw1, pw2, pw3;
#define PKW(P, B) cvtpk_s(P[B], P[B + 1])
#define PAF(k) __builtin_bit_cast(bf16x8, pw##k)
#define VFR(i) (bf16x8){vlo[i][0], vlo[i][1], vlo[i][2], vlo[i][3], vhi[i][0], vhi[i][1], vhi[i][2], vhi[i][3]}
#define PIN(x) asm volatile("" : "+v"(x))
#define MX3(a, b, c) __builtin_fmaxf(__builtin_fmaxf((a), (b)), (c))
#define GAPA(MF, A0, A1, A2, A3, W0, W1, PW) do { MF; sacc += A0; sacc += A1; sacc += A2; sacc += A3; PIN(sacc); W0; W1; PIN(PW); SBAR(); } while (0)
#define EX(v) __builtin_amdgcn_exp2f(v)
#define GAPB(MF, X, B) do { MF; X[B] = EX(X[B]); X[B + 1] = EX(X[B + 1]); PIN(X); } while (0)
#define VRD(s) do { vlo[(s) & 3] = vtr(vp_ + (((s) & 3) * 4096 + ((s) >> 2) * 1024)); vhi[(s) & 3] = vtr(vp_ + (((s) & 3) * 4096 + ((s) >> 2) * 1024 + 512)); } while (0)
#define KRD(G, j) do { if (G) { kload2(kf, kp0 + sl_next, j); SBAR(); } } while (0)
#define PVS(s, PA, X, B) do { GAPB(o[(s) & 3] = __builtin_amdgcn_mfma_f32_32x32x16_bf16(PA, VFR((s) & 3), o[(s) & 3], 0, 0, 0), X, B); if ((s) + 4 < 16) { VRD((s) + 4); } SBAR(); } while (0)
#define STEP(C0, C1, P0, P1, t, GK, GV, GL) do { SBAR(); \
    const lds_cptr vp_ = vp0 + sl_prev; \
    float sacc = (P0[0] + P0[1]); bf16x8 qa = *(const LAS bf16x8*)(qp), qb_; \
    GAPA(C0 = __builtin_amdgcn_mfma_f32_32x32x16_bf16(kf[0], qa, negm, 0, 0, 0), P0[2], P0[3], P0[4], P0[5],     pw0[0] = PKW(P0, 0), pw0[1] = PKW(P0, 2), pw0); \
    GAPA(C1 = __builtin_amdgcn_mfma_f32_32x32x16_bf16(kf[1], qa, negm, 0, 0, 0), P0[6], P0[7], P0[8], P0[9],     pw0[2] = PKW(P0, 4), pw0[3] = PKW(P0, 6), pw0); qb_ = *(const LAS bf16x8*)(qp + 1024); \
    GAPA(C0 = __builtin_amdgcn_mfma_f32_32x32x16_bf16(kf[2], qb_, C0, 0, 0, 0),   P0[10], P0[11], P0[12], P0[13], pw1[0] = PKW(P0, 8), pw1[1] = PKW(P0, 10), pw1); \
    GAPA(C1 = __builtin_amdgcn_mfma_f32_32x32x16_bf16(kf[3], qb_, C1, 0, 0, 0),   P0[14], P0[15], P1[0], P1[1],   pw1[2] = PKW(P0, 12), pw1[3] = PKW(P0, 14), pw1); qa = *(const LAS bf16x8*)(qp + 2048); \
    VRD(0); SBAR(); GAPA(C0 = __builtin_amdgcn_mfma_f32_32x32x16_bf16(kf[4], qa, C0, 0, 0, 0),   P1[2], P1[3], P1[4], P1[5],     pw2[0] = PKW(P1, 0), pw2[1] = PKW(P1, 2), pw2); \
    VRD(1); SBAR(); GAPA(C1 = __builtin_amdgcn_mfma_f32_32x32x16_bf16(kf[5], qa, C1, 0, 0, 0),   P1[6], P1[7], P1[8], P1[9],     pw2[2] = PKW(P1, 4), pw2[3] = PKW(P1, 6), pw2); qb_ = *(const LAS bf16x8*)(qp + 3072); \
    VRD(2); SBAR(); GAPA(C0 = __builtin_amdgcn_mfma_f32_32x32x16_bf16(kf[6], qb_, C0, 0, 0, 0),   P1[10], P1[11], P1[12], P1[13], pw3[0] = PKW(P1, 8), pw3[1] = PKW(P1, 10), pw3); \
    VRD(3); SBAR(); GAPA(C1 = __builtin_amdgcn_mfma_f32_32x32x16_bf16(kf[7], qb_, C1, 0, 0, 0),   P1[14], P1[15], 0.f, 0.f,       pw3[2] = PKW(P1, 12), pw3[3] = PKW(P1, 14), pw3); \
    l_reg += sacc; \
    { float a = MX3(C0[0], C0[1], C1[0]), b = MX3(C0[2], C0[3], C1[1]); a = MX3(a, C1[2], C1[3]); \
      _Pragma("unroll") for (int r = 4; r < 16; r += 4) { a = MX3(a, C0[r], C0[r + 1]); b = MX3(b, C0[r + 2], C0[r + 3]); a = MX3(a, C1[r], C1[r + 1]); b = MX3(b, C1[r + 2], C1[r + 3]); } \
      float rm = __builtin_fmaxf(a, b); { auto rr = __builtin_amdgcn_permlane32_swap(__float_as_uint(rm), __float_as_uint(rm), false, false); rm = __builtin_fmaxf(__uint_as_float(rr[0]), __uint_as_float(rr[1])); } \
      resc = false; \
      if (__builtin_expect(__any(rm > (float)THRL), 0)) { const float dl = __builtin_fmaxf(rm, 0.f); mhat += dl; \
        _Pragma("unroll") for (int r = 0; r < 16; ++r) { C0[r] -= dl; C1[r] -= dl; } \
        _Pragma("unroll") for (int r = 0; r < 16; ++r) negm[r] = -mhat; asm volatile("" : "+v"(negm)); \
        const float f = __builtin_amdgcn_exp2f(-dl); l_reg *= f; if (hi == 0) wsf[r32] = f; resc = true; } } \
    SBAR(); \
    PVS(0, PAF(0), C0, 0);  if (GK) { DMAK1((t) + 3, sl_cur); } PVS(1, PAF(0), C0, 2);  PVS(2, PAF(0), C0, 4);  if (GK) { DMAK2((t) + 3, sl_cur); } PVS(3, PAF(0), C0, 6); \
    KRD(GL, 0); PVS(4, PAF(1), C0, 8);  if (GV) { DMAV1((t) + 1, sl_next); } PVS(5, PAF(1), C0, 10); KRD(GL, 1); PVS(6, PAF(1), C0, 12); if (GV) { DMAV2((t) + 1, sl_next); } PVS(7, PAF(1), C0, 14); \
    KRD(GL, 2); PVS(8, PAF(2), C1, 0);  PVS(9, PAF(2), C1, 2);  KRD(GL, 3); PVS(10, PAF(2), C1, 4); PVS(11, PAF(2), C1, 6); \
    PVS(12, PAF(3), C1, 8); PVS(13, PAF(3), C1, 10); PVS(14, PAF(3), C1, 12); PVS(15, PAF(3), C1, 14); \
    } while (0)
  int t = 1;
  for (; t + 5 < NT; t += 2) {
    STEP(pB0, pB1, pA0, pA1, t, true, true, true);     WAIT_BAR(4); RESC(); ROT();
    STEP(pA0, pA1, pB0, pB1, t + 1, true, true, true); WAIT_BAR(4); RESC(); ROT();
  }
#define ENDW(tt) do { if ((tt) + 3 < NT) { WAIT_BAR(4); } else if ((tt) + 2 < NT) { WAIT_BAR(2); } else { WAIT_BAR(0); } } while (0)
  for (; t + 1 < NT; t += 2) {
    STEP(pB0, pB1, pA0, pA1, t, (t + 3 < NT), (t + 1 < NT), (t + 1 < NT));         ENDW(t);     RESC(); ROT();
    STEP(pA0, pA1, pB0, pB1, t + 1, (t + 4 < NT), (t + 2 < NT), (t + 2 < NT));     ENDW(t + 1); RESC(); ROT();
  }
  STEP(pB0, pB1, pA0, pA1, NT - 1, false, false, false); RESC();
  { float sacc = pB0[0] + pB0[1];
#pragma unroll
    for (int r = 2; r < 16; ++r) sacc += pB0[r];
#pragma unroll
    for (int r = 0; r < 16; ++r) sacc += pB1[r];
    l_reg += sacc;
    pw0 = (u32x4){PKW(pB0, 0), PKW(pB0, 2), PKW(pB0, 4), PKW(pB0, 6)}; pw1 = (u32x4){PKW(pB0, 8), PKW(pB0, 10), PKW(pB0, 12), PKW(pB0, 14)};
    pw2 = (u32x4){PKW(pB1, 0), PKW(pB1, 2), PKW(pB1, 4), PKW(pB1, 6)}; pw3 = (u32x4){PKW(pB1, 8), PKW(pB1, 10), PKW(pB1, 12), PKW(pB1, 14)};
    SBAR(); pv_last(o, vb0 + sl_cur, PAF(0), PAF(1), PAF(2), PAF(3)); }
  { auto rr = __builtin_amdgcn_permlane32_swap(__float_as_uint(l_reg), __float_as_uint(l_reg), false, false); l_reg = __uint_as_float(rr[0]) + __uint_as_float(rr[1]); }
  if (hi == 0) wsf[32 + r32] = l_reg; asm volatile("s_waitcnt lgkmcnt(0)" ::: "memory");
  float rli[16];
#pragma unroll
  for (int r = 0; r < 16; ++r) rli[r] = __builtin_amdgcn_rcpf(wsf[32 + crow(r, hi)]);
  asm volatile("s_waitcnt lgkmcnt(0)\n\ts_barrier" ::: "memory");
  LAS float* buf = (LAS float*)shm;
  if (comp == 1) {
#pragma unroll
    for (int r = 0; r < 16; ++r) { const int orow = wq * QBLK + crow(r, hi);
#pragma unroll
      for (int d0 = 0; d0 < 4; ++d0) buf[orow * 128 + d0 * 32 + r32] = o[d0][r] * rli[r] * lam; }
  }
  asm volatile("s_waitcnt lgkmcnt(0)\n\ts_barrier" ::: "memory");
  if (comp == 0) {
#pragma unroll
    for (int r = 0; r < 16; ++r) { const int orow = wq * QBLK + crow(r, hi);
#pragma unroll
      for (int d0 = 0; d0 < 4; ++d0) { const int ix = orow * 128 + d0 * 32 + r32; buf[ix] = o[d0][r] * rli[r] - buf[ix]; } }
  }
  asm volatile("s_waitcnt lgkmcnt(0)\n\ts_barrier" ::: "memory");
  { const float g0 = g_subln[lane * 2] * out_scale, g1 = g_subln[lane * 2 + 1] * out_scale;
#pragma unroll 4
    for (int i = 0; i < 16; ++i) { const int row = wid * 16 + i; const f32x2 v = *(const LAS f32x2*)(buf + row * 128 + lane * 2);
      const float ss = wave_sum(v.x * v.x + v.y * v.y); const float rstd = 1.0f / sqrtf(ss * (1.0f / 128.0f) + EPS);
      *(unsigned*)(CAT + (size_t)(qb * 128 + row) * DM + head * 128 + lane * 2) = pk2(v.x * rstd * g0, v.y * rstd * g1); } }
  asm volatile("s_waitcnt vmcnt(0) lgkmcnt(0)\n\ts_barrier" ::: "memory");
  if (wid >= 4) __builtin_amdgcn_s_setprio(0);
#undef DMA_K
#undef DMA_V
#undef DMAK1
#undef DMAK2
#undef DMAV1
#undef DMAV2
#undef START
#undef RESC
#undef ROT
#undef PKW
#undef PAF
#undef VFR
#undef PIN
#undef MX3
#undef GAPA
#undef GAPB
#undef EX
#undef VRD
#undef KRD
#undef PVS
#undef STEP
#undef ENDW
}
#undef SBAR
#undef WAIT_BAR
}

namespace fft {
constexpr int XST = 72, ZST = 136, LDS_X = 0, LDS_Z = 2 * 128 * XST * 2;
__device__ __forceinline__ int crow(int r, int hi) { return (r & 3) + 8 * (r >> 2) + 4 * hi; }
__device__ __forceinline__ void fft_phase(const bf16_t* __restrict__ WCT, bf16_t* __restrict__ FB, const bf16_t* __restrict__ A1T, const bf16_t* __restrict__ A2T, const float* __restrict__ TW, char* lds, int G) {
  const int tid = threadIdx.x, wid = tid >> 6, lane = tid & 63, r32 = lane & 31, hi = lane >> 5;
  bf16_t* Xs = (bf16_t*)(lds + LDS_X); bf16_t* Zs = (bf16_t*)(lds + LDS_Z);
  const int mb = wid & 3, nbp = wid >> 2;
  bf16x8 a1[8], a2[16];
#pragma unroll
  for (int ks = 0; ks < 8; ++ks) a1[ks] = *(const bf16x8*)(A1T + (32 * mb + r32) * 128 + 16 * ks + 8 * hi);
#pragma unroll
  for (int ks = 0; ks < 16; ++ks) a2[ks] = *(const bf16x8*)(A2T + (32 * mb + r32) * 256 + 16 * ks + 8 * hi);
  f32x2 tw[2][8];
#pragma unroll
  for (int nbi = 0; nbi < 2; ++nbi)
#pragma unroll
    for (int q = 0; q < 8; ++q) { const int k1 = 16 * mb + 4 * (q >> 1) + 2 * hi + (q & 1), t2 = 32 * (2 * nbp + nbi) + r32; tw[nbi][q] = *(const f32x2*)(TW + 2 * (k1 * 128 + t2)); }
  const int k1o = 32 * nbp + r32;
#define FFT_COLUMN(cp, OUT) do { \
      { const bf16_t* src = WCT + (size_t)(2 * (cp)) * 8192; \
        _Pragma("unroll") for (int pass = 0; pass < 4; ++pass) { const int p = tid + 512 * pass, ri = p >> 10, e = (p & 1023) * 8, t2 = e >> 6, t1 = e & 63; \
          const u32x4 v = *(const u32x4*)(src + (size_t)ri * 8192 + e); *(u32x4*)(Xs + (ri * 128 + t2) * XST + t1) = v; } } \
      __syncthreads(); \
      f32x16 acc[2]; acc[0] = f32x16{}; acc[1] = f32x16{}; \
      _Pragma("unroll") for (int ks = 0; ks < 8; ++ks) \
        _Pragma("unroll") for (int nbi = 0; nbi < 2; ++nbi) { const int t2 = 32 * (2 * nbp + nbi) + r32; \
          const bf16x8 bfr = *(const bf16x8*)(Xs + ((ks >> 2) * 128 + t2) * XST + (ks & 3) * 16 + 8 * hi); \
          acc[nbi] = __builtin_amdgcn_mfma_f32_32x32x16_bf16(a1[ks], bfr, acc[nbi], 0, 0, 0); } \
      _Pragma("unroll") for (int nbi = 0; nbi < 2; ++nbi) { const int t2 = 32 * (2 * nbp + nbi) + r32; \
        _Pragma("unroll") for (int q = 0; q < 8; ++q) { const float yr = acc[nbi][2 * q], yi = acc[nbi][2 * q + 1]; const f32x2 cs = tw[nbi][q]; \
          const int k1 = 16 * mb + 4 * (q >> 1) + 2 * hi + (q & 1); \
          Zs[k1 * ZST + t2] = (bf16_t)f2bf(yr * cs.x + yi * cs.y); Zs[(64 + k1) * ZST + t2] = (bf16_t)f2bf(yi * cs.x - yr * cs.y); } } \
      __syncthreads(); \
      OUT = f32x16{}; \
      _Pragma("unroll") for (int ks = 0; ks < 16; ++ks) { const bf16x8 bfr = *(const bf16x8*)(Zs + ((ks >> 3) * 64 + k1o) * ZST + (ks & 7) * 16 + 8 * hi); \
        OUT = __builtin_amdgcn_mfma_f32_32x32x16_bf16(a2[ks], bfr, OUT, 0, 0, 0); } } while (0)
#define FB_AT(col, k) (FB + ((size_t)((col) >> 3) * 8192 + (k)) * 8 + ((col) & 7))
  constexpr float SC = 1.0f / 2048.0f;
  for (int unit = blockIdx.x; unit < 256; unit += G) {
    const int g = unit >> 6, m0 = (unit & 63) * 4;
#pragma unroll
    for (int jp = 0; jp < 2; ++jp) { f32x16 ea, eb; const int me = m0 + 2 * jp, col = g * 512 + me;
      FFT_COLUMN(unit * 4 + 2 * jp, ea); FFT_COLUMN(unit * 4 + 2 * jp + 1, eb);
#pragma unroll
      for (int r = 0; r < 16; ++r) { const int k = k1o + 64 * (32 * mb + crow(r, hi)), kk = (8192 - k) & 8191; const float va = ea[r] * SC, vb = eb[r] * SC;
        *(unsigned*)FB_AT(col, k) = pk2(va, vb);
        if (me > 0) *FB_AT(g * 512 + 512 - me, kk) = (bf16_t)f2bf(va);
        *FB_AT(g * 512 + 511 - me, kk) = (bf16_t)f2bf(vb); } }
    if (unit < 4) { f32x16 en;
      FFT_COLUMN(1024 + unit, en);
#pragma unroll
      for (int r = 0; r < 16; ++r) { const int k = k1o + 64 * (32 * mb + crow(r, hi)); *FB_AT(unit * 512 + 256, k) = (bf16_t)f2bf(en[r] * SC); } }
  }
#undef FFT_COLUMN
#undef FB_AT
  __syncthreads();
}
}

struct Args {
    const float *x, *c, *ctx, *c_ctx, *w_mod, *b_mod, *g_mix, *g_ffn, *w_in, *w_out, *lq1, *lk1, *lq2, *lk2, *g_subln, *ln_g, *ln_b, *w_sp, *b_sp, *w_fo, *w_r, *w_gate, *w_up, *w_down, *g_final;
    float* out; unsigned char* ws; int lo, hi;
};


struct Ctx {
    const LAS unsigned long long* PT;
    __device__ __forceinline__ const void* ld(int i) const { const unsigned long long v = PT[i]; const unsigned l = __builtin_amdgcn_readfirstlane((unsigned)v), h = __builtin_amdgcn_readfirstlane((unsigned)(v >> 32));
        return (const void*)(const GAS void*)(((unsigned long long)h << 32) | l); }
    __device__ __forceinline__ const float* x() const { return (const float*)ld(0); }
    __device__ __forceinline__ const float* c() const { return (const float*)ld(1); }
    __device__ __forceinline__ const float* ctx() const { return (const float*)ld(2); }
    __device__ __forceinline__ const float* c_ctx() const { return (const float*)ld(3); }
    __device__ __forceinline__ const float* w_mod() const { return (const float*)ld(4); }
    __device__ __forceinline__ const float* b_mod() const { return (const float*)ld(5); }
    __device__ __forceinline__ const float* g_mix() const { return (const float*)ld(6); }
    __device__ __forceinline__ const float* g_ffn() const { return (const float*)ld(7); }
    __device__ __forceinline__ const float* w_in() const { return (const float*)ld(8); }
    __device__ __forceinline__ const float* w_out() const { return (const float*)ld(9); }
    __device__ __forceinline__ const float* lq1() const { return (const float*)ld(10); }
    __device__ __forceinline__ const float* lk1() const { return (const float*)ld(11); }
    __device__ __forceinline__ const float* lq2() const { return (const float*)ld(12); }
    __device__ __forceinline__ const float* lk2() const { return (const float*)ld(13); }
    __device__ __forceinline__ const float* g_subln() const { return (const float*)ld(14); }
    __device__ __forceinline__ const float* ln_g() const { return (const float*)ld(15); }
    __device__ __forceinline__ const float* ln_b() const { return (const float*)ld(16); }
    __device__ __forceinline__ const float* w_sp() const { return (const float*)ld(17); }
    __device__ __forceinline__ const float* b_sp() const { return (const float*)ld(18); }
    __device__ __forceinline__ const float* w_fo() const { return (const float*)ld(19); }
    __device__ __forceinline__ const float* w_r() const { return (const float*)ld(20); }
    __device__ __forceinline__ const float* w_gate() const { return (const float*)ld(21); }
    __device__ __forceinline__ const float* w_up() const { return (const float*)ld(22); }
    __device__ __forceinline__ const float* w_down() const { return (const float*)ld(23); }
    __device__ __forceinline__ const float* g_final() const { return (const float*)ld(24); }
    __device__ __forceinline__ float* out() const { return (float*)ld(25); }
    __device__ __forceinline__ unsigned char* ws() const { return (unsigned char*)ld(26); }
};

__device__ __forceinline__ void transpose_item(const float* W, int K, int N, bf16_t* WT, int row_off, int ilv, LAS float* scr, int item, int lane) {
    const int nblk = N / 32, kb = item / nblk, nb = item % nblk, k0 = 64 * kb, n0 = 32 * nb;
#pragma unroll 8
    for (int i = 0; i < 32; ++i) { const int kk = 2 * i + (lane >> 5); scr[kk * 33 + (lane & 31)] = __builtin_nontemporal_load(W + (size_t)(k0 + kk) * N + n0 + (lane & 31)); }
    asm volatile("s_waitcnt lgkmcnt(0)" ::: "memory");
    const int c = lane & 7;
#pragma unroll
    for (int j = 0; j < 4; ++j) { const int n = (lane >> 3) + 8 * j; const LAS float* s = scr + (8 * c) * 33 + n;
        u32x4 o; o.x = pk2(s[0 * 33], s[1 * 33]); o.y = pk2(s[2 * 33], s[3 * 33]); o.z = pk2(s[4 * 33], s[5 * 33]); o.w = pk2(s[6 * 33], s[7 * 33]);
        const int ng = n0 + n, drow = row_off + (ilv ? ((ng >> 7) * 256 + (ng & 127)) : ng);
        *(u32x4*)(WT + (size_t)drow * K + k0 + 8 * c) = o; }
    asm volatile("s_waitcnt lgkmcnt(0)" ::: "memory");
}
struct CvtItem { const float* src; bf16_t* dst; int N, K, row_off, ilv, k0, n0; };
__device__ __forceinline__ void cvt_load(const CvtItem& d, f32x4 (&v)[8], int lane) {
    const float* p = d.src + (size_t)(d.k0 + (lane >> 3)) * d.N + d.n0 + (lane & 7) * 4;
#pragma unroll
    for (int q = 0; q < 8; ++q) v[q] = __builtin_nontemporal_load((const f32x4*)(p + (size_t)(8 * q) * d.N));
}
__device__ __forceinline__ void cvt_store(const CvtItem& d, const f32x4 (&v)[8], LAS float* scr, int lane) {
    const int rr = lane >> 3, c4 = (lane & 7) * 4;
#pragma unroll
    for (int q = 0; q < 8; ++q) { LAS float* t = scr + (8 * q + rr) * 33 + c4; t[0] = v[q].x; t[1] = v[q].y; t[2] = v[q].z; t[3] = v[q].w; }
    asm volatile("s_waitcnt lgkmcnt(0)" ::: "memory");
    const int c = lane & 7;
#pragma unroll
    for (int j = 0; j < 4; ++j) { const int n = (lane >> 3) + 8 * j; const LAS float* s = scr + (8 * c) * 33 + n;
        u32x4 o; o.x = pk2(s[0 * 33], s[1 * 33]); o.y = pk2(s[2 * 33], s[3 * 33]); o.z = pk2(s[4 * 33], s[5 * 33]); o.w = pk2(s[6 * 33], s[7 * 33]);
        const int ng = d.n0 + n, drow = d.row_off + (d.ilv ? ((ng >> 7) * 256 + (ng & 127)) : ng);
        __builtin_nontemporal_store(o, (u32x4*)(d.dst + (size_t)drow * d.K + d.k0 + 8 * c)); }
    asm volatile("s_waitcnt lgkmcnt(0)" ::: "memory");
}
constexpr int MOE_ITEMS = NE * (2 * (DM / 64) * (FE / 32) + (FE / 64) * (DM / 32));
__device__ __forceinline__ void convert_moe_items(const Ctx& a, int layer, LAS unsigned char* lds, int it0, int it1, int widx, int nw, int wave, int lane) {
    LAS float* scr = (LAS float*)(lds + wave * 16384);
    bf16_t* WGU = (bf16_t*)(a.ws() + WS_WGU + (size_t)layer * WGU_BYTES); bf16_t* WD = (bf16_t*)(a.ws() + WS_WD + (size_t)layer * WD_BYTES);
    constexpr int I_G = (DM / 64) * (FE / 32), I_D = (FE / 64) * (DM / 32);
    constexpr int PER_E = 2 * I_G + I_D;
    const float *wg = a.w_gate(), *wu = a.w_up(), *wd = a.w_down();
    auto decode = [&](int it) { CvtItem d; const int e = it / PER_E; int r = it % PER_E; const size_t eo = ((size_t)layer * NE + e) * (size_t)DM * FE;
        if (r < I_G)          { d.src = wg + eo; d.dst = WGU; d.N = FE; d.K = DM; d.row_off = e * 2048; d.ilv = 1; }
        else if (r < 2 * I_G) { r -= I_G; d.src = wu + eo; d.dst = WGU; d.N = FE; d.K = DM; d.row_off = e * 2048 + 128; d.ilv = 1; }
        else                  { r -= 2 * I_G; d.src = wd + eo; d.dst = WD; d.N = DM; d.K = FE; d.row_off = e * 2048; d.ilv = 0; }
        const int nblk = d.N / 32; d.k0 = 64 * (r / nblk); d.n0 = 32 * (r % nblk); return d; };
    int it = it0 + widx;
    if (it >= it1) return;
    f32x4 va[8], vb[8]; CvtItem da = decode(it), db = da; bool hb = (it + nw < it1);
    cvt_load(da, va, lane);
    if (hb) { db = decode(it + nw); cvt_load(db, vb, lane); }
    for (;;) {
        cvt_store(da, va, scr, lane);
        it += 2 * nw; const bool ha = (it < it1);
        if (ha) { da = decode(it); cvt_load(da, va, lane); }
        if (!hb) break;
        cvt_store(db, vb, scr, lane);
        hb = (it + nw < it1);
        if (hb) { db = decode(it + nw); cvt_load(db, vb, lane); }
        if (!ha) break;
    }
}
constexpr int L0_A = 12288, L0_B = 20480, L1_A = 49152;
__device__ __forceinline__ void p0_prologue(const Ctx& a, LAS unsigned char* lds, int G) {
    const int tid = threadIdx.x, lane = tid & 63, wave = __builtin_amdgcn_readfirstlane(tid >> 6);
    float* MODL = (float*)(a.ws() + WS_MODL); float* MODC = (float*)(a.ws() + WS_MODC);
    {
        LAS float* s_l = (LAS float*)lds; LAS float* s_c = s_l + 2048; LAS float* red = s_c + 2048;
        for (int k = tid; k < 2048; k += NTHR) { const float v = a.c()[k], w = a.c_ctx()[k]; s_l[k] = v / (1.0f + __expf(-v)); s_c[k] = w / (1.0f + __expf(-w)); }
        __syncthreads();
        const int cg = tid % 24, kg = tid / 24;
        for (int u = blockIdx.x; u < 256; u += G) {
            const int layer = u >> 7, n0 = (u & 127) * 96;
            f32x4 al = (f32x4){0.f, 0.f, 0.f, 0.f}, ac = al;
            if (kg < 21) {
                const float* W = a.w_mod() + (size_t)layer * DM * 12288 + n0 + 4 * cg;
#pragma unroll 8
                for (int k = kg; k < 2048; k += 21) { const f32x4 w = __builtin_nontemporal_load((const f32x4*)(W + (size_t)k * 12288)); al += s_l[k] * w; ac += s_c[k] * w; }
#pragma unroll
                for (int j = 0; j < 4; ++j) { red[(kg * 96 + 4 * cg + j) * 2] = al[j]; red[(kg * 96 + 4 * cg + j) * 2 + 1] = ac[j]; }
            }
            __syncthreads();
            if (tid < 96) { float sl = 0.f, sc = 0.f;
                for (int q = 0; q < 21; ++q) { sl += red[(q * 96 + tid) * 2]; sc += red[(q * 96 + tid) * 2 + 1]; }
                const float b = a.b_mod()[layer * 12288 + n0 + tid];
                MODL[layer * 12288 + n0 + tid] = sl + b;
                if (layer == 0 && n0 + tid < 4096) MODC[n0 + tid] = sc + b; }
            __syncthreads();
        }
    }
    {
        LAS float* tab = (LAS float*)lds;
        for (int j = tid; j < 8192; j += NTHR) tab[j] = cospif((float)j * (1.0f / 4096.0f));
        __syncthreads();
        const int gt = blockIdx.x * NTHR + tid, NT_ = G * NTHR;
        float* RC = (float*)(a.ws() + WS_ROPE); float* RS = RC + 128 * 16;
        for (int i = gt; i < 128 * 16; i += NT_) { const int pos = i >> 4, j = i & 15; const float inv = powf(10000.0f, -(float)j * (1.0f / 16.0f)); const float ang = (float)pos * inv; RC[i] = cosf(ang); RS[i] = sinf(ang); }
        bf16_t* CS = (bf16_t*)(a.ws() + WS_CS);
        for (int i = gt; i < 512 * 512; i += NT_) { const int r = i >> 9, d = i & 511, m = r >> 1, ri = r & 1; const int j = (((m * d) & 511) * 16 + (ri ? 2048 : 0)) & 8191; CS[i] = (bf16_t)f2bf(tab[j]); }
        bf16_t* A1 = (bf16_t*)(a.ws() + WS_A1);
        for (int i = gt; i < 128 * 128; i += NT_) { const int m1 = i >> 7, k = i & 127, k1 = m1 >> 1, rp = m1 & 1, ri = k >> 6, t1 = k & 63; int j = ((t1 * k1) & 63) * 128;
            if (rp == 0 && ri == 1) j -= 2048; if (rp == 1 && ri == 0) j += 2048; A1[i] = (bf16_t)f2bf(tab[j & 8191]); }
        bf16_t* A2 = (bf16_t*)(a.ws() + WS_A2);
        for (int i = gt; i < 128 * 256; i += NT_) { const int k2 = i >> 8, k = i & 255, ri = k >> 7, t2 = k & 127; int j = ((t2 * k2) & 127) * 64; if (ri) j -= 2048; A2[i] = (bf16_t)f2bf(tab[j & 8191]); }
        float* TW = (float*)(a.ws() + WS_TW);
        for (int i = gt; i < 64 * 128; i += NT_) { const int k1 = i >> 7, t2 = i & 127, j = t2 * k1; TW[2 * i] = tab[j]; TW[2 * i + 1] = tab[(j - 2048) & 8191]; }
        __syncthreads();
    }
    {
        const int gw = blockIdx.x * NWAVES + wave, NGW = G * NWAVES;
        LAS float* scr = (LAS float*)(lds + wave * 16384);
        constexpr int I_IN = (DM / 64) * (INC / 32), I_SQ = (DM / 64) * (DM / 32);
        for (int it = gw; it < I_IN + 2 * I_SQ; it += NGW) {
            int r = it;
            if (r < I_IN) { transpose_item(a.w_in(), DM, INC, (bf16_t*)(a.ws() + WS_WIN), 0, 0, scr, r, lane); continue; } r -= I_IN;
            if (r < I_SQ) { transpose_item(a.w_out(), DM, DM, (bf16_t*)(a.ws() + WS_WOUT), 0, 0, scr, r, lane); continue; } r -= I_SQ;
            transpose_item(a.w_fo(), DM, DM, (bf16_t*)(a.ws() + WS_WFO), 0, 0, scr, r, lane);
        }
        convert_moe_items(a, 0, lds, 0, L0_A, gw, NGW, wave, lane);
    }
}

__device__ __forceinline__ void norm_mod_row(const float* xrow, const float* gain, const float* shift, const float* scale, bf16_t* orow, int lane) {
    f32x4 v[8]; float ss = 0.f;
#pragma unroll
    for (int j = 0; j < 8; ++j) { v[j] = *(const f32x4*)(xrow + j * 256 + lane * 4); ss += (v[j].x * v[j].x + v[j].y * v[j].y) + (v[j].z * v[j].z + v[j].w * v[j].w); }
    const float rstd = 1.0f / sqrtf(wave_sum(ss) * (1.0f / DM) + EPS);
#pragma unroll
    for (int j = 0; j < 8; ++j) { const int c = j * 256 + lane * 4; const f32x4 g = *(const f32x4*)(gain + c), sh = *(const f32x4*)(shift + c), sc = *(const f32x4*)(scale + c);
        const f32x4 y = v[j] * rstd * g * (1.0f + sc) + sh;
        u32x2 w; w.x = pk2(y.x, y.y); w.y = pk2(y.z, y.w); *(u32x2*)(orow + c) = w; }
}

__device__ __forceinline__ void router_phase(const Ctx& a, int layer, LAS unsigned char* lds, int G) {
    const int tid = threadIdx.x, lane = tid & 63, wave = __builtin_amdgcn_readfirstlane(tid >> 6);
    constexpr int ROWB = 4112;
    LAS unsigned char* XT = lds; LAS float* RS = (LAS float*)(lds + 32 * ROWB); LAS float* PART = (LAS float*)lds;
    const _Float16* X = (const _Float16*)(a.ws() + WS_X); bf16_t* H2 = (bf16_t*)(a.ws() + WS_H2); float* AFF = (float*)(a.ws() + WS_AFF);
    const float* mod = (const float*)(a.ws() + WS_MODL) + layer * 12288; const float* gain = a.g_ffn() + layer * DM;
    const int m = lane & 15, kq = lane >> 4;
    int unit = blockIdx.x;
    f16x4 nx[8];
    if (unit < SEQ / 32) {
#pragma unroll
        for (int j = 0; j < 8; ++j) nx[j] = *(const f16x4*)(X + (size_t)(unit * 32 + wave * 4) * DM + j * 256 + lane * 4); }
    f32x4 ca[8], cb[8];
#pragma unroll
    for (int j = 0; j < 8; ++j) { const int c = j * 256 + lane * 4; ca[j] = *(const f32x4*)(gain + c) * (1.0f + *(const f32x4*)(mod + 4 * DM + c)); cb[j] = *(const f32x4*)(mod + 3 * DM + c); }
    f16x8 bh[8], bl[8];
    { const f16x8* WRP = (const f16x8*)(a.ws() + WS_WRP) + (size_t)layer * 2 * 4096 + wave * 512 + lane;
#pragma unroll
      for (int s = 0; s < 8; ++s) { bh[s] = WRP[s * 64]; bl[s] = WRP[4096 + s * 64]; } }
    const float bias = ((const float*)(a.ws() + WS_WRB))[layer * 16 + m];
    for (; unit < SEQ / 32; unit += G) {
        const int r0 = unit * 32 + wave * 4;
#pragma unroll 1
        for (int i = 0; i < 4; ++i) {
            const int row = r0 + i; f32x4 v[8]; float ss = 0.f;
            LAS unsigned char* xt = XT + (wave * 4 + i) * ROWB + lane * 8;
#pragma unroll
            for (int j = 0; j < 8; ++j) { *(LAS f16x4*)(xt + j * 512) = nx[j]; v[j] = __builtin_convertvector(nx[j], f32x4);
                ss += (v[j].x * v[j].x + v[j].y * v[j].y) + (v[j].z * v[j].z + v[j].w * v[j].w); }
            { const int nrow = (i < 3) ? row + 1 : (unit + G) * 32 + wave * 4;
              if (nrow < SEQ) {
#pragma unroll
                for (int j = 0; j < 8; ++j) nx[j] = *(const f16x4*)(X + (size_t)nrow * DM + j * 256 + lane * 4); } }
            asm volatile("" ::: "memory");
            const float rstd = 1.0f / sqrtf(wave_sum(ss) * (1.0f / DM) + EPS);
            if (lane == 0) RS[wave * 4 + i] = rstd;
#pragma unroll
            for (int j = 0; j < 8; ++j) { const int c = j * 256 + lane * 4;
                const f32x4 h = v[j] * rstd * ca[j] + cb[j];
                u32x2 w; w.x = pk2(h.x, h.y); w.y = pk2(h.z, h.w); *(u32x2*)(H2 + (size_t)row * DM + c) = w; }
        }
        __syncthreads();
        f32x4 acc0 = {0.f, 0.f, 0.f, 0.f}, acc1 = {0.f, 0.f, 0.f, 0.f};
        { const LAS unsigned char* ap = XT + m * ROWB + (wave * 256 + kq * 8) * 2;
#pragma unroll
          for (int s = 0; s < 8; ++s) { const f16x8 a0 = *(const LAS f16x8*)(ap + s * 64), a1 = *(const LAS f16x8*)(ap + 16 * ROWB + s * 64);
            acc0 = __builtin_amdgcn_mfma_f32_16x16x32_f16(a0, bh[s], acc0, 0, 0, 0); acc0 = __builtin_amdgcn_mfma_f32_16x16x32_f16(a0, bl[s], acc0, 0, 0, 0);
            acc1 = __builtin_amdgcn_mfma_f32_16x16x32_f16(a1, bh[s], acc1, 0, 0, 0); acc1 = __builtin_amdgcn_mfma_f32_16x16x32_f16(a1, bl[s], acc1, 0, 0, 0); } }
        __syncthreads();
        *(LAS f32x4*)(PART + ((wave * 2 + 0) * 64 + lane) * 4) = acc0; *(LAS f32x4*)(PART + ((wave * 2 + 1) * 64 + lane) * 4) = acc1;
        __syncthreads();
        { const int mt = wave >> 2, r = wave & 3; float sum = 0.f;
#pragma unroll
          for (int w = 0; w < 8; ++w) sum += PART[((w * 2 + mt) * 64 + lane) * 4 + r];
          const int lr = 16 * mt + 4 * kq + r;
          const float lg = sum * (RS[lr] * (1.0f / 64.0f)) + bias;
          float mx = lg; mx = fmaxf(mx, dpp_f(mx, 0)); mx = fmaxf(mx, dpp_f(mx, 1)); mx = fmaxf(mx, dpp_f(mx, 2)); mx = fmaxf(mx, dpp_f(mx, 3));
          const float pe = expf(lg - mx); float sm = pe; sm += dpp_f(sm, 0); sm += dpp_f(sm, 1); sm += dpp_f(sm, 2); sm += dpp_f(sm, 3);
          AFF[(size_t)m * SEQ + unit * 32 + lr] = pe * (1.0f / sm); }
        __syncthreads();
    }
}

__device__ __forceinline__ void topk_expert(const Ctx& a, int e, LAS unsigned char* lds) {
    const int tid = threadIdx.x, lane = tid & 63;
    LAS unsigned* hist = (LAS unsigned*)lds; LAS unsigned* bc = hist + 256; LAS unsigned* cg = bc + 16; LAS unsigned* ce = cg + 512;
    const float* aff = (const float*)(a.ws() + WS_AFF) + (size_t)e * SEQ;
    int* IDX = (int*)(a.ws() + WS_IDX) + e * CAP; float* GATE = (float*)(a.ws() + WS_GATE) + e * CAP; int* POS = (int*)(a.ws() + WS_POS) + (size_t)e * SEQ;
    unsigned key[16];
#pragma unroll
    for (int j = 0; j < 4; ++j) { const u32x4 v = *(const u32x4*)(aff + tid * 16 + j * 4); key[4 * j] = v.x; key[4 * j + 1] = v.y; key[4 * j + 2] = v.z; key[4 * j + 3] = v.w; }
    unsigned prefix = 0u, mask = 0u, remaining = CAP;
    for (int pass = 0; pass < 4; ++pass) {
        const int shift = 24 - 8 * pass;
        if (tid < 256) hist[tid] = 0u;
        __syncthreads();
#pragma unroll
        for (int j = 0; j < 16; ++j) if ((key[j] & mask) == prefix) __hip_atomic_fetch_add(&hist[(key[j] >> shift) & 255u], 1u, __ATOMIC_RELAXED, __HIP_MEMORY_SCOPE_WORKGROUP);
        __syncthreads();
        if (tid < 64) {
            const unsigned h0 = hist[255 - 4 * lane], h1 = hist[254 - 4 * lane], h2 = hist[253 - 4 * lane], h3 = hist[252 - 4 * lane];
            const unsigned s = h0 + h1 + h2 + h3; unsigned inc = s;
#pragma unroll
            for (int o = 1; o < 64; o <<= 1) { const unsigned v = __shfl_up(inc, o); if (lane >= o) inc += v; }
            const unsigned exc = inc - s;
            if (exc < remaining && remaining <= inc) {
                unsigned c = exc; unsigned b;
                if (c + h0 >= remaining) b = 255 - 4 * lane;
                else { c += h0; if (c + h1 >= remaining) b = 254 - 4 * lane; else { c += h1; if (c + h2 >= remaining) b = 253 - 4 * lane; else { c += h2; b = 252 - 4 * lane; } } }
                bc[0] = b; bc[1] = remaining - c;
            }
        }
        __syncthreads();
        prefix |= bc[0] << shift; mask |= 255u << shift; remaining = bc[1];
        __syncthreads();
    }
    const unsigned T = prefix, need = remaining;
    unsigned ngt = 0u, neq = 0u;
#pragma unroll
    for (int j = 0; j < 16; ++j) { ngt += key[j] > T ? 1u : 0u; neq += key[j] == T ? 1u : 0u; }
    cg[tid] = ngt; ce[tid] = neq;
    __syncthreads();
    if (tid < 64) {
        unsigned av[8], bv[8], sa = 0u, sb = 0u;
#pragma unroll
        for (int q = 0; q < 8; ++q) { av[q] = cg[lane * 8 + q]; bv[q] = ce[lane * 8 + q]; sa += av[q]; sb += bv[q]; }
        unsigned ia = sa, ib = sb;
#pragma unroll
        for (int o = 1; o < 64; o <<= 1) { const unsigned va = __shfl_up(ia, o), vb = __shfl_up(ib, o); if (lane >= o) { ia += va; ib += vb; } }
        unsigned ea = ia - sa, eb = ib - sb;
#pragma unroll
        for (int q = 0; q < 8; ++q) { cg[lane * 8 + q] = ea; ea += av[q]; ce[lane * 8 + q] = eb; eb += bv[q]; }
        if (lane == 63) bc[2] = ia;
    }
    __syncthreads();
    unsigned og = cg[tid], oe = ce[tid]; const unsigned tg = bc[2];
#pragma unroll
    for (int j = 0; j < 16; ++j) { const int token = tid * 16 + j; int slot = -1;
        if (key[j] > T) slot = (int)(og++);
        else if (key[j] == T) { if (oe < need) slot = (int)(tg + oe); ++oe; }
        POS[token] = slot;
        if (slot >= 0) { IDX[slot] = token; GATE[slot] = __uint_as_float(key[j]); } }
    __syncthreads();
}

__device__ __forceinline__ void combine_phase(const Ctx& a, int layer, int G) {
    const int tid = threadIdx.x, lane = tid & 63, wave = __builtin_amdgcn_readfirstlane(tid >> 6);
    _Float16* X = (_Float16*)(a.ws() + WS_X); const bf16_t* Y = (const bf16_t*)(a.ws() + WS_Y); const int* POS = (const int*)(a.ws() + WS_POS);
    const float* modl = (const float*)(a.ws() + WS_MODL);
    const float* gf = modl + layer * 12288 + 5 * DM;
    const int gw = blockIdx.x * NWAVES + wave, NGW = G * NWAVES;
    int pl = (lane < NE && gw < SEQ) ? POS[(size_t)lane * SEQ + gw] : -1;
    f16x4 nx[8];
    if (gw < SEQ) {
#pragma unroll
        for (int j = 0; j < 8; ++j) nx[j] = *(const f16x4*)(X + (size_t)gw * DM + j * 256 + lane * 4); }
    for (int row = gw; row < SEQ; row += NGW) {
        _Float16* xr = X + (size_t)row * DM; f32x4 v[8], sum[8];
        const int plc = pl; unsigned long long sel = __ballot(plc >= 0);
        u32x2 w[8]; const bool any = sel != 0ull;
        if (any) { const int e = __builtin_ctzll(sel); sel &= sel - 1; const int p = __builtin_amdgcn_readlane(plc, e);
            const bf16_t* y = Y + (size_t)(e * CAP + p) * DM + lane * 4;
#pragma unroll
            for (int j = 0; j < 8; ++j) w[j] = *(const u32x2*)(y + j * 256); }
#pragma unroll
        for (int j = 0; j < 8; ++j) { v[j] = __builtin_convertvector(nx[j], f32x4); sum[j] = (f32x4){0.f, 0.f, 0.f, 0.f}; }
        if (row + NGW < SEQ) { const int nr = row + NGW;
            pl = (lane < NE) ? POS[(size_t)lane * SEQ + nr] : -1;
#pragma unroll
            for (int j = 0; j < 8; ++j) nx[j] = *(const f16x4*)(X + (size_t)nr * DM + j * 256 + lane * 4); }
        asm volatile("" ::: "memory");
        if (any) {
#pragma unroll
            for (int j = 0; j < 8; ++j) sum[j] += (f32x4){bflo(w[j].x), bfhi(w[j].x), bflo(w[j].y), bfhi(w[j].y)}; }
        while (sel) { const int e = __builtin_ctzll(sel); sel &= sel - 1; const int p = __builtin_amdgcn_readlane(plc, e);
            const bf16_t* y = Y + (size_t)(e * CAP + p) * DM + lane * 4;
#pragma unroll
            for (int j = 0; j < 8; ++j) w[j] = *(const u32x2*)(y + j * 256);
#pragma unroll
            for (int j = 0; j < 8; ++j) sum[j] += (f32x4){bflo(w[j].x), bfhi(w[j].x), bflo(w[j].y), bfhi(w[j].y)}; }
        float ss = 0.f;
#pragma unroll
        for (int j = 0; j < 8; ++j) { const int c = j * 256 + lane * 4; v[j] = v[j] + *(const f32x4*)(gf + c) * sum[j];
            ss += (v[j].x * v[j].x + v[j].y * v[j].y) + (v[j].z * v[j].z + v[j].w * v[j].w); }
        const float rstd = 1.0f / sqrtf(wave_sum(ss) * (1.0f / DM) + EPS);
        if (layer == 0) {
            bf16_t* orow = (bf16_t*)(a.ws() + WS_HCAT) + (size_t)row * DM; const float* m1 = modl + 12288; const float* gain = a.g_mix() + DM;
            float nyq[4] = {0.f, 0.f, 0.f, 0.f};
#pragma unroll
            for (int j = 0; j < 8; ++j) { const int c = j * 256 + lane * 4; stx4(xr + c, v[j]);
                const f32x4 y = v[j] * rstd * *(const f32x4*)(gain + c) * (1.0f + *(const f32x4*)(m1 + DM + c)) + *(const f32x4*)(m1 + c);
                u32x2 w; w.x = pk2(y.x, y.y); w.y = pk2(y.z, y.w); *(u32x2*)(orow + c) = w;
                nyq[j >> 1] += (bflo(w.x) - bfhi(w.x)) + (bflo(w.y) - bfhi(w.y)); }
            { bf16_t* WCT = (bf16_t*)(a.ws() + WS_WCT); const int n = (row & 127) * 64 + (row >> 7);
                float mine = 0.f;
#pragma unroll
                for (int g = 0; g < 4; ++g) { const float sg = wave_sum(nyq[g]); mine = (lane == g) ? sg : mine; }
                if (lane < 4) { WCT[(size_t)(2048 + 2 * lane) * 8192 + n] = (bf16_t)f2bf(mine); WCT[(size_t)(2049 + 2 * lane) * 8192 + n] = 0; } }
        } else {
            float* orow = a.out() + (size_t)row * DM;
#pragma unroll
            for (int j = 0; j < 8; ++j) { const int c = j * 256 + lane * 4; *(f32x4*)(orow + c) = v[j] * rstd * *(const f32x4*)(a.g_final() + c); }
        }
    }
}

#define PHASE_FN static __device__ __forceinline__ void
#define PH_PRO extern __shared__ __attribute__((aligned(16))) unsigned char lds_raw[]; LAS unsigned char* lds = (LAS unsigned char*)lds_raw; (void)lds; \
    const int tid = threadIdx.x, lane = tid & 63, wave = __builtin_amdgcn_readfirstlane(tid >> 6), G = gridDim.x; (void)lane; (void)wave; \
    Ctx a; a.PT = (const LAS unsigned long long*)(lds + LDSCTL_OFF + 64); const int gw = blockIdx.x * NWAVES + wave, NGW = G * NWAVES; (void)gw; (void)NGW;

PHASE_FN ph_prologue() { PH_PRO; p0_prologue(a, lds, G); }
PHASE_FN ph_hcat() { PH_PRO;
    const float* MODL = (const float*)(a.ws() + WS_MODL); const float* MODC = (const float*)(a.ws() + WS_MODC); bf16_t* HCAT = (bf16_t*)(a.ws() + WS_HCAT);
    const float* ctx = a.ctx(); const float* x = a.x(); const float* gm = a.g_mix();
    f32x4 nx[8];
    if (gw < SEQ) {
#pragma unroll
        for (int j = 0; j < 8; ++j) nx[j] = *(const f32x4*)(x + (size_t)gw * DM + j * 256 + lane * 4); }
    f32x4 ca[8], cb[8];
#pragma unroll
    for (int j = 0; j < 8; ++j) { const int c = j * 256 + lane * 4; ca[j] = *(const f32x4*)(gm + c) * (1.0f + *(const f32x4*)(MODL + DM + c)); cb[j] = *(const f32x4*)(MODL + c); }
    for (int row = gw; row < SEQ; row += NGW) {
        f32x4 v[8]; float ss = 0.f;
#pragma unroll
        for (int j = 0; j < 8; ++j) { v[j] = nx[j]; ss += (v[j].x * v[j].x + v[j].y * v[j].y) + (v[j].z * v[j].z + v[j].w * v[j].w); }
        if (row + NGW < SEQ) {
#pragma unroll
            for (int j = 0; j < 8; ++j) nx[j] = *(const f32x4*)(x + (size_t)(row + NGW) * DM + j * 256 + lane * 4); }
        asm volatile("" ::: "memory");
        const float rstd = 1.0f / sqrtf(wave_sum(ss) * (1.0f / DM) + EPS);
        bf16_t* orow = HCAT + (size_t)(CTXL + row) * DM;
#pragma unroll
        for (int j = 0; j < 8; ++j) { const int c = j * 256 + lane * 4; const f32x4 y = v[j] * rstd * ca[j] + cb[j];
            u32x2 w; w.x = pk2(y.x, y.y); w.y = pk2(y.z, y.w); *(u32x2*)(orow + c) = w; }
    }
    if (wave == 0) for (int r = blockIdx.x; r < CTXL; r += G) norm_mod_row(ctx + (size_t)r * DM, gm, MODC, MODC + DM, HCAT + (size_t)r * DM, lane);
    for (int it = blockIdx.x * NTHR + tid; it < 2 * 4096; it += G * NTHR) { const int layer = it >> 12, kc = (it >> 4) & 255, n = it & 15;
        const float* w_r = a.w_r() + (size_t)layer * DM * NE; const float* gain = a.g_ffn() + layer * DM; const float* sc = MODL + layer * 12288 + 4 * DM;
        f16x8 hi, lo;
#pragma unroll
        for (int i = 0; i < 8; ++i) { const int c = kc * 8 + i; const float wv = 64.0f * gain[c] * (1.0f + sc[c]) * w_r[c * NE + n];
            const _Float16 h = (_Float16)wv; hi[i] = h; lo[i] = (_Float16)(wv - (float)h); }
        f16x8* WRP = (f16x8*)(a.ws() + WS_WRP) + (size_t)layer * 2 * 4096;
        WRP[kc * 16 + n] = hi; WRP[4096 + kc * 16 + n] = lo; }
    if (gw >= NGW - 32) { const int q = gw - (NGW - 32), layer = q >> 4, e = q & 15;
        const float* w_r = a.w_r() + (size_t)layer * DM * NE; const float* sh = MODL + layer * 12288 + 3 * DM; float acc = 0.f;
#pragma unroll 8
        for (int i = 0; i < 32; ++i) { const int c = lane + 64 * i; acc = fmaf(sh[c], w_r[c * NE + e], acc); }
        acc = wave_sum(acc);
        if (lane == 0) ((float*)(a.ws() + WS_WRB))[q] = acc; }
}
PHASE_FN ph_win() { PH_PRO;
    unsigned char* ws = a.ws();
    const pg8::Geo g = pg8::geo_rowmajor(ws + WS_HCAT, DM, ws + WS_WIN, DM, DM);
    pg8::WinOrder S; S.init_win(G, (int)blockIdx.x);
    pg8::EpiWin E{(bf16_t*)(ws + WS_Q), (bf16_t*)(ws + WS_K), (bf16_t*)(ws + WS_V), (bf16_t*)(ws + WS_UV), (const float*)(ws + WS_ROPE), (const float*)(ws + WS_ROPE) + 128 * 16};
    pg8::gemm_phase<pg8::EpiWin, pg8::WinOrder, true, true>(lds, g, S, E);
    { const int nu = S.total(), maxu = (nu + G - 1) / G, nfull = nu - (maxu - 1) * G;
      if ((int)blockIdx.x >= nfull && nfull < G) convert_moe_items(a, 0, lds, L0_B, MOE_ITEMS, ((int)blockIdx.x - nfull) * NWAVES + wave, (G - nfull) * NWAVES, wave, lane);
      else if (nfull >= G) convert_moe_items(a, 0, lds, L0_B, MOE_ITEMS, gw, NGW, wave, lane); }
}
PHASE_FN ph_attn() { PH_PRO;
    unsigned char* ws = a.ws();
    float lam;
    { const float q1 = a.lq1()[lane] * a.lk1()[lane], q2 = a.lq2()[lane] * a.lk2()[lane]; lam = expf(wave_sum(q1)) - expf(wave_sum(q2)) + 0.2f; }
    const float* gs = a.g_subln();
    for (int i = blockIdx.x; i < 512; i += G)
        att2::attn_unit<8>((const bf16_t*)(ws + WS_Q), (const bf16_t*)(ws + WS_K), (const bf16_t*)(ws + WS_V), (bf16_t*)(ws + WS_CAT), i & 7, i >> 3, lam, 0.8f, gs, lds);
}
PHASE_FN ph_sgu() { PH_PRO;
    unsigned char* ws = a.ws();
    const float *w_sp = a.w_sp(), *b_sp = a.b_sp(), *ln_g = a.ln_g(), *ln_b = a.ln_b();
    for (int i = blockIdx.x; i < 512; i += G)
        att::sgu_unit((const bf16_t*)(ws + WS_UV), (bf16_t*)(ws + WS_CAT), w_sp, b_sp, ln_g, ln_b, i >> 3, i & 7, (char*)lds_raw);
}
PHASE_FN ph_wout() { PH_PRO;
    unsigned char* ws = a.ws();
    const int GH = (G >= 2) ? G / 2 : G;
    if ((int)blockIdx.x < GH) {
        const pg8::Geo g = pg8::geo_rowmajor(ws + WS_CAT, DM, ws + WS_WOUT, DM, DM);
        pg8::StaticOrder S; S.init(SEQ, DM, GH, (int)blockIdx.x);
        pg8::EpiResid<true> E{a.x(), (_Float16*)(ws + WS_X), (const float*)(ws + WS_MODL) + 2 * DM};
        pg8::gemm_phase<pg8::EpiResid<true>, pg8::StaticOrder, true, true>(lds, g, S, E);
        if (GH == G) convert_moe_items(a, 1, lds, 0, L1_A, gw, NGW, wave, lane);
    } else convert_moe_items(a, 1, lds, 0, L1_A, ((int)blockIdx.x - GH) * NWAVES + wave, (G - GH) * NWAVES, wave, lane);
}
PHASE_FN ph_stepa() { PH_PRO;
    unsigned char* ws = a.ws();
    pg8::Geo g = pg8::geo_rowmajor(ws + WS_CS, 512, ws + WS_HCAT, DM, 512);
    g.aB = 1024;
    g.bmode = 1; g.hB = (size_t)2 * g.ldb2; g.tB = (size_t)4 * g.ldb2;
    pg8::StepAOrder S{G, (int)blockIdx.x};
    pg8::EpiBf16 E{(bf16_t*)(ws + WS_WCT), SEQ, 512};
    pg8::gemm_phase<pg8::EpiBf16, pg8::StepAOrder, true, true>(lds, g, S, E);
}
PHASE_FN ph_dft() { PH_PRO;
    unsigned char* ws = a.ws();
    fft::fft_phase((const bf16_t*)(ws + WS_WCT), (bf16_t*)(ws + WS_F), (const bf16_t*)(ws + WS_A1), (const bf16_t*)(ws + WS_A2), (const float*)(ws + WS_TW), (char*)lds_raw, G);
}
PHASE_FN ph_wfo() { PH_PRO;
    unsigned char* ws = a.ws();
    pg8::Geo g = pg8::geo_rowmajor(ws + WS_F, DM, ws + WS_WFO, DM, DM);
    g.amode = 1; g.kA = 8 * 131072; g.hA = 2048; g.tA = 4096;
    pg8::StaticOrder S; S.init(SEQ, DM, G, (int)blockIdx.x);
    pg8::EpiResid<false> E{(const void*)(ws + WS_X), (_Float16*)(ws + WS_X), (const float*)(ws + WS_MODL) + 12288 + 2 * DM};
    pg8::gemm_phase<pg8::EpiResid<false>, pg8::StaticOrder, true, true>(lds, g, S, E);
}
PHASE_FN ph_router(int layer) { PH_PRO; router_phase(a, layer, lds, G); }
PHASE_FN ph_topk(int layer) { PH_PRO; for (int e = blockIdx.x; e < NE; e += G) topk_expert(a, e, lds);
    if ((int)blockIdx.x >= NE || G <= NE) { const int widx = (G <= NE) ? gw : ((int)blockIdx.x - NE) * NWAVES + wave, nw = (G <= NE) ? NGW : (G - NE) * NWAVES;
        if (layer == 0) convert_moe_items(a, 0, lds, L0_A, L0_B, widx, nw, wave, lane); else convert_moe_items(a, 1, lds, L1_A, MOE_ITEMS, widx, nw, wave, lane); } }
PHASE_FN ph_gather() { PH_PRO;
    unsigned char* ws = a.ws();
    const int* IDX = (const int*)(ws + WS_IDX); const bf16_t* H2 = (const bf16_t*)(ws + WS_H2); bf16_t* XS = (bf16_t*)(ws + WS_XS);
    for (int r = gw; r < MR; r += NGW) { const int t = IDX[r]; const u32x4* s = (const u32x4*)(H2 + (size_t)t * DM) + lane; u32x4* d = (u32x4*)(XS + (size_t)r * DM) + lane;
#pragma unroll
        for (int j = 0; j < 4; ++j) d[64 * j] = s[64 * j]; }
}
PHASE_FN ph_gateup(int layer) { PH_PRO;
    unsigned char* ws = a.ws();
    pg8::Geo g = pg8::geo_rowmajor(ws + WS_H2, DM, ws + WS_WGU + (size_t)layer * WGU_BYTES, DM, DM);
    g.aB = (size_t)2048 * DM * 2; g.hA = 0; g.tA = 0;
    pg8::MoeOrder S; S.init(MR, 2048, G, (int)blockIdx.x);
    pg8::EpiGateUp E{(bf16_t*)(ws + WS_ACT)};
    pg8::gemm_phase<pg8::EpiGateUp, pg8::MoeOrder, true, true, true>(lds, g, S, E, (const int*)(ws + WS_IDX));
}
PHASE_FN ph_down(int layer) { PH_PRO;
    unsigned char* ws = a.ws();
    pg8::Geo g = pg8::geo_rowmajor(ws + WS_ACT, FE, ws + WS_WD + (size_t)layer * WD_BYTES, FE, FE);
    g.aB = (size_t)2048 * FE * 2;
    pg8::MoeOrder S; S.init(MR, DM, G, (int)blockIdx.x);
    pg8::EpiDown E{(bf16_t*)(ws + WS_Y), (const float*)(ws + WS_GATE)};
    pg8::gemm_phase<pg8::EpiDown, pg8::MoeOrder, true, true>(lds, g, S, E);
}
PHASE_FN ph_combine(int layer) { PH_PRO; combine_phase(a, layer, G); }

__global__ void __launch_bounds__(NTHR, 2) fwd(Args ka) {
    extern __shared__ __attribute__((aligned(16))) unsigned char lds_raw[];
    LAS unsigned char* lds = (LAS unsigned char*)lds_raw;
    const int tid = threadIdx.x;
    const int lo = ka.lo, hi = ka.hi;
    for (int u = tid; u < 16; u += NTHR) ((LAS unsigned*)(lds + LDSCTL_OFF))[u] = 0u;
    LAS unsigned long long* PTW = (LAS unsigned long long*)(lds + LDSCTL_OFF + 64);
    if (tid == 0) {
        PTW[0] = (unsigned long long)ka.x;
        PTW[1] = (unsigned long long)ka.c;
        PTW[2] = (unsigned long long)ka.ctx;
        PTW[3] = (unsigned long long)ka.c_ctx;
        PTW[4] = (unsigned long long)ka.w_mod;
        PTW[5] = (unsigned long long)ka.b_mod;
        PTW[6] = (unsigned long long)ka.g_mix;
        PTW[7] = (unsigned long long)ka.g_ffn;
        PTW[8] = (unsigned long long)ka.w_in;
        PTW[9] = (unsigned long long)ka.w_out;
        PTW[10] = (unsigned long long)ka.lq1;
        PTW[11] = (unsigned long long)ka.lk1;
        PTW[12] = (unsigned long long)ka.lq2;
        PTW[13] = (unsigned long long)ka.lk2;
        PTW[14] = (unsigned long long)ka.g_subln;
        PTW[15] = (unsigned long long)ka.ln_g;
        PTW[16] = (unsigned long long)ka.ln_b;
        PTW[17] = (unsigned long long)ka.w_sp;
        PTW[18] = (unsigned long long)ka.b_sp;
        PTW[19] = (unsigned long long)ka.w_fo;
        PTW[20] = (unsigned long long)ka.w_r;
        PTW[21] = (unsigned long long)ka.w_gate;
        PTW[22] = (unsigned long long)ka.w_up;
        PTW[23] = (unsigned long long)ka.w_down;
        PTW[24] = (unsigned long long)ka.g_final;
        PTW[25] = (unsigned long long)ka.out; PTW[26] = (unsigned long long)ka.ws;
    }
    __syncthreads();
    XcdBarrier bar; bar.bar = (unsigned*)(ka.ws + WS_CTL); bar.x = 0; bar.st = nullptr;
    if (hi - lo > 1) bar = xcd_barrier_post((unsigned*)(ka.ws + WS_CTL), (volatile LAS unsigned*)(lds + LDSCTL_OFF));
#ifndef PHMASK
#define PHMASK 0xFFFFFFu
#endif
#define IN(k) (((PHMASK >> ((k) == 21 ? 3 : (k) == 22 ? 10 : (k))) & 1u) && lo <= ((k) == 21 ? 3 : (k) == 22 ? 10 : (k)) && ((k) == 21 ? 3 : (k) == 22 ? 10 : (k)) < hi)
#define SEAM(k) do { if (IN(k) && IN((k) + 1)) xcd_barrier(bar); } while (0)
#ifndef PROBE_PH
#define PROBE_PH -1
#endif
#ifndef PROBE_N
#define PROBE_N 3
#endif
#define RUNPH(k, call) do { if (IN(k)) { for (int rp_ = 0; rp_ < ((PROBE_PH == (k)) ? PROBE_N : 1); ++rp_) { if (rp_) xcd_barrier(bar); call; } } } while (0)
    RUNPH(0, ph_prologue());             SEAM(0);
    RUNPH(1, ph_hcat());                 SEAM(1);
    RUNPH(2, ph_win());                  SEAM(2);
    RUNPH(3, ph_attn());                 RUNPH(21, ph_sgu()); SEAM(3);
    RUNPH(4, ph_wout());                 SEAM(4);
    RUNPH(5, ph_router(0));              SEAM(5);
    RUNPH(6, ph_topk(0));                if (IN(6) && IN(8)) xcd_barrier(bar);
    RUNPH(8, ph_gateup(0));              SEAM(8);
    RUNPH(9, ph_down(0));                SEAM(9);
    if (IN(10)) ph_combine(0);           SEAM(10);
    RUNPH(11, ph_stepa());               SEAM(11);
    RUNPH(12, ph_dft());                 SEAM(12);
    if (IN(13)) ph_wfo();                SEAM(13);
    RUNPH(14, ph_router(1));             SEAM(14);
    RUNPH(15, ph_topk(1));               if (IN(15) && IN(17)) xcd_barrier(bar);
    RUNPH(17, ph_gateup(1));             SEAM(17);
    RUNPH(18, ph_down(1));               SEAM(18);
    if (IN(19)) ph_combine(1);
#undef RUNPH
#undef IN
#undef SEAM
}

extern "C" void kernel_launch(void* const* d_in, const int* in_sizes, int n_in, void* d_out, int out_size, void* d_ws, size_t ws_size, hipStream_t stream) {
    static int grid = 0;
    if (grid == 0) {
        if (n_in != 25 || in_sizes[0] != SEQ * DM || out_size != SEQ * DM || ws_size < WS_END) {
            fprintf(stderr, "kernel_launch: unexpected shapes: n_in %d in0 %d out %d ws %zu (need %zu)\n", n_in, n_in > 0 ? in_sizes[0] : -1, out_size, ws_size, (size_t)WS_END); grid = -1; return; }
        int dev = 0, cus = 0, per_cu = 0;
        if (hipGetDevice(&dev) != hipSuccess || hipDeviceGetAttribute(&cus, hipDeviceAttributeMultiprocessorCount, dev) != hipSuccess) { grid = -1; return; }
        if (hipFuncSetAttribute((const void*)fwd, hipFuncAttributeMaxDynamicSharedMemorySize, LDS_BYTES) != hipSuccess) { fprintf(stderr, "kernel_launch: hipFuncSetAttribute failed\n"); grid = -1; return; }
        if (hipOccupancyMaxActiveBlocksPerMultiprocessor(&per_cu, (const void*)fwd, NTHR, LDS_BYTES) != hipSuccess || per_cu < 1) fprintf(stderr, "kernel_launch: occupancy query says %d\n", per_cu);
        (void)hipGetLastError();
        grid = cus;
    }
    if (grid < 0) return;
    (void)hipMemsetAsync((char*)d_ws + WS_CTL, 0, CTL_BYTES, stream);
    Args a{};
    const float** p = (const float**)&a;
    for (int i = 0; i < 25; ++i) p[i] = (const float*)d_in[i];
    a.out = (float*)d_out; a.ws = (unsigned char*)d_ws;
#ifndef ONE_LAUNCH
    for (int ph = 0; ph < NPH; ++ph) { a.lo = ph; a.hi = ph + 1; hipLaunchKernelGGL(fwd, dim3(grid), dim3(NTHR), LDS_BYTES, stream, a); }
#else
    a.lo = 0; a.hi = NPH; hipLaunchKernelGGL(fwd, dim3(grid), dim3(NTHR), LDS_BYTES, stream, a);
#endif
    const hipError_t le = hipPeekAtLastError();
    if (le != hipSuccess) fprintf(stderr, "kernel_launch: launch failed: %s\n", hipGetErrorName(le));
}
```

```cpp
#include <hip/hip_runtime.h>
#include <hip/hip_bf16.h>
#include <cstdio>
#include <cstdint>
#define ONE_LAUNCH 1

#define GAS __attribute__((address_space(1)))
#define LAS __attribute__((address_space(3)))
typedef unsigned short bf16_t;
typedef short bf16x8 __attribute__((ext_vector_type(8)));
typedef short s16x4 __attribute__((ext_vector_type(4)));
typedef float f32x2 __attribute__((ext_vector_type(2)));
typedef float f32x4 __attribute__((ext_vector_type(4)));
typedef float f32x16 __attribute__((ext_vector_type(16)));
typedef unsigned u32x2 __attribute__((ext_vector_type(2)));
typedef _Float16 f16x4 __attribute__((ext_vector_type(4)));
typedef unsigned u32x4 __attribute__((ext_vector_type(4)));
typedef _Float16 f16x8 __attribute__((ext_vector_type(8)));

constexpr int DM = 2048, SEQ = 8192, CTXL = 256, MC = SEQ + CTXL, INC = 5120, NE = 16, CAP = 1024, FE = 1024, MR = NE * CAP;
constexpr float EPS = 1e-6f;
constexpr int NWAVES = 8, NTHR = 512;
constexpr int NPH = 20;

constexpr size_t al256(size_t x) { return (x + 255) / 256 * 256; }
constexpr size_t WS_CTL = 0, CTL_BYTES = 65536;
constexpr size_t WS_MODL = WS_CTL + CTL_BYTES;
constexpr size_t WS_MODC = WS_MODL + 2 * 12288 * 4;
constexpr size_t WS_ROPE = WS_MODC + 4096 * 4;
constexpr size_t WS_CS = WS_ROPE + 2 * 128 * 16 * 4;
constexpr size_t WS_WIN = WS_CS + 1024 * 512 * 2;
constexpr size_t WS_WOUT = WS_WIN + (size_t)INC * DM * 2;
constexpr size_t WS_WFO = WS_WOUT + (size_t)DM * DM * 2;
constexpr size_t WGU_BYTES = (size_t)NE * 2048 * DM * 2, WD_BYTES = (size_t)NE * DM * FE * 2;
constexpr size_t WS_WGU = WS_WFO + (size_t)DM * DM * 2;
constexpr size_t WS_WD = WS_WGU + 2 * WGU_BYTES;
constexpr size_t WS_HCAT = WS_WD + 2 * WD_BYTES;
constexpr size_t WS_Q = WS_HCAT + (size_t)MC * DM * 2;
constexpr size_t WS_K = WS_Q + (size_t)MC * 1024 * 2;
constexpr size_t WS_V = WS_K + (size_t)MC * 1024 * 2;
constexpr size_t WS_UV = WS_V + (size_t)MC * 1024 * 2;
constexpr size_t WS_CAT = WS_UV + (size_t)MC * DM * 2;
constexpr size_t WS_X = WS_CAT + (size_t)SEQ * DM * 2;
constexpr size_t WS_H2 = WS_X + (size_t)SEQ * DM * 4;
constexpr size_t WS_AFF = WS_H2 + (size_t)SEQ * DM * 2;
constexpr size_t WS_IDX = WS_AFF + (size_t)NE * SEQ * 4;
constexpr size_t WS_GATE = WS_IDX + (size_t)MR * 4;
constexpr size_t WS_POS = WS_GATE + (size_t)MR * 4;
constexpr size_t WS_XS = WS_POS + (size_t)NE * SEQ * 4;
constexpr size_t WS_WRP = WS_XS;
constexpr size_t WS_WRB = WS_WRP + 2 * 2 * 4096 * 16;
constexpr size_t WS_ACT = WS_XS + (size_t)MR * DM * 2;
constexpr size_t WS_Y = WS_ACT + (size_t)MR * FE * 2;
constexpr size_t WS_WCT = WS_Y + (size_t)MR * DM * 2;
constexpr size_t WS_F = WS_WCT + (size_t)4096 * 8192 * 2;
constexpr size_t WS_A1 = WS_F + (size_t)SEQ * DM * 2;
constexpr size_t WS_A2 = WS_A1 + 128 * 128 * 2;
constexpr size_t WS_TW = WS_A2 + 128 * 256 * 2;
constexpr size_t WS_END = WS_TW + 64 * 128 * 2 * 4;

constexpr int LDS_BYTES = 147456, LDSCTL_OFF = 146944;

__device__ __forceinline__ unsigned f2bf(float f) { unsigned u = __builtin_bit_cast(unsigned, f); return (u + 0x7fffu + ((u >> 16) & 1u)) >> 16; }
__device__ __forceinline__ unsigned pk2(float lo, float hi) { return f2bf(lo) | (f2bf(hi) << 16); }
__device__ __forceinline__ float bflo(unsigned w) { return __builtin_bit_cast(float, w << 16); }
__device__ __forceinline__ float bfhi(unsigned w) { return __builtin_bit_cast(float, w & 0xffff0000u); }
__device__ __forceinline__ unsigned cvt_pk_bf16(float lo, float hi) { unsigned r; asm volatile("v_cvt_pk_bf16_f32 %0, %1, %2" : "=v"(r) : "v"(lo), "v"(hi)); return r; }
__device__ __forceinline__ float dpp_f(float v, int ctrl_sel) {
    const int x = __builtin_bit_cast(int, v);
    int r;
    switch (ctrl_sel) {
        case 0: r = __builtin_amdgcn_update_dpp(0, x, 0xB1, 0xF, 0xF, true); break;
        case 1: r = __builtin_amdgcn_update_dpp(0, x, 0x4E, 0xF, 0xF, true); break;
        case 2: r = __builtin_amdgcn_update_dpp(0, x, 0x141, 0xF, 0xF, true); break;
        default: r = __builtin_amdgcn_update_dpp(0, x, 0x140, 0xF, 0xF, true); break;
    }
    return __builtin_bit_cast(float, r);
}
__device__ __forceinline__ float wave_sum(float v) {
    v += dpp_f(v, 0); v += dpp_f(v, 1); v += dpp_f(v, 2); v += dpp_f(v, 3);
    { auto rr = __builtin_amdgcn_permlane16_swap(__float_as_uint(v), __float_as_uint(v), false, false); v = __uint_as_float(rr[0]) + __uint_as_float(rr[1]); }
    { auto rr = __builtin_amdgcn_permlane32_swap(__float_as_uint(v), __float_as_uint(v), false, false); v = __uint_as_float(rr[0]) + __uint_as_float(rr[1]); }
    return v;
}
__device__ __forceinline__ f32x4 ldx4(const _Float16* p) { return __builtin_convertvector(*(const f16x4*)p, f32x4); }
__device__ __forceinline__ void stx4(_Float16* p, f32x4 v) { *(f16x4*)p = __builtin_convertvector(v, f16x4); }
__device__ __forceinline__ float wave_max(float v) {
#pragma unroll
    for (int o = 1; o < 64; o <<= 1) v = fmaxf(v, __shfl_xor(v, o));
    return v;
}

#define XB_TMO      128
#define XB_XCNT(j)  (256  + 64 * (j))
#define XB_XSUB(j)  (1280 + 64 * (j))
#define XB_XGEN(j)  (2304 + 64 * (j))
#define XB_TOP      3328
#define XB_TOPGEN   3392
#define XCD_BAR_WORDS 3456
#define XB_SPIN_CAP (1u << 18)
__device__ __forceinline__ unsigned xb_ld(unsigned* p)              { return __hip_atomic_load(p, __ATOMIC_RELAXED, __HIP_MEMORY_SCOPE_AGENT); }
__device__ __forceinline__ unsigned xb_add(unsigned* p, unsigned v) { return __hip_atomic_fetch_add(p, v, __ATOMIC_RELAXED, __HIP_MEMORY_SCOPE_AGENT); }
__device__ __forceinline__ unsigned xb_xcc_id() { return (unsigned)__builtin_amdgcn_s_getreg((3 << 11) | 20) & 0xFu; }
#define XB_SPIN(cond, bar) do { unsigned _sp = 0; while (cond) { __builtin_amdgcn_s_sleep(1); \
    if ((++_sp & 255u) == 0u) { if (xb_ld(&(bar)[XB_TMO])) break; if (_sp > XB_SPIN_CAP) { atomicAdd(&(bar)[XB_TMO], 1u); break; } } } } while (0)
struct XcdBarrier { unsigned* bar; unsigned x; volatile LAS unsigned* st; };
__device__ __forceinline__ XcdBarrier xcd_barrier_post(unsigned* bar, volatile LAS unsigned* st) {
    XcdBarrier b; b.bar = bar; b.x = xb_xcc_id(); b.st = st;
    if (threadIdx.x == 0) (void)xb_add(&bar[XB_XCNT(b.x)], 1u);
    return b;
}
__device__ __forceinline__ void xcd_barrier_complete(unsigned* bar, unsigned x, unsigned& nloc, unsigned& nx) {
    const unsigned G = gridDim.x * gridDim.y * gridDim.z;
    unsigned sum, cnt, mine, sp = 0u;
    for (;;) {
        sum = 0u; cnt = 0u; mine = 0u;
#pragma unroll
        for (unsigned j = 0; j < 16; ++j) { const unsigned c = xb_ld(&bar[XB_XCNT(j)]); sum += c; cnt += (c > 0u) ? 1u : 0u; mine = (j == x) ? c : mine; }
        if (sum == G) break;
        __builtin_amdgcn_s_sleep(1);
        if ((++sp & 255u) == 0u) { if (xb_ld(&bar[XB_TMO])) break; if (sp > XB_SPIN_CAP) { atomicAdd(&bar[XB_TMO], 1u); break; } }
    }
    nloc = mine > 0u ? mine : 1u; nx = cnt > 0u ? cnt : 1u;
}
__device__ __forceinline__ void xcd_barrier(const XcdBarrier& b) {
    asm volatile("s_waitcnt vmcnt(0)" ::: "memory");
    __syncthreads();
    if (threadIdx.x == 0) {
        unsigned* bar = b.bar;
        __builtin_amdgcn_s_waitcnt(0);
        unsigned nloc = b.st[0], nx = b.st[1];
        if (nloc == 0u) { xcd_barrier_complete(bar, b.x, nloc, nx); b.st[0] = nloc; b.st[1] = nx; }
        const unsigned old = xb_add(&bar[XB_XSUB(b.x)], 1u);
        const unsigned gen = old / nloc;
        if (old + 1u == (gen + 1u) * nloc) {
            __builtin_amdgcn_fence(__ATOMIC_RELEASE, "agent");
            asm volatile("s_waitcnt vmcnt(0)" ::: "memory");
            const unsigned og = xb_add(&bar[XB_TOP], 1u);
            const unsigned tg = og / nx;
            if (og + 1u == (tg + 1u) * nx) xb_add(&bar[XB_TOPGEN], 1u);
            else XB_SPIN(xb_ld(&bar[XB_TOPGEN]) == tg, bar);
            __builtin_amdgcn_fence(__ATOMIC_ACQUIRE, "agent");
            xb_add(&bar[XB_XGEN(b.x)], 1u);
            asm volatile("s_waitcnt vmcnt(0)" ::: "memory");
        } else {
            XB_SPIN(xb_ld(&bar[XB_XGEN(b.x)]) == gen, bar);
            __builtin_amdgcn_fence(__ATOMIC_ACQUIRE, "agent");
            asm volatile("s_waitcnt vmcnt(0)" ::: "memory");
        }
    }
    __syncthreads();
}

namespace pg8 {
constexpr int BM = 256, BK = 64, HALF = 128, HTB = HALF * BK * 2, STAGE_BYTES = 8 * HTB, NXCD = 8, WGM = 8;
__host__ __device__ __forceinline__ int lds_byte(int r, int c) { const int st = (r >> 4) * 2 + (c >> 5), rr = r & 15, cc = c & 31, ob = rr * 64 + cc * 2; return st * 1024 + (ob ^ (((ob >> 9) & 1) << 5)); }
__host__ __device__ __forceinline__ void stage_rc(int b, int& R, int& C) { const int st = b / 1024, sb = b % 1024, swz = sb ^ (((sb >> 9) & 1) << 5); R = (st >> 1) * 16 + swz / 64; C = (st & 1) * 32 + (swz % 64) / 2; }
__host__ __device__ __forceinline__ int perm32(int rho) { const int n = rho >> 4, i = rho & 15; return 8 * (i >> 2) + 4 * n + (i & 3); }

struct Unit { int pm, pn, aux; };
struct Geo {
    const char* A; const char* B;
    unsigned lda2, ldb2, kA, kB;
    size_t hA, hB, tA, tB, aA, aB;
    int nt, amode, bmode;
    __device__ __forceinline__ size_t offA(const Unit& u) const { return (size_t)u.pm * tA + (size_t)u.aux * aA; }
    __device__ __forceinline__ size_t offB(const Unit& u) const { return (size_t)u.pn * tB + (size_t)u.aux * aB; }
};
__device__ __forceinline__ Geo geo_rowmajor(const void* A, int lda, const void* B, int ldb, int K) {
    Geo g; g.A = (const char*)A; g.B = (const char*)B; g.lda2 = lda * 2; g.ldb2 = ldb * 2; g.kA = 128; g.kB = 128;
    g.hA = (size_t)128 * lda * 2; g.hB = (size_t)128 * ldb * 2; g.tA = 2 * g.hA; g.tB = 2 * g.hB; g.aA = 0; g.aB = 0; g.nt = K / 64; g.amode = 0; g.bmode = 0; return g;
}

struct StaticOrder {
    int nM, nN, nwg, G, c;
    __device__ void init(int M, int N, int G_, int c_) { nM = M / BM; nN = N / BM; nwg = nM * nN; G = G_; c = c_; }
    __device__ bool next(int i, Unit& u) const {
        const long L = (long)i * G + c; if (L >= nwg) return false;
        int wgid = (int)L; { const int q = nwg / NXCD, r = nwg % NXCD, xcd = wgid % NXCD, off = wgid / NXCD; wgid = (xcd < r ? xcd * (q + 1) : r * (q + 1) + (xcd - r) * q) + off; }
        const int nig = WGM * nN, gid = wgid / nig, fm = gid * WGM, gsz = (nM - fm) < WGM ? (nM - fm) : WGM;
        u.pm = fm + ((wgid % nig) % gsz); u.pn = (wgid % nig) / gsz; u.aux = 0; return true;
    }
    __device__ __forceinline__ void a_ready(const Unit&) const {}
    __device__ __forceinline__ void done(const Unit&) const {}
};
struct WinOrder : StaticOrder {
    __device__ void init_win(int G_, int c_) { init(SEQ, INC, G_, c_); }
    __device__ int total() const { return nwg + 8; }
    __device__ bool next(int i, Unit& u) const {
        const long L = (long)i * G + c;
        if (L < nwg) { StaticOrder::next(i, u); u.pm += 1; return true; }
        if (L < nwg + 8) { u.pm = 0; u.pn = 4 + (int)(L - nwg); u.aux = 0; return true; }
        return false; }
};
struct MoeOrder : StaticOrder {
    __device__ bool next(int i, Unit& u) const { if (!StaticOrder::next(i, u)) return false; u.aux = u.pm >> 2; return true; }
};
struct StepAOrder {
    int G, c;
    __device__ bool next(int i, Unit& u) const { const int L = i * G + c; if (L >= 256) return false; u.aux = L >> 6; const int r = L & 63; u.pm = r & 1; u.pn = r >> 1; return true; }
    __device__ __forceinline__ void a_ready(const Unit&) const {}
    __device__ __forceinline__ void done(const Unit&) const {}
};

template <class Epi, class Sched, bool ALIGN_EPI, bool SP2, bool GATHER = false>
__device__ __forceinline__ void gemm_phase(LAS unsigned char* lds, const Geo g, const Sched& S, const Epi& E, const int* gidx = nullptr) {
    const int tid = threadIdx.x, wid = __builtin_amdgcn_readfirstlane(tid >> 6), lane = tid & 63, wr = wid >> 2, wc = wid & 3, fr = lane & 15, fq = lane >> 4;
    const int nt = g.nt;
    unsigned voffA[2], voffB[2], voffA1[2], nvA0[2], nvA1[2]; int gR[2]; unsigned gC[2];
#pragma unroll
    for (int i = 0; i < 2; ++i) { int R, C; stage_rc(tid * 16 + i * 8192, R, C); const int Rb = Epi::PERM ? ((R & ~31) + perm32(R & 31)) : R; gR[i] = R; gC[i] = (unsigned)C * 2u;
        voffA[i] = g.amode ? (unsigned)(C >> 3) * 131072u + (unsigned)R * 16u : (unsigned)R * g.lda2 + (unsigned)C * 2u;
        voffB[i] = (unsigned)(g.bmode ? ((Rb & 63) * 128 + (Rb >> 6)) : Rb) * g.ldb2 + (unsigned)C * 2u; }
    const size_t kA = g.kA, kB = g.kB, hA = g.hA, hB = g.hB;
    const unsigned ldsw = (unsigned)wid * 1024u;
    const int aoff = lds_byte(wr * 64 + fr, fq * 8), boff = lds_byte(wc * 32 + fr, fq * 8);
#define PG8_GIDX(dst0, dst1, u) do { _Pragma("unroll") for (int _i = 0; _i < 2; ++_i) { \
        dst0[_i] = (unsigned)gidx[(u).pm * BM + gR[_i]] * g.lda2 + gC[_i]; dst1[_i] = (unsigned)gidx[(u).pm * BM + HALF + gR[_i]] * g.lda2 + gC[_i]; } } while (0)
#define PG8_SA(b, h) (((b) * 2 + (h)) * HTB)
#define PG8_SB(b, h) ((4 + (b) * 2 + (h)) * HTB)
#define PG8_STAGE(bufoff, gbase, voff) do { _Pragma("unroll") for (int _i = 0; _i < 2; ++_i) \
        __builtin_amdgcn_global_load_lds((const unsigned*)((const char*)(gbase) + (voff)[_i]), (LAS unsigned*)(lds + (bufoff) + ldsw + _i * 8192), 16, 0, 0); } while (0)
#define PG8_LDA(dst, b, h) do { _Pragma("unroll") for (int m = 0; m < 4; ++m) _Pragma("unroll") for (int k = 0; k < 2; ++k) dst[m][k] = *(const LAS bf16x8*)(lds + PG8_SA(b, h) + aoff + m * 2048 + k * 1024); } while (0)
#define PG8_LDB(dst, b, h) do { _Pragma("unroll") for (int n = 0; n < 2; ++n) _Pragma("unroll") for (int k = 0; k < 2; ++k) dst[n][k] = *(const LAS bf16x8*)(lds + PG8_SB(b, h) + boff + n * 2048 + k * 1024); } while (0)
#define PG8_MMA(ai, bj, At, Bt) do { __builtin_amdgcn_s_setprio(1); _Pragma("unroll") for (int m = 0; m < 4; ++m) _Pragma("unroll") for (int n = 0; n < 2; ++n) _Pragma("unroll") for (int k = 0; k < 2; ++k) \
        acc[ai][bj][m][n] = __builtin_amdgcn_mfma_f32_16x16x32_bf16(Bt[n][k], At[m][k], acc[ai][bj][m][n], 0, 0, 0); __builtin_amdgcn_s_setprio(0); } while (0)
#define PG8_WAIT_V(n) asm volatile("s_waitcnt vmcnt(" #n ")" ::: "memory")
#define PG8_WAIT_L(n) asm volatile("s_waitcnt lgkmcnt(" #n ")" ::: "memory")
#define PG8_BAR __builtin_amdgcn_s_barrier()
#define PG8_SCHED __builtin_amdgcn_sched_barrier(0)
    Unit cur, nxt; int ui = 0;
    if (!S.next(0, cur)) return;
    f32x4 acc[2][2][4][2];
#pragma unroll
    for (int a = 0; a < 2; ++a)
#pragma unroll
        for (int b = 0; b < 2; ++b)
#pragma unroll
            for (int m = 0; m < 4; ++m)
#pragma unroll
                for (int n = 0; n < 2; ++n) acc[a][b][m][n] = (f32x4){0.f, 0.f, 0.f, 0.f};
    bf16x8 At[4][2], B0[2][2], B1[2][2];
    const char* cA = g.A + g.offA(cur); const char* cB = g.B + g.offB(cur);
    S.a_ready(cur);
    if constexpr (GATHER) { PG8_GIDX(voffA, voffA1, cur); } else { voffA1[0] = voffA[0]; voffA1[1] = voffA[1]; }
    if constexpr (SP2) {
        PG8_STAGE(PG8_SB(0, 0), cB, voffB); PG8_STAGE(PG8_SB(0, 1), cB + hB, voffB); PG8_STAGE(PG8_SA(0, 0), cA, voffA); PG8_STAGE(PG8_SA(0, 1), cA + hA, voffA1);
        if (wr == 1) PG8_BAR;
        PG8_WAIT_V(2); PG8_BAR;
        PG8_STAGE(PG8_SB(1, 0), cB + kB, voffB); PG8_STAGE(PG8_SA(1, 0), cA + kA, voffA); PG8_STAGE(PG8_SB(1, 1), cB + hB + kB, voffB);
        PG8_WAIT_V(6); PG8_BAR;
    } else {
        PG8_STAGE(PG8_SB(0, 0), cB, voffB); PG8_STAGE(PG8_SA(0, 0), cA, voffA); PG8_STAGE(PG8_SB(0, 1), cB + hB, voffB); PG8_STAGE(PG8_SA(0, 1), cA + hA, voffA1);
        if (wr == 1) PG8_BAR;
        PG8_WAIT_V(4); PG8_BAR;
        PG8_STAGE(PG8_SB(1, 0), cB + kB, voffB); PG8_STAGE(PG8_SA(1, 0), cA + kA, voffA); PG8_STAGE(PG8_SB(1, 1), cB + hB + kB, voffB);
        PG8_WAIT_V(6); PG8_BAR;
    }
    for (;;) {
        const bool has_next = S.next(ui + 1, nxt);
        const char* nA = has_next ? g.A + g.offA(nxt) : cA; const char* nB = has_next ? g.B + g.offB(nxt) : cB;
        if constexpr (GATHER) { if (has_next) { PG8_GIDX(nvA0, nvA1, nxt); } else { nvA0[0] = voffA[0]; nvA0[1] = voffA[1]; nvA1[0] = voffA1[0]; nvA1[1] = voffA1[1]; } }
        for (int t = 0; t < nt; t += 2) {
            const bool last = (t == nt - 2);
            unsigned sA0[2], sA1[2];
            if constexpr (GATHER) { sA0[0] = last ? nvA0[0] : voffA[0]; sA0[1] = last ? nvA0[1] : voffA[1]; sA1[0] = last ? nvA1[0] : voffA1[0]; sA1[1] = last ? nvA1[1] : voffA1[1]; }
            else { sA0[0] = voffA[0]; sA0[1] = voffA[1]; sA1[0] = voffA[0]; sA1[1] = voffA[1]; }
            const char* a1 = cA + (size_t)(t + 1) * kA;
            const char* a2 = last ? nA : cA + (size_t)(t + 2) * kA; const char* b2 = last ? nB : cB + (size_t)(t + 2) * kB;
            const char* a3 = a2 + kA; const char* b3 = b2 + kB;
            if (last && has_next) S.a_ready(nxt);
            if constexpr (SP2) {
            PG8_LDB(B0, 0, 0); PG8_LDB(B1, 0, 1); PG8_SCHED; PG8_LDA(At, 0, 0); PG8_STAGE(PG8_SA(1, 1), a1 + hA, voffA1);
            PG8_WAIT_V(8); PG8_WAIT_L(0); PG8_BAR; PG8_MMA(0, 0, At, B0); PG8_MMA(0, 1, At, B1); PG8_BAR; PG8_SCHED;
            PG8_LDA(At, 0, 1); PG8_STAGE(PG8_SB(0, 0), b2, voffB); PG8_STAGE(PG8_SB(0, 1), b2 + hB, voffB); PG8_STAGE(PG8_SA(0, 0), a2, sA0);
            PG8_WAIT_V(8); PG8_WAIT_L(0); PG8_BAR; PG8_MMA(1, 0, At, B0); PG8_MMA(1, 1, At, B1); PG8_BAR; PG8_SCHED;
            PG8_LDB(B0, 1, 0); PG8_LDB(B1, 1, 1); PG8_SCHED; PG8_LDA(At, 1, 0); PG8_STAGE(PG8_SA(0, 1), a2 + hA, sA1);
            PG8_WAIT_V(8); PG8_WAIT_L(0); PG8_BAR; PG8_MMA(0, 0, At, B0); PG8_MMA(0, 1, At, B1); PG8_BAR; PG8_SCHED;
            PG8_LDA(At, 1, 1); PG8_STAGE(PG8_SB(1, 0), b3, voffB); PG8_STAGE(PG8_SB(1, 1), b3 + hB, voffB); PG8_STAGE(PG8_SA(1, 0), a3, sA0);
            PG8_WAIT_V(8); PG8_WAIT_L(0); PG8_BAR; PG8_MMA(1, 0, At, B0); PG8_MMA(1, 1, At, B1); PG8_BAR; PG8_SCHED;
            } else {
            PG8_LDB(B0, 0, 0); PG8_SCHED; PG8_LDA(At, 0, 0); PG8_STAGE(PG8_SA(1, 1), a1 + hA, voffA1);
            PG8_WAIT_L(8); PG8_BAR; PG8_WAIT_L(0); PG8_MMA(0, 0, At, B0); PG8_BAR; PG8_SCHED;
            PG8_LDB(B1, 0, 1); PG8_STAGE(PG8_SB(0, 0), b2, voffB);
            PG8_BAR; PG8_WAIT_L(0); PG8_MMA(0, 1, At, B1); PG8_BAR;
            PG8_LDA(At, 0, 1); PG8_STAGE(PG8_SA(0, 0), a2, sA0);
            PG8_BAR; PG8_WAIT_L(0); PG8_MMA(1, 0, At, B0); PG8_BAR; PG8_SCHED;
            PG8_STAGE(PG8_SB(0, 1), b2 + hB, voffB);
            PG8_WAIT_V(6); PG8_BAR; PG8_MMA(1, 1, At, B1); PG8_BAR;
            PG8_LDB(B0, 1, 0); PG8_SCHED; PG8_LDA(At, 1, 0); PG8_STAGE(PG8_SA(0, 1), a2 + hA, sA1);
            PG8_WAIT_L(8); PG8_BAR; PG8_WAIT_L(0); PG8_MMA(0, 0, At, B0); PG8_BAR; PG8_SCHED;
            PG8_LDB(B1, 1, 1); PG8_STAGE(PG8_SB(1, 0), b3, voffB);
            PG8_BAR; PG8_WAIT_L(0); PG8_MMA(0, 1, At, B1); PG8_BAR;
            PG8_LDA(At, 1, 1); PG8_STAGE(PG8_SA(1, 0), a3, sA0);
            PG8_BAR; PG8_WAIT_L(0); PG8_MMA(1, 0, At, B0); PG8_BAR; PG8_SCHED;
            PG8_STAGE(PG8_SB(1, 1), b3 + hB, voffB);
            PG8_WAIT_V(6); PG8_BAR; PG8_MMA(1, 1, At, B1); PG8_BAR;
            }
        }
        if constexpr (ALIGN_EPI) { if (wr == 0) PG8_BAR; }
        E(acc, cur, wr, wc, fr, fq); S.done(cur);
        if (!has_next) break;
#pragma unroll
        for (int a = 0; a < 2; ++a)
#pragma unroll
            for (int b = 0; b < 2; ++b)
#pragma unroll
                for (int m = 0; m < 4; ++m)
#pragma unroll
                    for (int n = 0; n < 2; ++n) acc[a][b][m][n] = (f32x4){0.f, 0.f, 0.f, 0.f};
        cur = nxt; cA = nA; cB = nB; ++ui;
        if constexpr (GATHER) { voffA[0] = nvA0[0]; voffA[1] = nvA0[1]; voffA1[0] = nvA1[0]; voffA1[1] = nvA1[1]; }
        if constexpr (ALIGN_EPI) { if (wr == 1) PG8_BAR; }
    }
    PG8_WAIT_V(0);
    if constexpr (!ALIGN_EPI) { if (wr == 0) PG8_BAR; }
    PG8_BAR;
#undef PG8_GIDX
#undef PG8_SA
#undef PG8_SB
#undef PG8_STAGE
#undef PG8_LDA
#undef PG8_LDB
#undef PG8_MMA
#undef PG8_WAIT_V
#undef PG8_WAIT_L
#undef PG8_BAR
#undef PG8_SCHED
}

typedef f32x4 AccT[2][2][4][2];

__device__ __forceinline__ float gelu_tanh(float x) {
    const float z = x * (1.5957691216f + 0.0713548163f * x * x);
    return x * __builtin_amdgcn_rcpf(1.0f + __builtin_amdgcn_exp2f(-1.4426950409f * z));
}
__device__ __forceinline__ u32x2 pack4(f32x4 v) { u32x2 w; w.x = cvt_pk_bf16(v[0], v[1]); w.y = cvt_pk_bf16(v[2], v[3]); return w; }

constexpr float QSCALE = 0.125f * 1.4426950408889634f;
struct EpiWin {
    static constexpr bool PERM = false;
    bf16_t *Q, *K, *V, *UV; const float* ropec; const float* ropes;
    __device__ __forceinline__ void operator()(const AccT& acc, const Unit& u, int wr, int wc, int fr, int fq) const {
        const int sec = u.pn >> 2, row0 = u.pm * BM + wr * 64 + fr;
        if (sec < 2) {
            bf16_t* O = sec == 0 ? Q : K;
            const int colb = (u.pn & 3) * 256 + wc * 32 + 4 * fq; const bool rope = u.pm >= 1;
#pragma unroll
            for (int ai = 0; ai < 2; ++ai)
#pragma unroll
                for (int m = 0; m < 4; ++m) { const int r = row0 + ai * HALF + m * 16; f32x4 cs = (f32x4){1.f, 1.f, 1.f, 1.f}, sn = (f32x4){0.f, 0.f, 0.f, 0.f};
                    if (rope) { const int t = r - CTXL, pos = (wc & 1) ? (t & 63) : (t >> 6); cs = *(const f32x4*)(ropec + pos * 16 + 4 * fq); sn = *(const f32x4*)(ropes + pos * 16 + 4 * fq); }
                    bf16_t* rowp = O + (size_t)r * 1024 + colb;
#pragma unroll
                    for (int bj = 0; bj < 2; ++bj) { const f32x4 x1 = acc[ai][bj][m][0], x2 = acc[ai][bj][m][1];
                        f32x4 o1 = x1 * cs - x2 * sn, o2 = x2 * cs + x1 * sn;
                        if (sec == 0) { o1 = o1 * QSCALE; o2 = o2 * QSCALE; }
                        *(u32x2*)(rowp + bj * HALF) = pack4(o1); *(u32x2*)(rowp + bj * HALF + 16) = pack4(o2); } }
        } else if (sec == 2) {
            const int colb = (u.pn & 3) * 256 + wc * 32 + 4 * fq;
#pragma unroll
            for (int ai = 0; ai < 2; ++ai)
#pragma unroll
                for (int m = 0; m < 4; ++m) { bf16_t* rowp = V + (size_t)(row0 + ai * HALF + m * 16) * 1024 + colb;
#pragma unroll
                    for (int bj = 0; bj < 2; ++bj)
#pragma unroll
                        for (int n = 0; n < 2; ++n) *(u32x2*)(rowp + bj * HALF + n * 16) = pack4(acc[ai][bj][m][n]); }
        } else {
            const int colb = (u.pn - 12) * 256 + wc * 32 + 4 * fq;
#pragma unroll
            for (int ai = 0; ai < 2; ++ai)
#pragma unroll
                for (int m = 0; m < 4; ++m) { bf16_t* rowp = UV + (size_t)(row0 + ai * HALF + m * 16) * 2048 + colb;
#pragma unroll
                    for (int bj = 0; bj < 2; ++bj)
#pragma unroll
                        for (int n = 0; n < 2; ++n) { f32x4 v = acc[ai][bj][m][n];
#pragma unroll
                            for (int j = 0; j < 4; ++j) v[j] = gelu_tanh(v[j]);
                            *(u32x2*)(rowp + bj * HALF + n * 16) = pack4(v); } }
        }
    }
};
template <bool XIN_F32> struct EpiResidN {
    static constexpr bool PERM = false;
    const void* Xin; _Float16* Xout; const float* gate;
    __device__ __forceinline__ void operator()(const AccT& acc, const Unit& u, int wr, int wc, int fr, int fq) const {
        const int row0 = u.pm * BM + wr * 64 + fr, col0 = u.pn * BM + wc * 32 + 4 * fq;
        f32x4 gv[2][2];
#pragma unroll
        for (int bj = 0; bj < 2; ++bj)
#pragma unroll
            for (int n = 0; n < 2; ++n) gv[bj][n] = *(const f32x4*)(gate + col0 + bj * HALF + n * 16);
#pragma unroll
        for (int ai = 0; ai < 2; ++ai)
#pragma unroll
            for (int m = 0; m < 4; ++m) { const size_t ro = (size_t)(row0 + ai * HALF + m * 16) * DM + col0;
#pragma unroll
                for (int bj = 0; bj < 2; ++bj)
#pragma unroll
                    for (int n = 0; n < 2; ++n) { const size_t o = ro + bj * HALF + n * 16;
                        const f32x4 xi = XIN_F32 ? *(const f32x4*)((const float*)Xin + o) : ldx4((const _Float16*)Xin + o);
                        stx4(Xout + o, xi + gv[bj][n] * acc[ai][bj][m][n]); } }
    }
};
template <bool XIN_F32> struct EpiResid {
    static constexpr bool PERM = true;
    const void* Xin; _Float16* Xout; const float* gate;
    __device__ __forceinline__ void operator()(const AccT& acc, const Unit& u, int wr, int wc, int fr, int fq) const {
        const int row0 = u.pm * BM + wr * 64 + fr, col0 = u.pn * BM + wc * 32 + 8 * fq;
        f32x4 gv[2][2];
#pragma unroll
        for (int bj = 0; bj < 2; ++bj)
#pragma unroll
            for (int n = 0; n < 2; ++n) gv[bj][n] = *(const f32x4*)(gate + col0 + bj * HALF + n * 4);
#pragma unroll
        for (int ai = 0; ai < 2; ++ai)
#pragma unroll
            for (int m = 0; m < 4; ++m) { const size_t ro = (size_t)(row0 + ai * HALF + m * 16) * DM + col0;
#pragma unroll
                for (int bj = 0; bj < 2; ++bj) { const size_t o = ro + bj * HALF; f32x4 x0, x1;
                    if (XIN_F32) { x0 = *(const f32x4*)((const float*)Xin + o); x1 = *(const f32x4*)((const float*)Xin + o + 4); }
                    else { const f16x8 h = *(const f16x8*)((const _Float16*)Xin + o);
                        x0 = __builtin_convertvector(__builtin_shufflevector(h, h, 0, 1, 2, 3), f32x4); x1 = __builtin_convertvector(__builtin_shufflevector(h, h, 4, 5, 6, 7), f32x4); }
                    const f16x4 r0 = __builtin_convertvector(x0 + gv[bj][0] * acc[ai][bj][m][0], f16x4), r1 = __builtin_convertvector(x1 + gv[bj][1] * acc[ai][bj][m][1], f16x4);
                    *(f16x8*)(Xout + o) = __builtin_shufflevector(r0, r1, 0, 1, 2, 3, 4, 5, 6, 7); } }
    }
};
struct EpiBf16 {
    static constexpr bool PERM = true;
    bf16_t* O; int ldc; int aux_rows;
    __device__ __forceinline__ void operator()(const AccT& acc, const Unit& u, int wr, int wc, int fr, int fq) const {
        const int row0 = u.aux * aux_rows + u.pm * BM + wr * 64 + fr, col0 = u.pn * BM + wc * 32 + 8 * fq;
#pragma unroll
        for (int ai = 0; ai < 2; ++ai)
#pragma unroll
            for (int m = 0; m < 4; ++m) { bf16_t* rowp = O + (size_t)(row0 + ai * HALF + m * 16) * ldc + col0;
#pragma unroll
                for (int bj = 0; bj < 2; ++bj) { const f32x4 v0 = acc[ai][bj][m][0], v1 = acc[ai][bj][m][1];
                    u32x4 w; w.x = cvt_pk_bf16(v0[0], v0[1]); w.y = cvt_pk_bf16(v0[2], v0[3]); w.z = cvt_pk_bf16(v1[0], v1[1]); w.w = cvt_pk_bf16(v1[2], v1[3]);
                    *(u32x4*)(rowp + bj * HALF) = w; } }
    }
};
struct EpiGateUp {
    static constexpr bool PERM = true;
    bf16_t* ACT;
    __device__ __forceinline__ void operator()(const AccT& acc, const Unit& u, int wr, int wc, int fr, int fq) const {
        const int row0 = u.pm * BM + wr * 64 + fr, col0 = u.pn * 128 + wc * 32 + 8 * fq;
#pragma unroll
        for (int ai = 0; ai < 2; ++ai)
#pragma unroll
            for (int m = 0; m < 4; ++m) { bf16_t* rowp = ACT + (size_t)(row0 + ai * HALF + m * 16) * FE + col0;
                f32x4 o[2];
#pragma unroll
                for (int n = 0; n < 2; ++n) { const f32x4 gt = acc[ai][0][m][n], up = acc[ai][1][m][n];
#pragma unroll
                    for (int j = 0; j < 4; ++j) o[n][j] = gt[j] * up[j] * __builtin_amdgcn_rcpf(1.0f + __builtin_amdgcn_exp2f(-1.4426950409f * gt[j])); }
                u32x4 w; w.x = cvt_pk_bf16(o[0][0], o[0][1]); w.y = cvt_pk_bf16(o[0][2], o[0][3]); w.z = cvt_pk_bf16(o[1][0], o[1][1]); w.w = cvt_pk_bf16(o[1][2], o[1][3]);
                *(u32x4*)rowp = w; }
    }
};
struct EpiDown {
    static constexpr bool PERM = true;
    bf16_t* Y; const float* gate;
    __device__ __forceinline__ void operator()(const AccT& acc, const Unit& u, int wr, int wc, int fr, int fq) const {
        const int row0 = u.pm * BM + wr * 64 + fr, col0 = u.pn * BM + wc * 32 + 8 * fq;
#pragma unroll
        for (int ai = 0; ai < 2; ++ai)
#pragma unroll
            for (int m = 0; m < 4; ++m) { const int r = row0 + ai * HALF + m * 16; const float gr = gate[r]; bf16_t* rowp = Y + (size_t)r * DM + col0;
#pragma unroll
                for (int bj = 0; bj < 2; ++bj) { const f32x4 v0 = acc[ai][bj][m][0] * gr, v1 = acc[ai][bj][m][1] * gr;
                    u32x4 w; w.x = cvt_pk_bf16(v0[0], v0[1]); w.y = cvt_pk_bf16(v0[2], v0[3]); w.z = cvt_pk_bf16(v1[0], v1[1]); w.w = cvt_pk_bf16(v1[2], v1[3]);
                    *(u32x4*)(rowp + bj * HALF) = w; } }
    }
};
}

namespace att {
__device__ __forceinline__ int crow(int r, int hi) { return (r & 3) + 8 * (r >> 2) + 4 * hi; }
__device__ __forceinline__ void sgu_unit(const bf16_t* __restrict__ UV, bf16_t* __restrict__ CAT, const float* __restrict__ w_sp, const float* __restrict__ b_sp,
                                         const float* __restrict__ ln_g, const float* __restrict__ ln_b, int chunk, int g, char* lds) {
  const int tid = threadIdx.x, wid = tid >> 6, lane = tid & 63, r32 = lane & 31, hi = lane >> 5;
  bf16_t* vT = (bf16_t*)lds;
  const int wp = wid >> 1, wd = wid & 1;
  unsigned pkv[16]; f32x4 wsv[16]; u32x4 uwv[4];
#pragma unroll
  for (int i = 0; i < 16; ++i) pkv[i] = *(const unsigned*)(UV + (size_t)(CTXL + chunk * 128 + wid * 16 + i) * DM + 1024 + g * 128 + 2 * lane);
  { const float* Wg = w_sp + (size_t)g * 128 * 128 + (size_t)(wp * 32 + r32) * 128 + hi * 8;
#pragma unroll
    for (int ks = 0; ks < 8; ++ks) { wsv[2 * ks] = *(const f32x4*)(Wg + ks * 16); wsv[2 * ks + 1] = *(const f32x4*)(Wg + ks * 16 + 4); } }
#pragma unroll
  for (int i = 0; i < 4; ++i) { const int ch = tid + 512 * i, p = ch >> 4, d0 = (ch & 15) * 8; uwv[i] = *(const u32x4*)(UV + (size_t)(CTXL + chunk * 128 + p) * DM + g * 128 + d0); }
  { const float lg0 = ln_g[g * 128 + 2 * lane], lg1 = ln_g[g * 128 + 2 * lane + 1], lb0 = ln_b[g * 128 + 2 * lane], lb1 = ln_b[g * 128 + 2 * lane + 1];
#pragma unroll
    for (int i = 0; i < 16; ++i) { const int pos = wid * 16 + i;
      const unsigned pk = pkv[i];
      const float a = bflo(pk), b = bfhi(pk);
      const float mean = wave_sum(a + b) * (1.0f / 128.0f); const float da = a - mean, db = b - mean;
      const float var = wave_sum(da * da + db * db) * (1.0f / 128.0f); const float rstd = 1.0f / sqrtf(var + EPS);
      vT[(2 * lane) * 136 + pos] = (bf16_t)f2bf(da * rstd * lg0 + lb0); vT[(2 * lane + 1) * 136 + pos] = (bf16_t)f2bf(db * rstd * lg1 + lb1); } }
  __syncthreads();
  f32x16 acc[2]; acc[0] = f32x16{}; acc[1] = f32x16{};
#pragma unroll
  for (int ks = 0; ks < 8; ++ks) { const f32x4 w0 = wsv[2 * ks], w1 = wsv[2 * ks + 1];
    u32x4 aw; aw.x = pk2(w0[0], w0[1]); aw.y = pk2(w0[2], w0[3]); aw.z = pk2(w1[0], w1[1]); aw.w = pk2(w1[2], w1[3]);
    const bf16x8 af = __builtin_bit_cast(bf16x8, aw);
#pragma unroll
    for (int nb = 0; nb < 2; ++nb) { const bf16x8 bf = *(const bf16x8*)(vT + (wd * 64 + nb * 32 + r32) * 136 + ks * 16 + hi * 8);
      acc[nb] = __builtin_amdgcn_mfma_f32_32x32x16_bf16(af, bf, acc[nb], 0, 0, 0); } }
  __syncthreads();
  float* mt = (float*)lds;
#pragma unroll
  for (int nb = 0; nb < 2; ++nb) { const int d = wd * 64 + nb * 32 + r32;
#pragma unroll
    for (int r = 0; r < 16; ++r) { const int p = wp * 32 + crow(r, hi); mt[p * 132 + d] = acc[nb][r] + b_sp[g * 128 + p]; } }
  __syncthreads();
#pragma unroll
  for (int i = 0; i < 4; ++i) { const int ch = tid + 512 * i, p = ch >> 4, d0 = (ch & 15) * 8, t = chunk * 128 + p;
    const u32x4 uw = uwv[i];
    const f32x4 m0 = *(const f32x4*)(mt + p * 132 + d0), m1 = *(const f32x4*)(mt + p * 132 + d0 + 4);
    u32x4 o; o.x = pk2(bflo(uw.x) * m0.x, bfhi(uw.x) * m0.y); o.y = pk2(bflo(uw.y) * m0.z, bfhi(uw.y) * m0.w);
    o.z = pk2(bflo(uw.z) * m1.x, bfhi(uw.z) * m1.y); o.w = pk2(bflo(uw.w) * m1.z, bfhi(uw.w) * m1.w);
    *(u32x4*)(CAT + (size_t)t * DM + 1024 + g * 128 + d0) = o; }
  __syncthreads();
}
}


namespace att2 {
using bf16x8_t = bf16x8;
constexpr int NW = 8, QBLK = 32, KVBLK = 64, NSLOT = 3, SLOTB = 16384, DMK = 1024, NT = MC / KVBLK;
constexpr int LDS_K = 0, LDS_V = NSLOT * SLOTB, LDS_WS = 2 * NSLOT * SLOTB, LDS_Q = LDS_WS + NW * 64 * 4, LDS_BYTES_ATT = LDS_Q + NW * 4096;
__device__ __forceinline__ int crow(int r, int hi) { return (r & 3) + 8 * (r >> 2) + 4 * hi; }
#define SBAR() __builtin_amdgcn_sched_barrier(0)
template <int IMM> __device__ __forceinline__ void glds16(const void* sbase, unsigned voff, unsigned lds_dst) { unsigned keep;
  asm volatile("s_mov_b32 %0, m0\n\ts_mov_b32 m0, %3\n\ts_nop 0\n\tglobal_load_lds_dwordx4 %1, %2 offset:%c4\n\ts_mov_b32 m0, %0" : "=&s"(keep) : "v"(voff), "s"(sbase), "s"(lds_dst), "i"(IMM) : "memory"); }
__device__ __forceinline__ float max3f(float a, float b, float c) { float r; asm("v_max3_f32 %0, %1, %2, %3" : "=v"(r) : "v"(a), "v"(b), "v"(c)); return r; }
__device__ __forceinline__ float max2f(float a, float b) { float r; asm("v_max_f32_e32 %0, %1, %2" : "=v"(r) : "v"(a), "v"(b)); return r; }
__device__ __forceinline__ float fadd_s(float a, float b) { float r; asm("v_add_f32_e32 %0, %1, %2" : "=v"(r) : "v"(a), "v"(b)); return r; }
__device__ __forceinline__ float fsub_s(float a, float b) { float r; asm("v_sub_f32_e32 %0, %1, %2" : "=v"(r) : "v"(a), "v"(b)); return r; }
typedef __bf16 bf16x2_t __attribute__((ext_vector_type(2)));
__device__ __forceinline__ unsigned cvtpk_s(float lo, float hi) { f32x2 v = {lo, hi}; bf16x2_t b = __builtin_convertvector(v, bf16x2_t); return __builtin_bit_cast(unsigned, b); }
#define WAIT_BAR(N) asm volatile("s_waitcnt vmcnt(" #N ") lgkmcnt(0)\n\ts_barrier" ::: "memory")
typedef LAS const char* lds_cptr;
typedef short v4i16_t __attribute__((ext_vector_type(4)));
__device__ __forceinline__ void kload8(bf16x8* kf, lds_cptr kp) {
  kf[0] = *(const LAS bf16x8*)(kp);        kf[1] = *(const LAS bf16x8*)(kp + 512);
  kf[2] = *(const LAS bf16x8*)(kp + 2048); kf[3] = *(const LAS bf16x8*)(kp + 2560);
  kf[4] = *(const LAS bf16x8*)(kp + 4096); kf[5] = *(const LAS bf16x8*)(kp + 4608);
  kf[6] = *(const LAS bf16x8*)(kp + 6144); kf[7] = *(const LAS bf16x8*)(kp + 6656);
}
__device__ __forceinline__ void kload2(bf16x8* kf, lds_cptr kp, int j) { kf[2 * j] = *(const LAS bf16x8*)(kp + j * 2048); kf[2 * j + 1] = *(const LAS bf16x8*)(kp + j * 2048 + 512); }
__device__ __forceinline__ s16x4 vtr(lds_cptr p) { return __builtin_bit_cast(s16x4, __builtin_amdgcn_ds_read_tr16_b64_v4i16((LAS v4i16_t*)p)); }
__device__ __forceinline__ float rowmax(const f32x16& p0, const f32x16& p1) {
  float a = max3f(p0[0], p0[1], p1[0]), b = max3f(p0[2], p0[3], p1[1]); a = max3f(a, p1[2], p1[3]);
#pragma unroll
  for (int r = 4; r < 16; r += 4) { a = max3f(a, p0[r], p0[r + 1]); b = max3f(b, p0[r + 2], p0[r + 3]); a = max3f(a, p1[r], p1[r + 1]); b = max3f(b, p1[r + 2], p1[r + 3]); }
  const float m = max2f(a, b);
  auto rr = __builtin_amdgcn_permlane32_swap(__float_as_uint(m), __float_as_uint(m), false, false);
  return max2f(__uint_as_float(rr[0]), __uint_as_float(rr[1]));
}
__device__ __forceinline__ void qkt(f32x16& p0, f32x16& p1, lds_cptr kb, const bf16x8* qr, const f32x16& negm) {
#pragma unroll
  for (int d0 = 0; d0 < 4; ++d0) {
    const bf16x8 b0 = *(const LAS bf16x8*)(kb + d0 * 2048);
    const bf16x8 b1 = *(const LAS bf16x8*)(kb + d0 * 2048 + 512);
    if (d0 == 0) { p0 = __builtin_amdgcn_mfma_f32_32x32x16_bf16(b0, qr[0], negm, 0, 0, 0); p1 = __builtin_amdgcn_mfma_f32_32x32x16_bf16(b1, qr[0], negm, 0, 0, 0); }
    else { p0 = __builtin_amdgcn_mfma_f32_32x32x16_bf16(b0, qr[d0], p0, 0, 0, 0); p1 = __builtin_amdgcn_mfma_f32_32x32x16_bf16(b1, qr[d0], p1, 0, 0, 0); } }
}
__device__ __forceinline__ void pv_last(f32x16* o, int vb, bf16x8 pa0, bf16x8 pa1, bf16x8 pa2, bf16x8 pa3) {
#pragma unroll
  for (int d0 = 0; d0 < 4; ++d0) { s16x4 lo[4], hi[4];
#pragma unroll
    for (int ks = 0; ks < 4; ++ks) {
      asm volatile("ds_read_b64_tr_b16 %0,%1 offset:%c2" : "=&v"(lo[ks]) : "v"(vb), "i"(d0 * 4096 + ks * 1024) : "memory");
      asm volatile("ds_read_b64_tr_b16 %0,%1 offset:%c2" : "=&v"(hi[ks]) : "v"(vb), "i"(d0 * 4096 + ks * 1024 + 512) : "memory"); }
    asm volatile("s_waitcnt lgkmcnt(0)" ::: "memory"); SBAR();
#define PK(k) (bf16x8){lo[k][0], lo[k][1], lo[k][2], lo[k][3], hi[k][0], hi[k][1], hi[k][2], hi[k][3]}
    o[d0] = __builtin_amdgcn_mfma_f32_32x32x16_bf16(pa0, PK(0), o[d0], 0, 0, 0);
    o[d0] = __builtin_amdgcn_mfma_f32_32x32x16_bf16(pa1, PK(1), o[d0], 0, 0, 0);
    o[d0] = __builtin_amdgcn_mfma_f32_32x32x16_bf16(pa2, PK(2), o[d0], 0, 0, 0);
    o[d0] = __builtin_amdgcn_mfma_f32_32x32x16_bf16(pa3, PK(3), o[d0], 0, 0, 0);
#undef PK
  }
}

template <int THRL>
__device__ __forceinline__ void attn_unit(const bf16_t* Q, const bf16_t* __restrict__ K, const bf16_t* __restrict__ V, bf16_t* __restrict__ CAT,
                                          int head, int qb, float lam, float out_scale, const float* __restrict__ g_subln, LAS unsigned char* shm) {
  const int tid = threadIdx.x, lane = tid & 63, r32 = lane & 31, hi = lane >> 5; const int wid = __builtin_amdgcn_readfirstlane(tid >> 6);
  const int comp = wid >> 2, wq = wid & 3;
  if (wid >= 4) __builtin_amdgcn_s_setprio(1);
  const bf16_t* Qw = Q + (size_t)(CTXL + qb * 128 + wq * QBLK) * DMK + head * 128 + comp * 64;
  const bf16_t* Kh = K + head * 128; const bf16_t* Vh = V + head * 128;
  const unsigned lds0 = (unsigned)(uintptr_t)shm;
  LAS float* wsf = (LAS float*)(shm + LDS_WS) + wid * 64;
  const unsigned kvoff = (unsigned)(lane * DMK + wid * 8) * 2u;
  const unsigned vvoff = (unsigned)((16 * (wid & 3) + (lane >> 2)) * DMK + (wid >> 2) * 32 + (lane & 3) * 8) * 2u;
  const unsigned kdst = lds0 + LDS_K + wid * 1024, vdst = lds0 + LDS_V + wid * 1024;
#define DMA_K(t, slot) do { const bf16_t* sb_ = Kh + (long)(t) * KVBLK * DMK; glds16<0>(sb_, kvoff, (unsigned)__builtin_amdgcn_readfirstlane(kdst + (slot))); glds16<0>(sb_ + 64, kvoff, (unsigned)__builtin_amdgcn_readfirstlane(kdst + 8192 + (slot))); } while (0)
#define DMAK1(t, slot) do { glds16<0>(Kh + (long)(t) * KVBLK * DMK, kvoff, (unsigned)__builtin_amdgcn_readfirstlane(kdst + (slot))); SBAR(); } while (0)
#define DMAK2(t, slot) do { glds16<0>(Kh + (long)(t) * KVBLK * DMK + 64, kvoff, (unsigned)__builtin_amdgcn_readfirstlane(kdst + 8192 + (slot))); SBAR(); } while (0)
#define DMAV1(t, slot) do { glds16<0>(Vh + (long)(t) * KVBLK * DMK, vvoff, (unsigned)__builtin_amdgcn_readfirstlane(vdst + (slot))); SBAR(); } while (0)
#define DMAV2(t, slot) do { glds16<0>(Vh + (long)(t) * KVBLK * DMK + 64, vvoff, (unsigned)__builtin_amdgcn_readfirstlane(vdst + 8192 + (slot))); SBAR(); } while (0)
#define DMA_V(t, slot) do { const bf16_t* sb_ = Vh + (long)(t) * KVBLK * DMK; glds16<0>(sb_, vvoff, (unsigned)__builtin_amdgcn_readfirstlane(vdst + (slot))); glds16<0>(sb_ + 64, vvoff, (unsigned)__builtin_amdgcn_readfirstlane(vdst + 8192 + (slot))); } while (0)
  const int vb0 = (int)(lds0 + LDS_V) + ((lane >> 4) & 1) * 32 + (lane & 3) * 8 + (4 * hi + ((lane & 15) >> 2)) * 64;
  bf16x8 kf[8];
  const lds_cptr shm3 = (lds_cptr)shm; const lds_cptr kp0 = shm3 + LDS_K + comp * 8192 + hi * 1024 + r32 * 16;
  const lds_cptr vp0 = shm3 + LDS_V + ((lane >> 4) & 1) * 32 + (lane & 3) * 8 + (4 * hi + ((lane & 15) >> 2)) * 64;
  DMA_K(0, 0); DMA_V(0, 0); DMA_K(1, SLOTB);
  bf16x8 qr[4];
#pragma unroll
  for (int d0 = 0; d0 < 4; ++d0) qr[d0] = *reinterpret_cast<const bf16x8*>(&Qw[(long)r32 * DMK + d0 * 16 + hi * 8]);
  float mhat = 0.f, l_reg = 0.f; f32x16 o[4]; o[0] = f32x16{}; o[1] = f32x16{}; o[2] = f32x16{}; o[3] = f32x16{}; f32x16 negm = f32x16{}; asm volatile("" : "+v"(negm));
  bool resc = false;
#define START(P0, P1) do { const float rm = rowmax(P0, P1); resc = false; \
    { const float dl = rm; mhat = fadd_s(mhat, dl); \
      _Pragma("unroll") for (int r = 0; r < 16; ++r) { P0[r] = fsub_s(P0[r], dl); P1[r] = fsub_s(P1[r], dl); } \
      _Pragma("unroll") for (int r = 0; r < 16; ++r) negm[r] = -mhat; asm volatile("" : "+v"(negm)); } \
    _Pragma("unroll") for (int r = 0; r < 16; ++r) P0[r] = __builtin_amdgcn_exp2f(P0[r]); } while (0)
#define RESC() do { if (resc) { asm volatile("s_waitcnt lgkmcnt(0)" ::: "memory"); \
      _Pragma("unroll") for (int d_ = 0; d_ < 4; ++d_) _Pragma("unroll") for (int r = 0; r < 16; ++r) o[d_][r] *= wsf[crow(r, hi)]; } } while (0)
  f32x16 pA0, pA1, pB0, pB1;
  int sl_prev = 0, sl_cur = 0, sl_next = SLOTB;
#define ROT() do { sl_prev = sl_cur; sl_cur = sl_next; sl_next = (sl_next == (NSLOT - 1) * SLOTB) ? 0 : sl_next + SLOTB; } while (0)
  DMA_K(2, 2 * SLOTB);
  WAIT_BAR(6);
  qkt(pA0, pA1, kp0, qr, negm); asm volatile("s_nop 15\n\ts_nop 7" : "+v"(pA0), "+v"(pA1));
  const lds_cptr qp = shm3 + LDS_Q + wid * 4096 + lane * 16;
#pragma unroll
  for (int d0 = 0; d0 < 4; ++d0) *(LAS bf16x8*)(shm + LDS_Q + wid * 4096 + lane * 16 + d0 * 1024) = qr[d0];
  START(pA0, pA1);
#pragma unroll
  for (int r = 0; r < 16; ++r) pA1[r] = __builtin_amdgcn_exp2f(pA1[r]);
  WAIT_BAR(0);
  DMA_K(3, 0); DMA_V(1, SLOTB);
  ROT();
  kload8(kf, kp0 + sl_cur);
  WAIT_BAR(4);
  s16x4 vlo[4], vhi[4]; u32x4 pw0, pw1, pw2, pw3;
#define PKW(P, B) cvtpk_s(P[B], P[B + 1])
#define PAF(k) __builtin_bit_cast(bf16x8, pw##k)
#define VFR(i) (bf16x8){vlo[i][0], vlo[i][1], vlo[i][2], vlo[i][3], vhi[i][0], vhi[i][1], vhi[i][2], vhi[i][3]}
#define PIN(x) asm volatile("" : "+v"(x))
#define MX3(a, b, c) __builtin_fmaxf(__builtin_fmaxf((a), (b)), (c))
#define GAPA(MF, A0, A1, A2, A3, W0, W1, PW) do { MF; sacc += A0; sacc += A1; sacc += A2; sacc += A3; PIN(sacc); W0; W1; PIN(PW); SBAR(); } while (0)
#define EX(v) __builtin_amdgcn_exp2f(v)
#define GAPB(MF, X, B) do { MF; X[B] = EX(X[B]); X[B + 1] = EX(X[B + 1]); PIN(X); } while (0)
#define VRD(s) do { vlo[(s) & 3] = vtr(vp_ + (((s) & 3) * 4096 + ((s) >> 2) * 1024)); vhi[(s) & 3] = vtr(vp_ + (((s) & 3) * 4096 + ((s) >> 2) * 1024 + 512)); } while (0)
#define KRD(G, j) do { if (G) { kload2(kf, kp0 + sl_next, j); SBAR(); } } while (0)
#define PVS(s, PA, X, B) do { GAPB(o[(s) & 3] = __builtin_amdgcn_mfma_f32_32x32x16_bf16(PA, VFR((s) & 3), o[(s) & 3], 0, 0, 0), X, B); if ((s) + 4 < 16) { VRD((s) + 4); } SBAR(); } while (0)
#define STEP(C0, C1, P0, P1, t, GK, GV, GL) do { SBAR(); \
    const lds_cptr vp_ = vp0 + sl_prev; \
    float sacc = (P0[0] + P0[1]); bf16x8 qa = *(const LAS bf16x8*)(qp), qb_; \
    GAPA(C0 = __builtin_amdgcn_mfma_f32_32x32x16_bf16(kf[0], qa, negm, 0, 0, 0), P0[2], P0[3], P0[4], P0[5],     pw0[0] = PKW(P0, 0), pw0[1] = PKW(P0, 2), pw0); \
    GAPA(C1 = __builtin_amdgcn_mfma_f32_32x32x16_bf16(kf[1], qa, negm, 0, 0, 0), P0[6], P0[7], P0[8], P0[9],     pw0[2] = PKW(P0, 4), pw0[3] = PKW(P0, 6), pw0); qb_ = *(const LAS bf16x8*)(qp + 1024); \
    GAPA(C0 = __builtin_amdgcn_mfma_f32_32x32x16_bf16(kf[2], qb_, C0, 0, 0, 0),   P0[10], P0[11], P0[12], P0[13], pw1[0] = PKW(P0, 8), pw1[1] = PKW(P0, 10), pw1); \
    GAPA(C1 = __builtin_amdgcn_mfma_f32_32x32x16_bf16(kf[3], qb_, C1, 0, 0, 0),   P0[14], P0[15], P1[0], P1[1],   pw1[2] = PKW(P0, 12), pw1[3] = PKW(P0, 14), pw1); qa = *(const LAS bf16x8*)(qp + 2048); \
    VRD(0); SBAR(); GAPA(C0 = __builtin_amdgcn_mfma_f32_32x32x16_bf16(kf[4], qa, C0, 0, 0, 0),   P1[2], P1[3], P1[4], P1[5],     pw2[0] = PKW(P1, 0), pw2[1] = PKW(P1, 2), pw2); \
    VRD(1); SBAR(); GAPA(C1 = __builtin_amdgcn_mfma_f32_32x32x16_bf16(kf[5], qa, C1, 0, 0, 0),   P1[6], P1[7], P1[8], P1[9],     pw2[2] = PKW(P1, 4), pw2[3] = PKW(P1, 6), pw2); qb_ = *(const LAS bf16x8*)(qp + 3072); \
    VRD(2); SBAR(); GAPA(C0 = __builtin_amdgcn_mfma_f32_32x32x16_bf16(kf[6], qb_, C0, 0, 0, 0),   P1[10], P1[11], P1[12], P1[13], pw3[0] = PKW(P1, 8), pw3[1] = PKW(P1, 10), pw3); \
    VRD(3); SBAR(); GAPA(C1 = __builtin_amdgcn_mfma_f32_32x32x16_bf16(kf[7], qb_, C1, 0, 0, 0),   P1[14], P1[15], 0.f, 0.f,       pw3[2] = PKW(P1, 12), pw3[3] = PKW(P1, 14), pw3); \
    l_reg += sacc; \
    { float a = MX3(C0[0], C0[1], C1[0]), b = MX3(C0[2], C0[3], C1[1]); a = MX3(a, C1[2], C1[3]); \
      _Pragma("unroll") for (int r = 4; r < 16; r += 4) { a = MX3(a, C0[r], C0[r + 1]); b = MX3(b, C0[r + 2], C0[r + 3]); a = MX3(a, C1[r], C1[r + 1]); b = MX3(b, C1[r + 2], C1[r + 3]); } \
      float rm = __builtin_fmaxf(a, b); { auto rr = __builtin_amdgcn_permlane32_swap(__float_as_uint(rm), __float_as_uint(rm), false, false); rm = __builtin_fmaxf(__uint_as_float(rr[0]), __uint_as_float(rr[1])); } \
      resc = false; \
      if (__builtin_expect(__any(rm > (float)THRL), 0)) { const float dl = __builtin_fmaxf(rm, 0.f); mhat += dl; \
        _Pragma("unroll") for (int r = 0; r < 16; ++r) { C0[r] -= dl; C1[r] -= dl; } \
        _Pragma("unroll") for (int r = 0; r < 16; ++r) negm[r] = -mhat; asm volatile("" : "+v"(negm)); \
        const float f = __builtin_amdgcn_exp2f(-dl); l_reg *= f; if (hi == 0) wsf[r32] = f; resc = true; } } \
    SBAR(); \
    PVS(0, PAF(0), C0, 0);  if (GK) { DMAK1((t) + 3, sl_cur); } PVS(1, PAF(0), C0, 2);  PVS(2, PAF(0), C0, 4);  if (GK) { DMAK2((t) + 3, sl_cur); } PVS(3, PAF(0), C0, 6); \
    KRD(GL, 0); PVS(4, PAF(1), C0, 8);  if (GV) { DMAV1((t) + 1, sl_next); } PVS(5, PAF(1), C0, 10); KRD(GL, 1); PVS(6, PAF(1), C0, 12); if (GV) { DMAV2((t) + 1, sl_next); } PVS(7, PAF(1), C0, 14); \
    KRD(GL, 2); PVS(8, PAF(2), C1, 0);  PVS(9, PAF(2), C1, 2);  KRD(GL, 3); PVS(10, PAF(2), C1, 4); PVS(11, PAF(2), C1, 6); \
    PVS(12, PAF(3), C1, 8); PVS(13, PAF(3), C1, 10); PVS(14, PAF(3), C1, 12); PVS(15, PAF(3), C1, 14); \
    } while (0)
  int t = 1;
  for (; t + 5 < NT; t += 2) {
    STEP(pB0, pB1, pA0, pA1, t, true, true, true);     WAIT_BAR(4); RESC(); ROT();
    STEP(pA0, pA1, pB0, pB1, t + 1, true, true, true); WAIT_BAR(4); RESC(); ROT();
  }
#define ENDW(tt) do { if ((tt) + 3 < NT) { WAIT_BAR(4); } else if ((tt) + 2 < NT) { WAIT_BAR(2); } else { WAIT_BAR(0); } } while (0)
  for (; t + 1 < NT; t += 2) {
    STEP(pB0, pB1, pA0, pA1, t, (t + 3 < NT), (t + 1 < NT), (t + 1 < NT));         ENDW(t);     RESC(); ROT();
    STEP(pA0, pA1, pB0, pB1, t + 1, (t + 4 < NT), (t + 2 < NT), (t + 2 < NT));     ENDW(t + 1); RESC(); ROT();
  }
  STEP(pB0, pB1, pA0, pA1, NT - 1, false, false, false); RESC();
  { float sacc = pB0[0] + pB0[1];
#pragma unroll
    for (int r = 2; r < 16; ++r) sacc += pB0[r];
#pragma unroll
    for (int r = 0; r < 16; ++r) sacc += pB1[r];
    l_reg += sacc;
    pw0 = (u32x4){PKW(pB0, 0), PKW(pB0, 2), PKW(pB0, 4), PKW(pB0, 6)}; pw1 = (u32x4){PKW(pB0, 8), PKW(pB0, 10), PKW(pB0, 12), PKW(pB0, 14)};
    pw2 = (u32x4){PKW(pB1, 0), PKW(pB1, 2), PKW(pB1, 4), PKW(pB1, 6)}; pw3 = (u32x4){PKW(pB1, 8), PKW(pB1, 10), PKW(pB1, 12), PKW(pB1, 14)};
    SBAR(); pv_last(o, vb0 + sl_cur, PAF(0), PAF(1), PAF(2), PAF(3)); }
  { auto rr = __builtin_amdgcn_permlane32_swap(__float_as_uint(l_reg), __float_as_uint(l_reg), false, false); l_reg = __uint_as_float(rr[0]) + __uint_as_float(rr[1]); }
  if (hi == 0) wsf[32 + r32] = l_reg; asm volatile("s_waitcnt lgkmcnt(0)" ::: "memory");
  float rli[16];
#pragma unroll
  for (int r = 0; r < 16; ++r) rli[r] = __builtin_amdgcn_rcpf(wsf[32 + crow(r, hi)]);
  asm volatile("s_waitcnt lgkmcnt(0)\n\ts_barrier" ::: "memory");
  LAS float* buf = (LAS float*)shm;
  if (comp == 1) {
#pragma unroll
    for (int r = 0; r < 16; ++r) { const int orow = wq * QBLK + crow(r, hi);
#pragma unroll
      for (int d0 = 0; d0 < 4; ++d0) buf[orow * 128 + d0 * 32 + r32] = o[d0][r] * rli[r] * lam; }
  }
  asm volatile("s_waitcnt lgkmcnt(0)\n\ts_barrier" ::: "memory");
  if (comp == 0) {
#pragma unroll
    for (int r = 0; r < 16; ++r) { const int orow = wq * QBLK + crow(r, hi);
#pragma unroll
      for (int d0 = 0; d0 < 4; ++d0) { const int ix = orow * 128 + d0 * 32 + r32; buf[ix] = o[d0][r] * rli[r] - buf[ix]; } }
  }
  asm volatile("s_waitcnt lgkmcnt(0)\n\ts_barrier" ::: "memory");
  { const float g0 = g_subln[lane * 2] * out_scale, g1 = g_subln[lane * 2 + 1] * out_scale;
#pragma unroll 4
    for (int i = 0; i < 16; ++i) { const int row = wid * 16 + i; const f32x2 v = *(const LAS f32x2*)(buf + row * 128 + lane * 2);
      const float ss = wave_sum(v.x * v.x + v.y * v.y); const float rstd = 1.0f / sqrtf(ss * (1.0f / 128.0f) + EPS);
      *(unsigned*)(CAT + (size_t)(qb * 128 + row) * DM + head * 128 + lane * 2) = pk2(v.x * rstd * g0, v.y * rstd * g1); } }
  asm volatile("s_waitcnt vmcnt(0) lgkmcnt(0)\n\ts_barrier" ::: "memory");
  if (wid >= 4) __builtin_amdgcn_s_setprio(0);
#undef DMA_K
#undef DMA_V
#undef DMAK1
#undef DMAK2
#undef DMAV1
#undef DMAV2
#undef START
#undef RESC
#undef ROT
#undef PKW
#undef PAF
#undef VFR
#undef PIN
#undef MX3
#undef GAPA
#undef GAPB
#undef EX
#undef VRD
#undef KRD
#undef PVS
#undef STEP
#undef ENDW
}
#undef SBAR
#undef WAIT_BAR
}

namespace fft {
constexpr int XST = 72, ZST = 136, LDS_X = 0, LDS_Z = 2 * 128 * XST * 2, LDS_A1 = LDS_Z + 2 * 64 * ZST * 2, LDS_A2 = LDS_A1 + 128 * 136 * 2;
__device__ __forceinline__ int crow(int r, int hi) { return (r & 3) + 8 * (r >> 2) + 4 * hi; }
__device__ __forceinline__ void fft_phase(const bf16_t* __restrict__ WCT, bf16_t* __restrict__ FB, const bf16_t* __restrict__ A1T, const bf16_t* __restrict__ A2T, const float* __restrict__ TW, char* lds, int G) {
  const int tid = threadIdx.x, wid = tid >> 6, lane = tid & 63, r32 = lane & 31, hi = lane >> 5;
  bf16_t* Xs = (bf16_t*)(lds + LDS_X); bf16_t* Zs = (bf16_t*)(lds + LDS_Z);
  const int mb = wid & 3, nbp = wid >> 2;
  bf16x8 a2[8];
  bf16_t* A1s = (bf16_t*)(lds + LDS_A1);
#pragma unroll
  for (int q = 0; q < 4; ++q) { const int i = tid + 512 * q, row = i >> 4, c8 = (i & 15) * 8; *(u32x4*)(A1s + row * 136 + c8) = *(const u32x4*)(A1T + row * 128 + c8); }
#pragma unroll
  for (int ks = 0; ks < 8; ++ks) a2[ks] = *(const bf16x8*)(A2T + (32 * mb + r32) * 256 + 16 * (ks + 8) + 8 * hi);
  bf16_t* A2s = (bf16_t*)(lds + LDS_A2);
#pragma unroll
  for (int q = 0; q < 4; ++q) { const int i = tid + 512 * q, row = i >> 4, c8 = (i & 15) * 8; *(u32x4*)(A2s + row * 136 + c8) = *(const u32x4*)(A2T + row * 256 + c8); }
  f32x2 tw[2][8];
#pragma unroll
  for (int nbi = 0; nbi < 2; ++nbi)
#pragma unroll
    for (int q = 0; q < 8; ++q) { const int k1 = 16 * mb + 4 * (q >> 1) + 2 * hi + (q & 1), t2 = 32 * (2 * nbp + nbi) + r32; tw[nbi][q] = *(const f32x2*)(TW + 2 * (k1 * 128 + t2)); }
  const int k1o = 32 * nbp + r32;
#define FFT_LOADX(cp) do { const bf16_t* src = WCT + (size_t)(2 * (cp)) * 8192; \
        _Pragma("unroll") for (int pass = 0; pass < 4; ++pass) { const int p = tid + 512 * pass, ri = p >> 10, e = (p & 1023) * 8; pv[pass] = *(const u32x4*)(src + (size_t)ri * 8192 + e); } } while (0)
#define FFT_COLUMN(ncp, hasn, neg, OUT) do { \
      { _Pragma("unroll") for (int pass = 0; pass < 4; ++pass) { const int p = tid + 512 * pass, ri = p >> 10, e = (p & 1023) * 8, t2 = e >> 6, t1 = e & 63; \
          *(u32x4*)(Xs + (ri * 128 + t2) * XST + t1) = pv[pass]; } } \
      const unsigned sgn = (neg) ? 0x80008000u : 0u; \
      __syncthreads(); \
      if (hasn) FFT_LOADX(ncp); \
      f32x16 acc[2]; acc[0] = f32x16{}; acc[1] = f32x16{}; \
      _Pragma("unroll") for (int ks = 0; ks < 8; ++ks) \
        _Pragma("unroll") for (int nbi = 0; nbi < 2; ++nbi) { const int t2 = 32 * (2 * nbp + nbi) + r32; \
          u32x4 bw = *(const u32x4*)(Xs + ((ks >> 2) * 128 + t2) * XST + (ks & 3) * 16 + 8 * hi); if (ks >= 4) { bw.x ^= sgn; bw.y ^= sgn; bw.z ^= sgn; bw.w ^= sgn; } const bf16x8 bfr = __builtin_bit_cast(bf16x8, bw); \
          acc[nbi] = __builtin_amdgcn_mfma_f32_32x32x16_bf16(*(const bf16x8*)(A1s + (32 * mb + r32) * 136 + 16 * ks + 8 * hi), bfr, acc[nbi], 0, 0, 0); } \
      _Pragma("unroll") for (int nbi = 0; nbi < 2; ++nbi) { const int t2 = 32 * (2 * nbp + nbi) + r32; \
        _Pragma("unroll") for (int q = 0; q < 8; ++q) { const float yr = acc[nbi][2 * q], yi = acc[nbi][2 * q + 1]; const f32x2 cs = tw[nbi][q]; \
          const int k1 = 16 * mb + 4 * (q >> 1) + 2 * hi + (q & 1); \
          Zs[k1 * ZST + t2] = (bf16_t)f2bf(yr * cs.x + yi * cs.y); Zs[(64 + k1) * ZST + t2] = (bf16_t)f2bf(yi * cs.x - yr * cs.y); } } \
      __syncthreads(); \
      OUT = f32x16{}; \
      _Pragma("unroll") for (int ks = 0; ks < 16; ++ks) { const bf16x8 bfr = *(const bf16x8*)(Zs + ((ks >> 3) * 64 + k1o) * ZST + (ks & 7) * 16 + 8 * hi); \
        OUT = __builtin_amdgcn_mfma_f32_32x32x16_bf16(ks < 8 ? *(const bf16x8*)(A2s + (32 * mb + r32) * 136 + 16 * ks + 8 * hi) : a2[ks & 7], bfr, OUT, 0, 0, 0); } } while (0)
#define FB_AT(col, k) (FB + ((size_t)((col) >> 3) * 8192 + (k)) * 8 + ((col) & 7))
  constexpr float SC = 1.0f / 2048.0f;
  for (int unit = blockIdx.x; unit < 256; unit += G) {
    const int g = unit >> 6, cb = unit & 63;
    bf16_t* fb = FB + (size_t)(g * 64 + cb) * 8192 * 8;
    auto cpof = [&](int c) { return (c <= 255) ? g * 256 + c : (c == 256 ? 1024 + g : g * 256 + (512 - c)); };
    u32x4 pv[4];
    FFT_LOADX(cpof(8 * cb));
#pragma unroll 1
    for (int half = 0; half < 2; ++half) { u32x2 o[16];
#pragma unroll
      for (int jp = 0; jp < 2; ++jp) { f32x16 ea, eb;
        { const int c = 8 * cb + 4 * half + 2 * jp; const bool ng = c > 256; FFT_COLUMN(cpof(c + 1), true, ng, ea); }
        { const int c = 8 * cb + 4 * half + 2 * jp + 1; const bool ng = c > 256; const bool hn = (c & 7) != 7; FFT_COLUMN(cpof(c + 1), hn, ng, eb); }
#pragma unroll
        for (int r = 0; r < 16; ++r) o[r][jp] = pk2(ea[r] * SC, eb[r] * SC); }
#pragma unroll
      for (int r = 0; r < 16; ++r) { const int k = k1o + 64 * (32 * mb + crow(r, hi)); *(u32x2*)(fb + (size_t)k * 8 + 4 * half) = o[r]; } }
  }
#undef FFT_LOADX
#undef FFT_COLUMN
#undef FB_AT
  __syncthreads();
}
}

struct Args {
    const float *x, *c, *ctx, *c_ctx, *w_mod, *b_mod, *g_mix, *g_ffn, *w_in, *w_out, *lq1, *lk1, *lq2, *lk2, *g_subln, *ln_g, *ln_b, *w_sp, *b_sp, *w_fo, *w_r, *w_gate, *w_up, *w_down, *g_final;
    float* out; unsigned char* ws; int lo, hi;
};


struct Ctx {
    const LAS unsigned long long* PT;
    __device__ __forceinline__ const void* ld(int i) const { const unsigned long long v = PT[i]; const unsigned l = __builtin_amdgcn_readfirstlane((unsigned)v), h = __builtin_amdgcn_readfirstlane((unsigned)(v >> 32));
        return (const void*)(const GAS void*)(((unsigned long long)h << 32) | l); }
    __device__ __forceinline__ const float* x() const { return (const float*)ld(0); }
    __device__ __forceinline__ const float* c() const { return (const float*)ld(1); }
    __device__ __forceinline__ const float* ctx() const { return (const float*)ld(2); }
    __device__ __forceinline__ const float* c_ctx() const { return (const float*)ld(3); }
    __device__ __forceinline__ const float* w_mod() const { return (const float*)ld(4); }
    __device__ __forceinline__ const float* b_mod() const { return (const float*)ld(5); }
    __device__ __forceinline__ const float* g_mix() const { return (const float*)ld(6); }
    __device__ __forceinline__ const float* g_ffn() const { return (const float*)ld(7); }
    __device__ __forceinline__ const float* w_in() const { return (const float*)ld(8); }
    __device__ __forceinline__ const float* w_out() const { return (const float*)ld(9); }
    __device__ __forceinline__ const float* lq1() const { return (const float*)ld(10); }
    __device__ __forceinline__ const float* lk1() const { return (const float*)ld(11); }
    __device__ __forceinline__ const float* lq2() const { return (const float*)ld(12); }
    __device__ __forceinline__ const float* lk2() const { return (const float*)ld(13); }
    __device__ __forceinline__ const float* g_subln() const { return (const float*)ld(14); }
    __device__ __forceinline__ const float* ln_g() const { return (const float*)ld(15); }
    __device__ __forceinline__ const float* ln_b() const { return (const float*)ld(16); }
    __device__ __forceinline__ const float* w_sp() const { return (const float*)ld(17); }
    __device__ __forceinline__ const float* b_sp() const { return (const float*)ld(18); }
    __device__ __forceinline__ const float* w_fo() const { return (const float*)ld(19); }
    __device__ __forceinline__ const float* w_r() const { return (const float*)ld(20); }
    __device__ __forceinline__ const float* w_gate() const { return (const float*)ld(21); }
    __device__ __forceinline__ const float* w_up() const { return (const float*)ld(22); }
    __device__ __forceinline__ const float* w_down() const { return (const float*)ld(23); }
    __device__ __forceinline__ const float* g_final() const { return (const float*)ld(24); }
    __device__ __forceinline__ float* out() const { return (float*)ld(25); }
    __device__ __forceinline__ unsigned char* ws() const { return (unsigned char*)ld(26); }
};

__device__ __forceinline__ void transpose_item(const float* W, int K, int N, bf16_t* WT, int row_off, int ilv, LAS float* scr, int item, int lane) {
    const int nblk = N / 32, kb = item / nblk, nb = item % nblk, k0 = 64 * kb, n0 = 32 * nb;
#pragma unroll 8
    for (int i = 0; i < 32; ++i) { const int kk = 2 * i + (lane >> 5); scr[kk * 33 + (lane & 31)] = __builtin_nontemporal_load(W + (size_t)(k0 + kk) * N + n0 + (lane & 31)); }
    asm volatile("s_waitcnt lgkmcnt(0)" ::: "memory");
    const int c = lane & 7;
#pragma unroll
    for (int j = 0; j < 4; ++j) { const int n = (lane >> 3) + 8 * j; const LAS float* s = scr + (8 * c) * 33 + n;
        u32x4 o; o.x = pk2(s[0 * 33], s[1 * 33]); o.y = pk2(s[2 * 33], s[3 * 33]); o.z = pk2(s[4 * 33], s[5 * 33]); o.w = pk2(s[6 * 33], s[7 * 33]);
        const int ng = n0 + n, drow = row_off + (ilv ? ((ng >> 7) * 256 + (ng & 127)) : ng);
        *(u32x4*)(WT + (size_t)drow * K + k0 + 8 * c) = o; }
    asm volatile("s_waitcnt lgkmcnt(0)" ::: "memory");
}
struct CvtItem { const float* src; bf16_t* dst; int N, K, row_off, ilv, k0, n0; };
__device__ __forceinline__ void cvt_load(const CvtItem& d, f32x4 (&v)[8], int lane) {
    const float* p = d.src + (size_t)(d.k0 + (lane >> 3)) * d.N + d.n0 + (lane & 7) * 4;
#pragma unroll
    for (int q = 0; q < 8; ++q) v[q] = __builtin_nontemporal_load((const f32x4*)(p + (size_t)(8 * q) * d.N));
}
__device__ __forceinline__ void cvt_store(const CvtItem& d, const f32x4 (&v)[8], LAS float* scr, int lane) {
    const int rr = lane >> 3, c4 = (lane & 7) * 4;
#pragma unroll
    for (int q = 0; q < 8; ++q) { LAS float* t = scr + (8 * q + rr) * 33 + c4; t[0] = v[q].x; t[1] = v[q].y; t[2] = v[q].z; t[3] = v[q].w; }
    asm volatile("s_waitcnt lgkmcnt(0)" ::: "memory");
    const int c = lane & 7;
#pragma unroll
    for (int j = 0; j < 4; ++j) { const int n = (lane >> 3) + 8 * j; const LAS float* s = scr + (8 * c) * 33 + n;
        u32x4 o; o.x = pk2(s[0 * 33], s[1 * 33]); o.y = pk2(s[2 * 33], s[3 * 33]); o.z = pk2(s[4 * 33], s[5 * 33]); o.w = pk2(s[6 * 33], s[7 * 33]);
        const int ng = d.n0 + n, drow = d.row_off + (d.ilv ? ((ng >> 7) * 256 + (ng & 127)) : ng);
        __builtin_nontemporal_store(o, (u32x4*)(d.dst + (size_t)drow * d.K + d.k0 + 8 * c)); }
    asm volatile("s_waitcnt lgkmcnt(0)" ::: "memory");
}
constexpr int MOE_ITEMS = NE * (2 * (DM / 64) * (FE / 32) + (FE / 64) * (DM / 32));
__device__ __forceinline__ void convert_moe_items(const Ctx& a, int layer, LAS unsigned char* lds, int it0, int it1, int widx, int nw, int wave, int lane) {
    LAS float* scr = (LAS float*)(lds + wave * 16384);
    bf16_t* WGU = (bf16_t*)(a.ws() + WS_WGU + (size_t)layer * WGU_BYTES); bf16_t* WD = (bf16_t*)(a.ws() + WS_WD + (size_t)layer * WD_BYTES);
    constexpr int I_G = (DM / 64) * (FE / 32), I_D = (FE / 64) * (DM / 32);
    constexpr int PER_E = 2 * I_G + I_D;
    const float *wg = a.w_gate(), *wu = a.w_up(), *wd = a.w_down();
    auto decode = [&](int it) { CvtItem d; const int e = it / PER_E; int r = it % PER_E; const size_t eo = ((size_t)layer * NE + e) * (size_t)DM * FE;
        if (r < I_G)          { d.src = wg + eo; d.dst = WGU; d.N = FE; d.K = DM; d.row_off = e * 2048; d.ilv = 1; }
        else if (r < 2 * I_G) { r -= I_G; d.src = wu + eo; d.dst = WGU; d.N = FE; d.K = DM; d.row_off = e * 2048 + 128; d.ilv = 1; }
        else                  { r -= 2 * I_G; d.src = wd + eo; d.dst = WD; d.N = DM; d.K = FE; d.row_off = e * 2048; d.ilv = 0; }
        const int nblk = d.N / 32; d.k0 = 64 * (r / nblk); d.n0 = 32 * (r % nblk); return d; };
    int it = it0 + widx;
    if (it >= it1) return;
    f32x4 va[8], vb[8]; CvtItem da = decode(it), db = da; bool hb = (it + nw < it1);
    cvt_load(da, va, lane);
    if (hb) { db = decode(it + nw); cvt_load(db, vb, lane); }
    for (;;) {
        cvt_store(da, va, scr, lane);
        it += 2 * nw; const bool ha = (it < it1);
        if (ha) { da = decode(it); cvt_load(da, va, lane); }
        if (!hb) break;
        cvt_store(db, vb, scr, lane);
        hb = (it + nw < it1);
        if (hb) { db = decode(it + nw); cvt_load(db, vb, lane); }
        if (!ha) break;
    }
}
constexpr int L0_A = 12288, L0_B = 20480, L1_A = 45056;
__device__ __forceinline__ void p0_prologue(const Ctx& a, LAS unsigned char* lds, int G) {
    const int tid = threadIdx.x, lane = tid & 63, wave = __builtin_amdgcn_readfirstlane(tid >> 6);
    float* MODL = (float*)(a.ws() + WS_MODL); float* MODC = (float*)(a.ws() + WS_MODC);
    {
        LAS float* s_l = (LAS float*)lds; LAS float* s_c = s_l + 2048; LAS float* red = s_c + 2048;
        for (int k = tid; k < 2048; k += NTHR) { const float v = a.c()[k], w = a.c_ctx()[k]; s_l[k] = v / (1.0f + __expf(-v)); s_c[k] = w / (1.0f + __expf(-w)); }
        __syncthreads();
        const int cg = tid % 24, kg = tid / 24;
        for (int u = blockIdx.x; u < 256; u += G) {
            const int layer = u >> 7, n0 = (u & 127) * 96;
            f32x4 al = (f32x4){0.f, 0.f, 0.f, 0.f}, ac = al;
            if (kg < 21) {
                const float* W = a.w_mod() + (size_t)layer * DM * 12288 + n0 + 4 * cg;
#pragma unroll 8
                for (int k = kg; k < 2048; k += 21) { const f32x4 w = __builtin_nontemporal_load((const f32x4*)(W + (size_t)k * 12288)); al += s_l[k] * w; ac += s_c[k] * w; }
#pragma unroll
                for (int j = 0; j < 4; ++j) { red[(kg * 96 + 4 * cg + j) * 2] = al[j]; red[(kg * 96 + 4 * cg + j) * 2 + 1] = ac[j]; }
            }
            __syncthreads();
            if (tid < 96) { float sl = 0.f, sc = 0.f;
                for (int q = 0; q < 21; ++q) { sl += red[(q * 96 + tid) * 2]; sc += red[(q * 96 + tid) * 2 + 1]; }
                const float b = a.b_mod()[layer * 12288 + n0 + tid];
                MODL[layer * 12288 + n0 + tid] = sl + b;
                if (layer == 0 && n0 + tid < 4096) MODC[n0 + tid] = sc + b; }
            __syncthreads();
        }
    }
    {
        LAS float* tab = (LAS float*)lds;
        for (int j = tid; j < 8192; j += NTHR) tab[j] = cospif((float)j * (1.0f / 4096.0f));
        __syncthreads();
        const int gt = blockIdx.x * NTHR + tid, NT_ = G * NTHR;
        float* RC = (float*)(a.ws() + WS_ROPE); float* RS = RC + 128 * 16;
        for (int i = gt; i < 128 * 16; i += NT_) { const int pos = i >> 4, j = i & 15; const float inv = powf(10000.0f, -(float)j * (1.0f / 16.0f)); const float ang = (float)pos * inv; RC[i] = cosf(ang); RS[i] = sinf(ang); }
        bf16_t* CS = (bf16_t*)(a.ws() + WS_CS);
        for (int i = gt; i < 512 * 512; i += NT_) { const int r = i >> 9, d = i & 511, m = r >> 1, ri = r & 1; const int j = (((m * d) & 511) * 16 + (ri ? 2048 : 0)) & 8191; CS[i] = (bf16_t)f2bf(tab[j]); }
        bf16_t* A1 = (bf16_t*)(a.ws() + WS_A1);
        for (int i = gt; i < 128 * 128; i += NT_) { const int m1 = i >> 7, k = i & 127, k1 = m1 >> 1, rp = m1 & 1, ri = k >> 6, t1 = k & 63; int j = ((t1 * k1) & 63) * 128;
            if (rp == 0 && ri == 1) j -= 2048; if (rp == 1 && ri == 0) j += 2048; A1[i] = (bf16_t)f2bf(tab[j & 8191]); }
        bf16_t* A2 = (bf16_t*)(a.ws() + WS_A2);
        for (int i = gt; i < 128 * 256; i += NT_) { const int k2 = i >> 8, k = i & 255, ri = k >> 7, t2 = k & 127; int j = ((t2 * k2) & 127) * 64; if (ri) j -= 2048; A2[i] = (bf16_t)f2bf(tab[j & 8191]); }
        float* TW = (float*)(a.ws() + WS_TW);
        for (int i = gt; i < 64 * 128; i += NT_) { const int k1 = i >> 7, t2 = i & 127, j = t2 * k1; TW[2 * i] = tab[j]; TW[2 * i + 1] = tab[(j - 2048) & 8191]; }
        __syncthreads();
    }
    {
        const int gw = blockIdx.x * NWAVES + wave, NGW = G * NWAVES;
        LAS float* scr = (LAS float*)(lds + wave * 16384);
        constexpr int I_IN = (DM / 64) * (INC / 32), I_SQ = (DM / 64) * (DM / 32);
        for (int it = gw; it < I_IN + 2 * I_SQ; it += NGW) {
            int r = it;
            if (r < I_IN) { transpose_item(a.w_in(), DM, INC, (bf16_t*)(a.ws() + WS_WIN), 0, 0, scr, r, lane); continue; } r -= I_IN;
            if (r < I_SQ) { transpose_item(a.w_out(), DM, DM, (bf16_t*)(a.ws() + WS_WOUT), 0, 0, scr, r, lane); continue; } r -= I_SQ;
            transpose_item(a.w_fo(), DM, DM, (bf16_t*)(a.ws() + WS_WFO), 0, 0, scr, r, lane);
        }
        convert_moe_items(a, 0, lds, 0, L0_A, gw, NGW, wave, lane);
    }
}

__device__ __forceinline__ void norm_mod_row(const float* xrow, const float* gain, const float* shift, const float* scale, bf16_t* orow, int lane) {
    f32x4 v[8]; float ss = 0.f;
#pragma unroll
    for (int j = 0; j < 8; ++j) { v[j] = *(const f32x4*)(xrow + j * 256 + lane * 4); ss += (v[j].x * v[j].x + v[j].y * v[j].y) + (v[j].z * v[j].z + v[j].w * v[j].w); }
    const float rstd = 1.0f / sqrtf(wave_sum(ss) * (1.0f / DM) + EPS);
#pragma unroll
    for (int j = 0; j < 8; ++j) { const int c = j * 256 + lane * 4; const f32x4 g = *(const f32x4*)(gain + c), sh = *(const f32x4*)(shift + c), sc = *(const f32x4*)(scale + c);
        const f32x4 y = v[j] * rstd * g * (1.0f + sc) + sh;
        u32x2 w; w.x = pk2(y.x, y.y); w.y = pk2(y.z, y.w); *(u32x2*)(orow + c) = w; }
}

__device__ __forceinline__ void router_phase(const Ctx& a, int layer, LAS unsigned char* lds, int G) {
    const int tid = threadIdx.x, lane = tid & 63, wave = __builtin_amdgcn_readfirstlane(tid >> 6);
    constexpr int ROWB = 4112;
    LAS unsigned char* XT = lds; LAS float* RS = (LAS float*)(lds + 32 * ROWB); LAS float* PART = (LAS float*)lds;
    const _Float16* X = (const _Float16*)(a.ws() + WS_X); bf16_t* H2 = (bf16_t*)(a.ws() + WS_H2); float* AFF = (float*)(a.ws() + WS_AFF);
    const float* mod = (const float*)(a.ws() + WS_MODL) + layer * 12288; const float* gain = a.g_ffn() + layer * DM;
    const int m = lane & 15, kq = lane >> 4;
    int unit = blockIdx.x;
    f16x4 nx[4][8];
    if (unit < SEQ / 32) {
#pragma unroll
        for (int i = 0; i < 4; ++i) {
#pragma unroll
            for (int j = 0; j < 8; ++j) nx[i][j] = *(const f16x4*)(X + (size_t)(unit * 32 + wave * 4 + i) * DM + j * 256 + lane * 4); } }
    f32x4 ca[8], cb[8];
#pragma unroll
    for (int j = 0; j < 8; ++j) { const int c = j * 256 + lane * 4; ca[j] = *(const f32x4*)(gain + c) * (1.0f + *(const f32x4*)(mod + 4 * DM + c)); cb[j] = *(const f32x4*)(mod + 3 * DM + c); }
    const float bias = ((const float*)(a.ws() + WS_WRB))[layer * 16 + m];
    for (; unit < SEQ / 32; unit += G) {
        const int r0 = unit * 32 + wave * 4;
#pragma unroll
        for (int i = 0; i < 4; ++i) {
            const int row = r0 + i; f32x4 v[8]; float ss = 0.f;
            LAS unsigned char* xt = XT + (wave * 4 + i) * ROWB + lane * 8;
#pragma unroll
            for (int j = 0; j < 8; ++j) { *(LAS f16x4*)(xt + j * 512) = nx[i][j]; v[j] = __builtin_convertvector(nx[i][j], f32x4);
                ss += (v[j].x * v[j].x + v[j].y * v[j].y) + (v[j].z * v[j].z + v[j].w * v[j].w); }
            { const int nrow = (unit + G) * 32 + wave * 4 + i;
              if (nrow < SEQ) {
#pragma unroll
                for (int j = 0; j < 8; ++j) nx[i][j] = *(const f16x4*)(X + (size_t)nrow * DM + j * 256 + lane * 4); } }
            asm volatile("" ::: "memory");
            const float rstd = 1.0f / sqrtf(wave_sum(ss) * (1.0f / DM) + EPS);
            if (lane == 0) RS[wave * 4 + i] = rstd;
#pragma unroll
            for (int j = 0; j < 8; ++j) { const int c = j * 256 + lane * 4;
                const f32x4 h = v[j] * rstd * ca[j] + cb[j];
                u32x2 w; w.x = pk2(h.x, h.y); w.y = pk2(h.z, h.w); *(u32x2*)(H2 + (size_t)row * DM + c) = w; }
        }
        f16x8 bh[8], bl[8];
        { const f16x8* WRP = (const f16x8*)(a.ws() + WS_WRP) + (size_t)layer * 2 * 4096 + wave * 512 + lane;
#pragma unroll
          for (int s = 0; s < 8; ++s) { bh[s] = WRP[s * 64]; bl[s] = WRP[4096 + s * 64]; } }
        __syncthreads();
        f32x4 acc0 = {0.f, 0.f, 0.f, 0.f}, acc1 = {0.f, 0.f, 0.f, 0.f};
        { const LAS unsigned char* ap = XT + m * ROWB + (wave * 256 + kq * 8) * 2;
#pragma unroll
          for (int s = 0; s < 8; ++s) { const f16x8 a0 = *(const LAS f16x8*)(ap + s * 64), a1 = *(const LAS f16x8*)(ap + 16 * ROWB + s * 64);
            acc0 = __builtin_amdgcn_mfma_f32_16x16x32_f16(a0, bh[s], acc0, 0, 0, 0); acc0 = __builtin_amdgcn_mfma_f32_16x16x32_f16(a0, bl[s], acc0, 0, 0, 0);
            acc1 = __builtin_amdgcn_mfma_f32_16x16x32_f16(a1, bh[s], acc1, 0, 0, 0); acc1 = __builtin_amdgcn_mfma_f32_16x16x32_f16(a1, bl[s], acc1, 0, 0, 0); } }
        __syncthreads();
        *(LAS f32x4*)(PART + ((wave * 2 + 0) * 64 + lane) * 4) = acc0; *(LAS f32x4*)(PART + ((wave * 2 + 1) * 64 + lane) * 4) = acc1;
        __syncthreads();
        { const int mt = wave >> 2, r = wave & 3; float sum = 0.f;
#pragma unroll
          for (int w = 0; w < 8; ++w) sum += PART[((w * 2 + mt) * 64 + lane) * 4 + r];
          const int lr = 16 * mt + 4 * kq + r;
          const float lg = sum * (RS[lr] * (1.0f / 64.0f)) + bias;
          float mx = lg; mx = fmaxf(mx, dpp_f(mx, 0)); mx = fmaxf(mx, dpp_f(mx, 1)); mx = fmaxf(mx, dpp_f(mx, 2)); mx = fmaxf(mx, dpp_f(mx, 3));
          const float pe = expf(lg - mx); float sm = pe; sm += dpp_f(sm, 0); sm += dpp_f(sm, 1); sm += dpp_f(sm, 2); sm += dpp_f(sm, 3);
          AFF[(size_t)m * SEQ + unit * 32 + lr] = pe * (1.0f / sm); }
        __syncthreads();
    }
}

__device__ __forceinline__ void topk_expert(const Ctx& a, int e, LAS unsigned char* lds) {
    const int tid = threadIdx.x, lane = tid & 63;
    LAS unsigned* hist = (LAS unsigned*)lds; LAS unsigned* bc = hist + 256; LAS unsigned* cg = bc + 16; LAS unsigned* ce = cg + 512;
    const float* aff = (const float*)(a.ws() + WS_AFF) + (size_t)e * SEQ;
    int* IDX = (int*)(a.ws() + WS_IDX) + e * CAP; float* GATE = (float*)(a.ws() + WS_GATE) + e * CAP; int* POS = (int*)(a.ws() + WS_POS) + (size_t)e * SEQ;
    unsigned key[16];
#pragma unroll
    for (int j = 0; j < 4; ++j) { const u32x4 v = *(const u32x4*)(aff + tid * 16 + j * 4); key[4 * j] = v.x; key[4 * j + 1] = v.y; key[4 * j + 2] = v.z; key[4 * j + 3] = v.w; }
    unsigned prefix = 0u, mask = 0u, remaining = CAP;
    for (int pass = 0; pass < 4; ++pass) {
        const int shift = 24 - 8 * pass;
        if (tid < 256) hist[tid] = 0u;
        __syncthreads();
#pragma unroll
        for (int j = 0; j < 16; ++j) if ((key[j] & mask) == prefix) __hip_atomic_fetch_add(&hist[(key[j] >> shift) & 255u], 1u, __ATOMIC_RELAXED, __HIP_MEMORY_SCOPE_WORKGROUP);
        __syncthreads();
        if (tid < 64) {
            const unsigned h0 = hist[255 - 4 * lane], h1 = hist[254 - 4 * lane], h2 = hist[253 - 4 * lane], h3 = hist[252 - 4 * lane];
            const unsigned s = h0 + h1 + h2 + h3; unsigned inc = s;
#pragma unroll
            for (int o = 1; o < 64; o <<= 1) { const unsigned v = __shfl_up(inc, o); if (lane >= o) inc += v; }
            const unsigned exc = inc - s;
            if (exc < remaining && remaining <= inc) {
                unsigned c = exc; unsigned b;
                if (c + h0 >= remaining) b = 255 - 4 * lane;
                else { c += h0; if (c + h1 >= remaining) b = 254 - 4 * lane; else { c += h1; if (c + h2 >= remaining) b = 253 - 4 * lane; else { c += h2; b = 252 - 4 * lane; } } }
                bc[0] = b; bc[1] = remaining - c;
            }
        }
        __syncthreads();
        prefix |= bc[0] << shift; mask |= 255u << shift; remaining = bc[1];
        __syncthreads();
    }
    const unsigned T = prefix, need = remaining;
    unsigned ngt = 0u, neq = 0u;
#pragma unroll
    for (int j = 0; j < 16; ++j) { ngt += key[j] > T ? 1u : 0u; neq += key[j] == T ? 1u : 0u; }
    cg[tid] = ngt; ce[tid] = neq;
    __syncthreads();
    if (tid < 64) {
        unsigned av[8], bv[8], sa = 0u, sb = 0u;
#pragma unroll
        for (int q = 0; q < 8; ++q) { av[q] = cg[lane * 8 + q]; bv[q] = ce[lane * 8 + q]; sa += av[q]; sb += bv[q]; }
        unsigned ia = sa, ib = sb;
#pragma unroll
        for (int o = 1; o < 64; o <<= 1) { const unsigned va = __shfl_up(ia, o), vb = __shfl_up(ib, o); if (lane >= o) { ia += va; ib += vb; } }
        unsigned ea = ia - sa, eb = ib - sb;
#pragma unroll
        for (int q = 0; q < 8; ++q) { cg[lane * 8 + q] = ea; ea += av[q]; ce[lane * 8 + q] = eb; eb += bv[q]; }
        if (lane == 63) bc[2] = ia;
    }
    __syncthreads();
    unsigned og = cg[tid], oe = ce[tid]; const unsigned tg = bc[2];
#pragma unroll
    for (int j = 0; j < 16; ++j) { const int token = tid * 16 + j; int slot = -1;
        if (key[j] > T) slot = (int)(og++);
        else if (key[j] == T) { if (oe < need) slot = (int)(tg + oe); ++oe; }
        POS[token] = slot;
        if (slot >= 0) { IDX[slot] = token; GATE[slot] = __uint_as_float(key[j]); } }
    __syncthreads();
}

__device__ __forceinline__ void combine_phase(const Ctx& a, int layer, int G) {
    const int tid = threadIdx.x, lane = tid & 63, wave = __builtin_amdgcn_readfirstlane(tid >> 6);
    _Float16* X = (_Float16*)(a.ws() + WS_X); const bf16_t* Y = (const bf16_t*)(a.ws() + WS_Y); const int* POS = (const int*)(a.ws() + WS_POS);
    const float* modl = (const float*)(a.ws() + WS_MODL);
    const float* gf = modl + layer * 12288 + 5 * DM;
    const int gw = blockIdx.x * NWAVES + wave, NGW = G * NWAVES;
    int pl[4]; f16x4 nx[4][8];
#pragma unroll
    for (int i = 0; i < 4; ++i) { const int row = gw + i * NGW; pl[i] = -1;
        if (row < SEQ) { pl[i] = (lane < NE) ? POS[(size_t)lane * SEQ + row] : -1;
#pragma unroll
            for (int j = 0; j < 8; ++j) nx[i][j] = *(const f16x4*)(X + (size_t)row * DM + j * 256 + lane * 4); } }
    for (int base = gw; base < SEQ; base += 4 * NGW) {
#pragma unroll
      for (int i = 0; i < 4; ++i) { const int row = base + i * NGW;
       if (row < SEQ) {
        _Float16* xr = X + (size_t)row * DM; f32x4 v[8], sum[8];
        const int plc = pl[i]; unsigned long long sel = __ballot(plc >= 0);
#pragma unroll
        for (int j = 0; j < 8; ++j) { v[j] = __builtin_convertvector(nx[i][j], f32x4); sum[j] = (f32x4){0.f, 0.f, 0.f, 0.f}; }
        { const int nrow = row + 4 * NGW;
          if (nrow < SEQ) { pl[i] = (lane < NE) ? POS[(size_t)lane * SEQ + nrow] : -1;
#pragma unroll
            for (int j = 0; j < 8; ++j) nx[i][j] = *(const f16x4*)(X + (size_t)nrow * DM + j * 256 + lane * 4); } }
        while (sel) { const int e0 = __builtin_ctzll(sel); sel &= sel - 1;
            const bf16_t* y0 = Y + (size_t)(e0 * CAP + __builtin_amdgcn_readlane(plc, e0)) * DM + lane * 4;
            u32x2 w0[8];
#pragma unroll
            for (int j = 0; j < 8; ++j) w0[j] = *(const u32x2*)(y0 + j * 256);
#pragma unroll
            for (int j = 0; j < 8; ++j) sum[j] += (f32x4){bflo(w0[j].x), bfhi(w0[j].x), bflo(w0[j].y), bfhi(w0[j].y)}; }
        float ss = 0.f;
#pragma unroll
        for (int j = 0; j < 8; ++j) { const int c = j * 256 + lane * 4; v[j] = v[j] + *(const f32x4*)(gf + c) * sum[j];
            ss += (v[j].x * v[j].x + v[j].y * v[j].y) + (v[j].z * v[j].z + v[j].w * v[j].w); }
        const float rstd = 1.0f / sqrtf(wave_sum(ss) * (1.0f / DM) + EPS);
        if (layer == 0) {
            bf16_t* orow = (bf16_t*)(a.ws() + WS_HCAT) + (size_t)row * DM; const float* m1 = modl + 12288; const float* gain = a.g_mix() + DM;
            float nyq[4] = {0.f, 0.f, 0.f, 0.f};
#pragma unroll
            for (int j = 0; j < 8; ++j) { const int c = j * 256 + lane * 4; stx4(xr + c, v[j]);
                const f32x4 y = v[j] * rstd * *(const f32x4*)(gain + c) * (1.0f + *(const f32x4*)(m1 + DM + c)) + *(const f32x4*)(m1 + c);
                u32x2 w; w.x = pk2(y.x, y.y); w.y = pk2(y.z, y.w); *(u32x2*)(orow + c) = w;
                nyq[j >> 1] += (bflo(w.x) - bfhi(w.x)) + (bflo(w.y) - bfhi(w.y)); }
            { bf16_t* WCT = (bf16_t*)(a.ws() + WS_WCT); const int n = (row & 127) * 64 + (row >> 7);
                float mine = 0.f;
#pragma unroll
                for (int g = 0; g < 4; ++g) { const float sg = wave_sum(nyq[g]); mine = (lane == g) ? sg : mine; }
                if (lane < 4) { WCT[(size_t)(2048 + 2 * lane) * 8192 + n] = (bf16_t)f2bf(mine); WCT[(size_t)(2049 + 2 * lane) * 8192 + n] = 0; } }
        } else {
            float* orow = a.out() + (size_t)row * DM;
#pragma unroll
            for (int j = 0; j < 8; ++j) { const int c = j * 256 + lane * 4; *(f32x4*)(orow + c) = v[j] * rstd * *(const f32x4*)(a.g_final() + c); }
        }
       } }
    }
}

#define PHASE_FN static __device__ __forceinline__ void
#define PH_PRO extern __shared__ __attribute__((aligned(16))) unsigned char lds_raw[]; LAS unsigned char* lds = (LAS unsigned char*)lds_raw; (void)lds; \
    const int tid = threadIdx.x, lane = tid & 63, wave = __builtin_amdgcn_readfirstlane(tid >> 6), G = gridDim.x; (void)lane; (void)wave; \
    Ctx a; a.PT = (const LAS unsigned long long*)(lds + LDSCTL_OFF + 64); const int gw = blockIdx.x * NWAVES + wave, NGW = G * NWAVES; (void)gw; (void)NGW;

__device__ __forceinline__ void router_prep(const Ctx& a, int nb, int tid, int lane, int wave) {
    const float* MODL = (const float*)(a.ws() + WS_MODL);
    for (int it = blockIdx.x * NTHR + tid; it < 2 * 4096; it += nb * NTHR) { const int layer = it >> 12, kc = (it >> 4) & 255, n = it & 15;
        const float* w_r = a.w_r() + (size_t)layer * DM * NE; const float* gain = a.g_ffn() + layer * DM; const float* sc = MODL + layer * 12288 + 4 * DM;
        f16x8 hi, lo;
#pragma unroll
        for (int i = 0; i < 8; ++i) { const int c = kc * 8 + i; const float wv = 64.0f * gain[c] * (1.0f + sc[c]) * w_r[c * NE + n];
            const _Float16 h = (_Float16)wv; hi[i] = h; lo[i] = (_Float16)(wv - (float)h); }
        f16x8* WRP = (f16x8*)(a.ws() + WS_WRP) + (size_t)layer * 2 * 4096;
        WRP[kc * 16 + n] = hi; WRP[4096 + kc * 16 + n] = lo; }
    const int gwb = blockIdx.x * NWAVES + wave, ngw = nb * NWAVES;
    if (gwb >= ngw - 32 && gwb < ngw) { const int q = gwb - (ngw - 32), layer = q >> 4, e = q & 15;
        const float* w_r = a.w_r() + (size_t)layer * DM * NE; const float* sh = MODL + layer * 12288 + 3 * DM; float acc = 0.f;
#pragma unroll 8
        for (int i = 0; i < 32; ++i) { const int c = lane + 64 * i; acc = fmaf(sh[c], w_r[c * NE + e], acc); }
        acc = wave_sum(acc);
        if (lane == 0) ((float*)(a.ws() + WS_WRB))[q] = acc; }
}
PHASE_FN ph_prologue() { PH_PRO; p0_prologue(a, lds, G); }
PHASE_FN ph_hcat() { PH_PRO;
    const float* MODL = (const float*)(a.ws() + WS_MODL); const float* MODC = (const float*)(a.ws() + WS_MODC); bf16_t* HCAT = (bf16_t*)(a.ws() + WS_HCAT);
    const float* ctx = a.ctx(); const float* x = a.x(); const float* gm = a.g_mix();
    f32x4 nx[4][8];
#pragma unroll
    for (int i = 0; i < 4; ++i) { const int row = gw + i * NGW;
        if (row < SEQ) {
#pragma unroll
            for (int j = 0; j < 8; ++j) nx[i][j] = __builtin_nontemporal_load((const f32x4*)(x + (size_t)row * DM + j * 256 + lane * 4)); } }
    for (int r = blockIdx.x; r < CTXL; r += G) { LAS float* red = (LAS float*)lds; const int c = wave * 256 + lane * 4;
        const f32x4 cv = *(const f32x4*)(ctx + (size_t)r * DM + c), g4 = *(const f32x4*)(gm + c), s4 = *(const f32x4*)(MODC + DM + c), h4 = *(const f32x4*)(MODC + c);
        const float ps = wave_sum((cv.x * cv.x + cv.y * cv.y) + (cv.z * cv.z + cv.w * cv.w));
        if (lane == 0) red[wave] = ps;
        __syncthreads();
        float tot = 0.f;
#pragma unroll
        for (int w = 0; w < NWAVES; ++w) tot += red[w];
        const float rstd = 1.0f / sqrtf(tot * (1.0f / DM) + EPS);
        const f32x4 y = cv * rstd * g4 * (1.0f + s4) + h4;
        u32x2 w; w.x = pk2(y.x, y.y); w.y = pk2(y.z, y.w); *(u32x2*)(HCAT + (size_t)r * DM + c) = w;
        __syncthreads(); }
    for (int base = gw; base < SEQ; base += 4 * NGW) {
#pragma unroll
        for (int i = 0; i < 4; ++i) { const int row = base + i * NGW;
            if (row < SEQ) {
                float ss = 0.f;
#pragma unroll
                for (int j = 0; j < 8; ++j) { const f32x4 t = nx[i][j]; ss += (t.x * t.x + t.y * t.y) + (t.z * t.z + t.w * t.w); }
                const float rstd = 1.0f / sqrtf(wave_sum(ss) * (1.0f / DM) + EPS);
                bf16_t* orow = HCAT + (size_t)(CTXL + row) * DM;
#pragma unroll
                for (int j = 0; j < 8; ++j) { const int c = j * 256 + lane * 4; const f32x4 y = nx[i][j] * rstd * (*(const f32x4*)(gm + c) * (1.0f + *(const f32x4*)(MODL + DM + c))) + *(const f32x4*)(MODL + c);
                    u32x2 w; w.x = pk2(y.x, y.y); w.y = pk2(y.z, y.w); *(u32x2*)(orow + c) = w; }
                const int nrow = row + 4 * NGW;
                if (nrow < SEQ) {
#pragma unroll
                    for (int j = 0; j < 8; ++j) nx[i][j] = __builtin_nontemporal_load((const f32x4*)(x + (size_t)nrow * DM + j * 256 + lane * 4)); }
            } }
    }
}
PHASE_FN ph_win() { PH_PRO;
    unsigned char* ws = a.ws();
    const pg8::Geo g = pg8::geo_rowmajor(ws + WS_HCAT, DM, ws + WS_WIN, DM, DM);
    pg8::WinOrder S; S.init_win(G, (int)blockIdx.x);
    pg8::EpiWin E{(bf16_t*)(ws + WS_Q), (bf16_t*)(ws + WS_K), (bf16_t*)(ws + WS_V), (bf16_t*)(ws + WS_UV), (const float*)(ws + WS_ROPE), (const float*)(ws + WS_ROPE) + 128 * 16};
    pg8::gemm_phase<pg8::EpiWin, pg8::WinOrder, true, true>(lds, g, S, E);
    { const int nu = S.total(), maxu = (nu + G - 1) / G, nfull = nu - (maxu - 1) * G;
      if ((int)blockIdx.x >= nfull && nfull < G) convert_moe_items(a, 0, lds, L0_B, MOE_ITEMS, ((int)blockIdx.x - nfull) * NWAVES + wave, (G - nfull) * NWAVES, wave, lane);
      else if (nfull >= G) { convert_moe_items(a, 0, lds, L0_B, MOE_ITEMS, gw, NGW, wave, lane); router_prep(a, G, tid, lane, wave); }
      else router_prep(a, nfull, tid, lane, wave); }
}
PHASE_FN ph_attn() { PH_PRO;
    unsigned char* ws = a.ws();
    float lam;
    { const float q1 = a.lq1()[lane] * a.lk1()[lane], q2 = a.lq2()[lane] * a.lk2()[lane]; lam = expf(wave_sum(q1)) - expf(wave_sum(q2)) + 0.2f; }
    const float* gs = a.g_subln();
    for (int i = blockIdx.x; i < 512; i += G)
        att2::attn_unit<8>((const bf16_t*)(ws + WS_Q), (const bf16_t*)(ws + WS_K), (const bf16_t*)(ws + WS_V), (bf16_t*)(ws + WS_CAT), i & 7, i >> 3, lam, 0.8f, gs, lds);
}
PHASE_FN ph_sgu() { PH_PRO;
    unsigned char* ws = a.ws();
    const float *w_sp = a.w_sp(), *b_sp = a.b_sp(), *ln_g = a.ln_g(), *ln_b = a.ln_b();
    for (int i = blockIdx.x; i < 512; i += G)
        att::sgu_unit((const bf16_t*)(ws + WS_UV), (bf16_t*)(ws + WS_CAT), w_sp, b_sp, ln_g, ln_b, i >> 3, i & 7, (char*)lds_raw);
}
PHASE_FN ph_wout() { PH_PRO;
    unsigned char* ws = a.ws();
    const int GH = (G >= 2) ? G / 2 : G;
    if ((int)blockIdx.x < GH) {
        const pg8::Geo g = pg8::geo_rowmajor(ws + WS_CAT, DM, ws + WS_WOUT, DM, DM);
        pg8::StaticOrder S; S.init(SEQ, DM, GH, (int)blockIdx.x);
        pg8::EpiResidN<true> E{a.x(), (_Float16*)(ws + WS_X), (const float*)(ws + WS_MODL) + 2 * DM};
        pg8::gemm_phase<pg8::EpiResidN<true>, pg8::StaticOrder, true, true>(lds, g, S, E);
        if (GH == G) convert_moe_items(a, 1, lds, 0, L1_A, gw, NGW, wave, lane);
    } else convert_moe_items(a, 1, lds, 0, L1_A, ((int)blockIdx.x - GH) * NWAVES + wave, (G - GH) * NWAVES, wave, lane);
}
PHASE_FN ph_stepa() { PH_PRO;
    unsigned char* ws = a.ws();
    pg8::Geo g = pg8::geo_rowmajor(ws + WS_CS, 512, ws + WS_HCAT, DM, 512);
    g.aB = 1024;
    g.bmode = 1; g.hB = (size_t)2 * g.ldb2; g.tB = (size_t)4 * g.ldb2;
    pg8::StepAOrder S{G, (int)blockIdx.x};
    pg8::EpiBf16 E{(bf16_t*)(ws + WS_WCT), SEQ, 512};
    pg8::gemm_phase<pg8::EpiBf16, pg8::StepAOrder, true, true>(lds, g, S, E);
}
PHASE_FN ph_dft() { PH_PRO;
    unsigned char* ws = a.ws();
    fft::fft_phase((const bf16_t*)(ws + WS_WCT), (bf16_t*)(ws + WS_F), (const bf16_t*)(ws + WS_A1), (const bf16_t*)(ws + WS_A2), (const float*)(ws + WS_TW), (char*)lds_raw, G);
}
PHASE_FN ph_wfo() { PH_PRO;
    unsigned char* ws = a.ws();
    pg8::Geo g = pg8::geo_rowmajor(ws + WS_F, DM, ws + WS_WFO, DM, DM);
    g.amode = 1; g.kA = 8 * 131072; g.hA = 2048; g.tA = 4096;
    pg8::StaticOrder S; S.init(SEQ, DM, G, (int)blockIdx.x);
    pg8::EpiResid<false> E{(const void*)(ws + WS_X), (_Float16*)(ws + WS_X), (const float*)(ws + WS_MODL) + 12288 + 2 * DM};
    pg8::gemm_phase<pg8::EpiResid<false>, pg8::StaticOrder, true, true>(lds, g, S, E);
}
PHASE_FN ph_router(int layer) { PH_PRO; router_phase(a, layer, lds, G); }
PHASE_FN ph_topk(int layer) { PH_PRO; for (int e = blockIdx.x; e < NE; e += G) topk_expert(a, e, lds);
    if ((int)blockIdx.x >= NE || G <= NE) { const int widx = (G <= NE) ? gw : ((int)blockIdx.x - NE) * NWAVES + wave, nw = (G <= NE) ? NGW : (G - NE) * NWAVES;
        if (layer == 0) convert_moe_items(a, 0, lds, L0_A, L0_B, widx, nw, wave, lane); else convert_moe_items(a, 1, lds, L1_A, MOE_ITEMS, widx, nw, wave, lane); } }
PHASE_FN ph_gather() { PH_PRO;
    unsigned char* ws = a.ws();
    const int* IDX = (const int*)(ws + WS_IDX); const bf16_t* H2 = (const bf16_t*)(ws + WS_H2); bf16_t* XS = (bf16_t*)(ws + WS_XS);
    for (int r = gw; r < MR; r += NGW) { const int t = IDX[r]; const u32x4* s = (const u32x4*)(H2 + (size_t)t * DM) + lane; u32x4* d = (u32x4*)(XS + (size_t)r * DM) + lane;
#pragma unroll
        for (int j = 0; j < 4; ++j) d[64 * j] = s[64 * j]; }
}
PHASE_FN ph_gateup(int layer) { PH_PRO;
    unsigned char* ws = a.ws();
    pg8::Geo g = pg8::geo_rowmajor(ws + WS_H2, DM, ws + WS_WGU + (size_t)layer * WGU_BYTES, DM, DM);
    g.aB = (size_t)2048 * DM * 2; g.hA = 0; g.tA = 0;
    pg8::MoeOrder S; S.init(MR, 2048, G, (int)blockIdx.x);
    pg8::EpiGateUp E{(bf16_t*)(ws + WS_ACT)};
    pg8::gemm_phase<pg8::EpiGateUp, pg8::MoeOrder, true, true, true>(lds, g, S, E, (const int*)(ws + WS_IDX));
}
PHASE_FN ph_down(int layer) { PH_PRO;
    unsigned char* ws = a.ws();
    pg8::Geo g = pg8::geo_rowmajor(ws + WS_ACT, FE, ws + WS_WD + (size_t)layer * WD_BYTES, FE, FE);
    g.aB = (size_t)2048 * FE * 2;
    pg8::MoeOrder S; S.init(MR, DM, G, (int)blockIdx.x);
    pg8::EpiDown E{(bf16_t*)(ws + WS_Y), (const float*)(ws + WS_GATE)};
    pg8::gemm_phase<pg8::EpiDown, pg8::MoeOrder, true, true>(lds, g, S, E);
}
PHASE_FN ph_combine(int layer) { PH_PRO; combine_phase(a, layer, G); }

__global__ void __launch_bounds__(NTHR, 2) fwd(Args ka) {
    extern __shared__ __attribute__((aligned(16))) unsigned char lds_raw[];
    LAS unsigned char* lds = (LAS unsigned char*)lds_raw;
    const int tid = threadIdx.x;
    const int lo = ka.lo, hi = ka.hi;
    for (int u = tid; u < 16; u += NTHR) ((LAS unsigned*)(lds + LDSCTL_OFF))[u] = 0u;
    LAS unsigned long long* PTW = (LAS unsigned long long*)(lds + LDSCTL_OFF + 64);
    if (tid == 0) {
        PTW[0] = (unsigned long long)ka.x;
        PTW[1] = (unsigned long long)ka.c;
        PTW[2] = (unsigned long long)ka.ctx;
        PTW[3] = (unsigned long long)ka.c_ctx;
        PTW[4] = (unsigned long long)ka.w_mod;
        PTW[5] = (unsigned long long)ka.b_mod;
        PTW[6] = (unsigned long long)ka.g_mix;
        PTW[7] = (unsigned long long)ka.g_ffn;
        PTW[8] = (unsigned long long)ka.w_in;
        PTW[9] = (unsigned long long)ka.w_out;
        PTW[10] = (unsigned long long)ka.lq1;
        PTW[11] = (unsigned long long)ka.lk1;
        PTW[12] = (unsigned long long)ka.lq2;
        PTW[13] = (unsigned long long)ka.lk2;
        PTW[14] = (unsigned long long)ka.g_subln;
        PTW[15] = (unsigned long long)ka.ln_g;
        PTW[16] = (unsigned long long)ka.ln_b;
        PTW[17] = (unsigned long long)ka.w_sp;
        PTW[18] = (unsigned long long)ka.b_sp;
        PTW[19] = (unsigned long long)ka.w_fo;
        PTW[20] = (unsigned long long)ka.w_r;
        PTW[21] = (unsigned long long)ka.w_gate;
        PTW[22] = (unsigned long long)ka.w_up;
        PTW[23] = (unsigned long long)ka.w_down;
        PTW[24] = (unsigned long long)ka.g_final;
        PTW[25] = (unsigned long long)ka.out; PTW[26] = (unsigned long long)ka.ws;
    }
    __syncthreads();
    XcdBarrier bar; bar.bar = (unsigned*)(ka.ws + WS_CTL); bar.x = 0; bar.st = nullptr;
    if (hi - lo > 1) bar = xcd_barrier_post((unsigned*)(ka.ws + WS_CTL), (volatile LAS unsigned*)(lds + LDSCTL_OFF));
#ifndef PHMASK
#define PHMASK 0xFFFFFFu
#endif
#define IN(k) (((PHMASK >> ((k) == 21 ? 3 : (k) == 22 ? 10 : (k))) & 1u) && lo <= ((k) == 21 ? 3 : (k) == 22 ? 10 : (k)) && ((k) == 21 ? 3 : (k) == 22 ? 10 : (k)) < hi)
#define SEAM(k) do { if (IN(k) && IN((k) + 1)) xcd_barrier(bar); } while (0)
#ifndef TPROBE
#define TPROBE -1
#endif
#ifndef TSIDE
#define TSIDE 0
#endif
#ifndef TAMP
#define TAMP 9
#endif
#define RUNPH(k, call) do { if (IN(k)) { if (TPROBE == (k)) { const unsigned long long t0_ = __builtin_amdgcn_s_memrealtime(); call; __syncthreads(); \
        const unsigned long long t1_ = __builtin_amdgcn_s_memrealtime(); const bool on_ = TSIDE == 0 || (TSIDE == 1 ? (int)blockIdx.x < (int)gridDim.x / 2 : (int)blockIdx.x >= (int)gridDim.x / 2); \
        if (on_) { const unsigned long long end_ = t1_ + (unsigned long long)TAMP * (t1_ - t0_); while (__builtin_amdgcn_s_memrealtime() < end_) __builtin_amdgcn_s_sleep(8); } } else { call; } } } while (0)
    RUNPH(0, ph_prologue());             SEAM(0);
    RUNPH(1, ph_hcat());                 SEAM(1);
    RUNPH(2, ph_win());                  SEAM(2);
    RUNPH(3, ph_attn());                 RUNPH(21, ph_sgu()); SEAM(3);
    RUNPH(4, ph_wout());                 SEAM(4);
    RUNPH(5, ph_router(0));              SEAM(5);
    RUNPH(6, ph_topk(0));                if (IN(6) && IN(8)) xcd_barrier(bar);
    RUNPH(8, ph_gateup(0));              SEAM(8);
    RUNPH(9, ph_down(0));                SEAM(9);
    RUNPH(10, ph_combine(0));            SEAM(10);
    RUNPH(11, ph_stepa());               SEAM(11);
    RUNPH(12, ph_dft());                 SEAM(12);
    RUNPH(13, ph_wfo());                 SEAM(13);
    RUNPH(14, ph_router(1));             SEAM(14);
    RUNPH(15, ph_topk(1));               if (IN(15) && IN(17)) xcd_barrier(bar);
    RUNPH(17, ph_gateup(1));             SEAM(17);
    RUNPH(18, ph_down(1));               SEAM(18);
    RUNPH(19, ph_combine(1));
#undef RUNPH
#undef IN
#undef SEAM
}

extern "C" void kernel_launch(void* const* d_in, const int* in_sizes, int n_in, void* d_out, int out_size, void* d_ws, size_t ws_size, hipStream_t stream) {
    static int grid = 0;
    if (grid == 0) {
        if (n_in != 25 || in_sizes[0] != SEQ * DM || out_size != SEQ * DM || ws_size < WS_END) {
            fprintf(stderr, "kernel_launch: unexpected shapes: n_in %d in0 %d out %d ws %zu (need %zu)\n", n_in, n_in > 0 ? in_sizes[0] : -1, out_size, ws_size, (size_t)WS_END); grid = -1; return; }
        int dev = 0, cus = 0, per_cu = 0;
        if (hipGetDevice(&dev) != hipSuccess || hipDeviceGetAttribute(&cus, hipDeviceAttributeMultiprocessorCount, dev) != hipSuccess) { grid = -1; return; }
        if (hipFuncSetAttribute((const void*)fwd, hipFuncAttributeMaxDynamicSharedMemorySize, LDS_BYTES) != hipSuccess) { fprintf(stderr, "kernel_launch: hipFuncSetAttribute failed\n"); grid = -1; return; }
        if (hipOccupancyMaxActiveBlocksPerMultiprocessor(&per_cu, (const void*)fwd, NTHR, LDS_BYTES) != hipSuccess || per_cu < 1) fprintf(stderr, "kernel_launch: occupancy query says %d\n", per_cu);
        (void)hipGetLastError();
        grid = cus;
    }
    if (grid < 0) return;
    (void)hipMemsetAsync((char*)d_ws + WS_CTL, 0, CTL_BYTES, stream);
    Args a{};
    const float** p = (const float**)&a;
    for (int i = 0; i < 25; ++i) p[i] = (const float*)d_in[i];
    a.out = (float*)d_out; a.ws = (unsigned char*)d_ws;
#ifndef ONE_LAUNCH
    for (int ph = 0; ph < NPH; ++ph) { a.lo = ph; a.hi = ph + 1; hipLaunchKernelGGL(fwd, dim3(grid), dim3(NTHR), LDS_BYTES, stream, a); }
#else
    a.lo = 0; a.hi = NPH; hipLaunchKernelGGL(fwd, dim3(grid), dim3(NTHR), LDS_BYTES, stream, a);
#endif
    const hipError_t le = hipPeekAtLastError();
    if (le != hipSuccess) fprintf(stderr, "kernel_launch: launch failed: %s\n", hipGetErrorName(le));
}
```

```cpp
#include <hip/hip_runtime.h>
#include <hip/hip_bf16.h>
#include <cstdio>
#include <cstdint>
#define ONE_LAUNCH 1

#define GAS __attribute__((address_space(1)))
#define LAS __attribute__((address_space(3)))
typedef unsigned short bf16_t;
typedef short bf16x8 __attribute__((ext_vector_type(8)));
typedef short s16x4 __attribute__((ext_vector_type(4)));
typedef float f32x2 __attribute__((ext_vector_type(2)));
typedef float f32x4 __attribute__((ext_vector_type(4)));
typedef float f32x16 __attribute__((ext_vector_type(16)));
typedef unsigned u32x2 __attribute__((ext_vector_type(2)));
typedef _Float16 f16x4 __attribute__((ext_vector_type(4)));
typedef unsigned u32x4 __attribute__((ext_vector_type(4)));
typedef _Float16 f16x8 __attribute__((ext_vector_type(8)));

constexpr int DM = 2048, SEQ = 8192, CTXL = 256, MC = SEQ + CTXL, INC = 5120, NE = 16, CAP = 1024, FE = 1024, MR = NE * CAP;
constexpr float EPS = 1e-6f;
constexpr int NWAVES = 8, NTHR = 512;
constexpr int NPH = 20;

constexpr size_t al256(size_t x) { return (x + 255) / 256 * 256; }
constexpr size_t WS_CTL = 0, CTL_BYTES = 65536;
constexpr size_t WS_MODL = WS_CTL + CTL_BYTES;
constexpr size_t WS_MODC = WS_MODL + 2 * 12288 * 4;
constexpr size_t WS_ROPE = WS_MODC + 4096 * 4;
constexpr size_t WS_CS = WS_ROPE + 2 * 128 * 16 * 4;
constexpr size_t WS_WIN = WS_CS + 1024 * 512 * 2;
constexpr size_t WS_WOUT = WS_WIN + (size_t)INC * DM * 2;
constexpr size_t WS_WFO = WS_WOUT + (size_t)DM * DM * 2;
constexpr size_t WGU_BYTES = (size_t)NE * 2048 * DM * 2, WD_BYTES = (size_t)NE * DM * FE * 2;
constexpr size_t WS_WGU = WS_WFO + (size_t)DM * DM * 2;
constexpr size_t WS_WD = WS_WGU + 2 * WGU_BYTES;
constexpr size_t WS_HCAT = WS_WD + 2 * WD_BYTES;
constexpr size_t WS_Q = WS_HCAT + (size_t)MC * DM * 2;
constexpr size_t WS_K = WS_Q + (size_t)MC * 1024 * 2;
constexpr size_t WS_V = WS_K + (size_t)MC * 1024 * 2;
constexpr size_t WS_UV = WS_V + (size_t)MC * 1024 * 2;
constexpr size_t WS_CAT = WS_UV + (size_t)MC * DM * 2;
constexpr size_t WS_X = WS_CAT + (size_t)SEQ * DM * 2;
constexpr size_t WS_H2 = WS_X + (size_t)SEQ * DM * 4;
constexpr size_t WS_AFF = WS_H2 + (size_t)SEQ * DM * 2;
constexpr size_t WS_IDX = WS_AFF + (size_t)NE * SEQ * 4;
constexpr size_t WS_GATE = WS_IDX + (size_t)MR * 4;
constexpr size_t WS_POS = WS_GATE + (size_t)MR * 4;
constexpr size_t WS_XS = WS_POS + (size_t)NE * SEQ * 4;
constexpr size_t WS_WRP = WS_XS;
constexpr size_t WS_WRB = WS_WRP + 2 * 2 * 4096 * 16;
constexpr size_t WS_ACT = WS_XS + (size_t)MR * DM * 2;
constexpr size_t WS_Y = WS_ACT + (size_t)MR * FE * 2;
constexpr size_t WS_WCT = WS_Y + (size_t)MR * DM * 2;
constexpr size_t WS_F = WS_WCT + (size_t)4096 * 8192 * 2;
constexpr size_t WS_A1 = WS_F + (size_t)SEQ * DM * 2;
constexpr size_t WS_A2 = WS_A1 + 128 * 128 * 2;
constexpr size_t WS_TW = WS_A2 + 128 * 256 * 2;
constexpr size_t WS_END = WS_TW + 64 * 128 * 2 * 4;

constexpr int LDS_BYTES = 147456, LDSCTL_OFF = 146944;

__device__ __forceinline__ unsigned f2bf(float f) { unsigned u = __builtin_bit_cast(unsigned, f); return (u + 0x7fffu + ((u >> 16) & 1u)) >> 16; }
__device__ __forceinline__ unsigned pk2(float lo, float hi) { return f2bf(lo) | (f2bf(hi) << 16); }
__device__ __forceinline__ float bflo(unsigned w) { return __builtin_bit_cast(float, w << 16); }
__device__ __forceinline__ float bfhi(unsigned w) { return __builtin_bit_cast(float, w & 0xffff0000u); }
__device__ __forceinline__ unsigned cvt2_bf16(float lo, float hi) { unsigned r; asm("v_cvt_pk_bf16_f32 %0, %1, %2" : "=v"(r) : "v"(lo), "v"(hi)); return r; }
__device__ __forceinline__ unsigned cvt_pk_bf16(float lo, float hi) { unsigned r; asm volatile("v_cvt_pk_bf16_f32 %0, %1, %2" : "=v"(r) : "v"(lo), "v"(hi)); return r; }
__device__ __forceinline__ float dpp_f(float v, int ctrl_sel) {
    const int x = __builtin_bit_cast(int, v);
    int r;
    switch (ctrl_sel) {
        case 0: r = __builtin_amdgcn_update_dpp(0, x, 0xB1, 0xF, 0xF, true); break;
        case 1: r = __builtin_amdgcn_update_dpp(0, x, 0x4E, 0xF, 0xF, true); break;
        case 2: r = __builtin_amdgcn_update_dpp(0, x, 0x141, 0xF, 0xF, true); break;
        default: r = __builtin_amdgcn_update_dpp(0, x, 0x140, 0xF, 0xF, true); break;
    }
    return __builtin_bit_cast(float, r);
}
__device__ __forceinline__ float wave_sum(float v) {
    v += dpp_f(v, 0); v += dpp_f(v, 1); v += dpp_f(v, 2); v += dpp_f(v, 3);
    { auto rr = __builtin_amdgcn_permlane16_swap(__float_as_uint(v), __float_as_uint(v), false, false); v = __uint_as_float(rr[0]) + __uint_as_float(rr[1]); }
    { auto rr = __builtin_amdgcn_permlane32_swap(__float_as_uint(v), __float_as_uint(v), false, false); v = __uint_as_float(rr[0]) + __uint_as_float(rr[1]); }
    return v;
}
__device__ __forceinline__ f32x4 ldx4(const _Float16* p) { return __builtin_convertvector(*(const f16x4*)p, f32x4); }
__device__ __forceinline__ void stx4(_Float16* p, f32x4 v) { *(f16x4*)p = __builtin_convertvector(v, f16x4); }
__device__ __forceinline__ float wave_max(float v) {
#pragma unroll
    for (int o = 1; o < 64; o <<= 1) v = fmaxf(v, __shfl_xor(v, o));
    return v;
}

#define XB_TMO      128
#define XB_XCNT(j)  (256  + 64 * (j))
#define XB_XSUB(j)  (1280 + 64 * (j))
#define XB_XGEN(j)  (2304 + 64 * (j))
#define XB_TOP      3328
#define XB_TOPGEN   3392
#define XCD_BAR_WORDS 3456
#define XB_SPIN_CAP (1u << 18)
__device__ __forceinline__ unsigned xb_ld(unsigned* p)              { return __hip_atomic_load(p, __ATOMIC_RELAXED, __HIP_MEMORY_SCOPE_AGENT); }
__device__ __forceinline__ unsigned xb_add(unsigned* p, unsigned v) { return __hip_atomic_fetch_add(p, v, __ATOMIC_RELAXED, __HIP_MEMORY_SCOPE_AGENT); }
__device__ __forceinline__ unsigned xb_xcc_id() { return (unsigned)__builtin_amdgcn_s_getreg((3 << 11) | 20) & 0xFu; }
#define XB_SPIN(cond, bar) do { unsigned _sp = 0; while (cond) { __builtin_amdgcn_s_sleep(1); \
    if ((++_sp & 255u) == 0u) { if (xb_ld(&(bar)[XB_TMO])) break; if (_sp > XB_SPIN_CAP) { atomicAdd(&(bar)[XB_TMO], 1u); break; } } } } while (0)
struct XcdBarrier { unsigned* bar; unsigned x; volatile LAS unsigned* st; };
__device__ __forceinline__ XcdBarrier xcd_barrier_post(unsigned* bar, volatile LAS unsigned* st) {
    XcdBarrier b; b.bar = bar; b.x = xb_xcc_id(); b.st = st;
    if (threadIdx.x == 0) (void)xb_add(&bar[XB_XCNT(b.x)], 1u);
    return b;
}
__device__ __forceinline__ void xcd_barrier_complete(unsigned* bar, unsigned x, unsigned& nloc, unsigned& nx) {
    const unsigned G = gridDim.x * gridDim.y * gridDim.z;
    unsigned sum, cnt, mine, sp = 0u;
    for (;;) {
        sum = 0u; cnt = 0u; mine = 0u;
#pragma unroll
        for (unsigned j = 0; j < 16; ++j) { const unsigned c = xb_ld(&bar[XB_XCNT(j)]); sum += c; cnt += (c > 0u) ? 1u : 0u; mine = (j == x) ? c : mine; }
        if (sum == G) break;
        __builtin_amdgcn_s_sleep(1);
        if ((++sp & 255u) == 0u) { if (xb_ld(&bar[XB_TMO])) break; if (sp > XB_SPIN_CAP) { atomicAdd(&bar[XB_TMO], 1u); break; } }
    }
    nloc = mine > 0u ? mine : 1u; nx = cnt > 0u ? cnt : 1u;
}
__device__ __forceinline__ void xcd_barrier(const XcdBarrier& b) {
    asm volatile("s_waitcnt vmcnt(0)" ::: "memory");
    __syncthreads();
    if (threadIdx.x == 0) {
        unsigned* bar = b.bar;
        __builtin_amdgcn_s_waitcnt(0);
        unsigned nloc = b.st[0], nx = b.st[1];
        if (nloc == 0u) { xcd_barrier_complete(bar, b.x, nloc, nx); b.st[0] = nloc; b.st[1] = nx; }
        const unsigned old = xb_add(&bar[XB_XSUB(b.x)], 1u);
        const unsigned gen = old / nloc;
        if (old + 1u == (gen + 1u) * nloc) {
            __builtin_amdgcn_fence(__ATOMIC_RELEASE, "agent");
            asm volatile("s_waitcnt vmcnt(0)" ::: "memory");
            const unsigned og = xb_add(&bar[XB_TOP], 1u);
            const unsigned tg = og / nx;
            if (og + 1u == (tg + 1u) * nx) xb_add(&bar[XB_TOPGEN], 1u);
            else XB_SPIN(xb_ld(&bar[XB_TOPGEN]) == tg, bar);
            __builtin_amdgcn_fence(__ATOMIC_ACQUIRE, "agent");
            xb_add(&bar[XB_XGEN(b.x)], 1u);
            asm volatile("s_waitcnt vmcnt(0)" ::: "memory");
        } else {
            XB_SPIN(xb_ld(&bar[XB_XGEN(b.x)]) == gen, bar);
            __builtin_amdgcn_fence(__ATOMIC_ACQUIRE, "agent");
            asm volatile("s_waitcnt vmcnt(0)" ::: "memory");
        }
    }
    __syncthreads();
}

namespace pg8 {
constexpr int BM = 256, BK = 64, HALF = 128, HTB = HALF * BK * 2, STAGE_BYTES = 8 * HTB, NXCD = 8, WGM = 8;
__host__ __device__ __forceinline__ int lds_byte(int r, int c) { const int st = (r >> 4) * 2 + (c >> 5), rr = r & 15, cc = c & 31, ob = rr * 64 + cc * 2; return st * 1024 + (ob ^ (((ob >> 9) & 1) << 5)); }
__host__ __device__ __forceinline__ void stage_rc(int b, int& R, int& C) { const int st = b / 1024, sb = b % 1024, swz = sb ^ (((sb >> 9) & 1) << 5); R = (st >> 1) * 16 + swz / 64; C = (st & 1) * 32 + (swz % 64) / 2; }
__host__ __device__ __forceinline__ int perm32(int rho) { const int n = rho >> 4, i = rho & 15; return 8 * (i >> 2) + 4 * n + (i & 3); }

struct Unit { int pm, pn, aux; };
struct Geo {
    const char* A; const char* B;
    unsigned lda2, ldb2, kA, kB;
    size_t hA, hB, tA, tB, aA, aB;
    int nt, amode, bmode;
    __device__ __forceinline__ size_t offA(const Unit& u) const { return (size_t)u.pm * tA + (size_t)u.aux * aA; }
    __device__ __forceinline__ size_t offB(const Unit& u) const { return (size_t)u.pn * tB + (size_t)u.aux * aB; }
};
__device__ __forceinline__ Geo geo_rowmajor(const void* A, int lda, const void* B, int ldb, int K) {
    Geo g; g.A = (const char*)A; g.B = (const char*)B; g.lda2 = lda * 2; g.ldb2 = ldb * 2; g.kA = 128; g.kB = 128;
    g.hA = (size_t)128 * lda * 2; g.hB = (size_t)128 * ldb * 2; g.tA = 2 * g.hA; g.tB = 2 * g.hB; g.aA = 0; g.aB = 0; g.nt = K / 64; g.amode = 0; g.bmode = 0; return g;
}

struct StaticOrder {
    int nM, nN, nwg, G, c;
    __device__ void init(int M, int N, int G_, int c_) { nM = M / BM; nN = N / BM; nwg = nM * nN; G = G_; c = c_; }
    __device__ bool next(int i, Unit& u) const {
        const long L = (long)i * G + c; if (L >= nwg) return false;
        int wgid = (int)L; { const int q = nwg / NXCD, r = nwg % NXCD, xcd = wgid % NXCD, off = wgid / NXCD; wgid = (xcd < r ? xcd * (q + 1) : r * (q + 1) + (xcd - r) * q) + off; }
        const int nig = WGM * nN, gid = wgid / nig, fm = gid * WGM, gsz = (nM - fm) < WGM ? (nM - fm) : WGM;
        u.pm = fm + ((wgid % nig) % gsz); u.pn = (wgid % nig) / gsz; u.aux = 0; return true;
    }
    __device__ __forceinline__ void a_ready(const Unit&) const {}
    __device__ __forceinline__ void done(const Unit&) const {}
};
struct WinOrder : StaticOrder {
    __device__ void init_win(int G_, int c_) { init(SEQ, INC, G_, c_); }
    __device__ int total() const { return nwg + 8; }
    __device__ bool next(int i, Unit& u) const {
        const long L = (long)i * G + c;
        if (L < nwg) { StaticOrder::next(i, u); u.pm += 1; return true; }
        if (L < nwg + 8) { u.pm = 0; u.pn = 4 + (int)(L - nwg); u.aux = 0; return true; }
        return false; }
};
struct MoeOrder : StaticOrder {
    __device__ bool next(int i, Unit& u) const { if (!StaticOrder::next(i, u)) return false; u.aux = u.pm >> 2; return true; }
};
struct StepAOrder {
    int G, c;
    __device__ bool next(int i, Unit& u) const { const int L = i * G + c; if (L >= 256) return false; u.aux = L >> 6; const int r = L & 63; u.pm = r & 1; u.pn = r >> 1; return true; }
    __device__ __forceinline__ void a_ready(const Unit&) const {}
    __device__ __forceinline__ void done(const Unit&) const {}
};

template <class Epi, class Sched, bool ALIGN_EPI, bool SP2, bool GATHER = false>
__device__ __forceinline__ void gemm_phase(LAS unsigned char* lds, const Geo g, const Sched& S, const Epi& E, const int* gidx = nullptr) {
    const int tid = threadIdx.x, wid = __builtin_amdgcn_readfirstlane(tid >> 6), lane = tid & 63, wr = wid >> 2, wc = wid & 3, fr = lane & 15, fq = lane >> 4;
    const int nt = g.nt;
    unsigned voffA[2], voffB[2], voffA1[2], nvA0[2], nvA1[2]; int gR[2]; unsigned gC[2];
#pragma unroll
    for (int i = 0; i < 2; ++i) { int R, C; stage_rc(tid * 16 + i * 8192, R, C); const int Rb = Epi::PERM ? ((R & ~31) + perm32(R & 31)) : R; gR[i] = R; gC[i] = (unsigned)C * 2u;
        voffA[i] = g.amode ? (unsigned)(C >> 3) * 131072u + (unsigned)R * 16u : (unsigned)R * g.lda2 + (unsigned)C * 2u;
        voffB[i] = (unsigned)(g.bmode ? ((Rb & 63) * 128 + (Rb >> 6)) : Rb) * g.ldb2 + (unsigned)C * 2u; }
    const size_t kA = g.kA, kB = g.kB, hA = g.hA, hB = g.hB;
    const unsigned ldsw = (unsigned)wid * 1024u;
    const int aoff = lds_byte(wr * 64 + fr, fq * 8), boff = lds_byte(wc * 32 + fr, fq * 8);
#define PG8_GIDX(dst0, dst1, u) do { _Pragma("unroll") for (int _i = 0; _i < 2; ++_i) { \
        dst0[_i] = (unsigned)gidx[(u).pm * BM + gR[_i]] * g.lda2 + gC[_i]; dst1[_i] = (unsigned)gidx[(u).pm * BM + HALF + gR[_i]] * g.lda2 + gC[_i]; } } while (0)
#define PG8_SA(b, h) (((b) * 2 + (h)) * HTB)
#define PG8_SB(b, h) ((4 + (b) * 2 + (h)) * HTB)
#define PG8_STAGE(bufoff, gbase, voff) do { _Pragma("unroll") for (int _i = 0; _i < 2; ++_i) \
        __builtin_amdgcn_global_load_lds((const unsigned*)((const char*)(gbase) + (voff)[_i]), (LAS unsigned*)(lds + (bufoff) + ldsw + _i * 8192), 16, 0, 0); } while (0)
#define PG8_LDA(dst, b, h) do { _Pragma("unroll") for (int m = 0; m < 4; ++m) _Pragma("unroll") for (int k = 0; k < 2; ++k) dst[m][k] = *(const LAS bf16x8*)(lds + PG8_SA(b, h) + aoff + m * 2048 + k * 1024); } while (0)
#define PG8_LDB(dst, b, h) do { _Pragma("unroll") for (int n = 0; n < 2; ++n) _Pragma("unroll") for (int k = 0; k < 2; ++k) dst[n][k] = *(const LAS bf16x8*)(lds + PG8_SB(b, h) + boff + n * 2048 + k * 1024); } while (0)
#define PG8_MMA(ai, bj, At, Bt) do { __builtin_amdgcn_s_setprio(1); _Pragma("unroll") for (int m = 0; m < 4; ++m) _Pragma("unroll") for (int n = 0; n < 2; ++n) _Pragma("unroll") for (int k = 0; k < 2; ++k) \
        acc[ai][bj][m][n] = __builtin_amdgcn_mfma_f32_16x16x32_bf16(Bt[n][k], At[m][k], acc[ai][bj][m][n], 0, 0, 0); __builtin_amdgcn_s_setprio(0); } while (0)
#define PG8_WAIT_V(n) asm volatile("s_waitcnt vmcnt(" #n ")" ::: "memory")
#define PG8_WAIT_L(n) asm volatile("s_waitcnt lgkmcnt(" #n ")" ::: "memory")
#define PG8_BAR __builtin_amdgcn_s_barrier()
#define PG8_SCHED __builtin_amdgcn_sched_barrier(0)
    Unit cur, nxt; int ui = 0;
    if (!S.next(0, cur)) return;
    f32x4 acc[2][2][4][2];
#pragma unroll
    for (int a = 0; a < 2; ++a)
#pragma unroll
        for (int b = 0; b < 2; ++b)
#pragma unroll
            for (int m = 0; m < 4; ++m)
#pragma unroll
                for (int n = 0; n < 2; ++n) acc[a][b][m][n] = (f32x4){0.f, 0.f, 0.f, 0.f};
    bf16x8 At[4][2], B0[2][2], B1[2][2];
    const char* cA = g.A + g.offA(cur); const char* cB = g.B + g.offB(cur);
    S.a_ready(cur);
    if constexpr (GATHER) { PG8_GIDX(voffA, voffA1, cur); } else { voffA1[0] = voffA[0]; voffA1[1] = voffA[1]; }
    if constexpr (SP2) {
        PG8_STAGE(PG8_SB(0, 0), cB, voffB); PG8_STAGE(PG8_SB(0, 1), cB + hB, voffB); PG8_STAGE(PG8_SA(0, 0), cA, voffA); PG8_STAGE(PG8_SA(0, 1), cA + hA, voffA1);
        if (wr == 1) PG8_BAR;
        PG8_WAIT_V(2); PG8_BAR;
        PG8_STAGE(PG8_SB(1, 0), cB + kB, voffB); PG8_STAGE(PG8_SA(1, 0), cA + kA, voffA); PG8_STAGE(PG8_SB(1, 1), cB + hB + kB, voffB);
        PG8_WAIT_V(6); PG8_BAR;
    } else {
        PG8_STAGE(PG8_SB(0, 0), cB, voffB); PG8_STAGE(PG8_SA(0, 0), cA, voffA); PG8_STAGE(PG8_SB(0, 1), cB + hB, voffB); PG8_STAGE(PG8_SA(0, 1), cA + hA, voffA1);
        if (wr == 1) PG8_BAR;
        PG8_WAIT_V(4); PG8_BAR;
        PG8_STAGE(PG8_SB(1, 0), cB + kB, voffB); PG8_STAGE(PG8_SA(1, 0), cA + kA, voffA); PG8_STAGE(PG8_SB(1, 1), cB + hB + kB, voffB);
        PG8_WAIT_V(6); PG8_BAR;
    }
    for (;;) {
        const bool has_next = S.next(ui + 1, nxt);
        const char* nA = has_next ? g.A + g.offA(nxt) : cA; const char* nB = has_next ? g.B + g.offB(nxt) : cB;
        if constexpr (GATHER) { if (has_next) { PG8_GIDX(nvA0, nvA1, nxt); } else { nvA0[0] = voffA[0]; nvA0[1] = voffA[1]; nvA1[0] = voffA1[0]; nvA1[1] = voffA1[1]; } }
        for (int t = 0; t < nt; t += 2) {
            const bool last = (t == nt - 2);
            unsigned sA0[2], sA1[2];
            if constexpr (GATHER) { sA0[0] = last ? nvA0[0] : voffA[0]; sA0[1] = last ? nvA0[1] : voffA[1]; sA1[0] = last ? nvA1[0] : voffA1[0]; sA1[1] = last ? nvA1[1] : voffA1[1]; }
            else { sA0[0] = voffA[0]; sA0[1] = voffA[1]; sA1[0] = voffA[0]; sA1[1] = voffA[1]; }
            const char* a1 = cA + (size_t)(t + 1) * kA;
            const char* a2 = last ? nA : cA + (size_t)(t + 2) * kA; const char* b2 = last ? nB : cB + (size_t)(t + 2) * kB;
            const char* a3 = a2 + kA; const char* b3 = b2 + kB;
            if (last && has_next) S.a_ready(nxt);
            if constexpr (SP2) {
            PG8_LDB(B0, 0, 0); PG8_LDB(B1, 0, 1); PG8_SCHED; PG8_LDA(At, 0, 0); PG8_STAGE(PG8_SA(1, 1), a1 + hA, voffA1);
            PG8_WAIT_V(8); PG8_WAIT_L(0); PG8_BAR; PG8_MMA(0, 0, At, B0); PG8_MMA(0, 1, At, B1); PG8_BAR; PG8_SCHED;
            PG8_LDA(At, 0, 1); PG8_STAGE(PG8_SB(0, 0), b2, voffB); PG8_STAGE(PG8_SB(0, 1), b2 + hB, voffB); PG8_STAGE(PG8_SA(0, 0), a2, sA0);
            PG8_WAIT_V(8); PG8_WAIT_L(0); PG8_BAR; PG8_MMA(1, 0, At, B0); PG8_MMA(1, 1, At, B1); PG8_BAR; PG8_SCHED;
            PG8_LDB(B0, 1, 0); PG8_LDB(B1, 1, 1); PG8_SCHED; PG8_LDA(At, 1, 0); PG8_STAGE(PG8_SA(0, 1), a2 + hA, sA1);
            PG8_WAIT_V(8); PG8_WAIT_L(0); PG8_BAR; PG8_MMA(0, 0, At, B0); PG8_MMA(0, 1, At, B1); PG8_BAR; PG8_SCHED;
            PG8_LDA(At, 1, 1); PG8_STAGE(PG8_SB(1, 0), b3, voffB); PG8_STAGE(PG8_SB(1, 1), b3 + hB, voffB); PG8_STAGE(PG8_SA(1, 0), a3, sA0);
            PG8_WAIT_V(8); PG8_WAIT_L(0); PG8_BAR; PG8_MMA(1, 0, At, B0); PG8_MMA(1, 1, At, B1); PG8_BAR; PG8_SCHED;
            } else {
            PG8_LDB(B0, 0, 0); PG8_SCHED; PG8_LDA(At, 0, 0); PG8_STAGE(PG8_SA(1, 1), a1 + hA, voffA1);
            PG8_WAIT_L(8); PG8_BAR; PG8_WAIT_L(0); PG8_MMA(0, 0, At, B0); PG8_BAR; PG8_SCHED;
            PG8_LDB(B1, 0, 1); PG8_STAGE(PG8_SB(0, 0), b2, voffB);
            PG8_BAR; PG8_WAIT_L(0); PG8_MMA(0, 1, At, B1); PG8_BAR;
            PG8_LDA(At, 0, 1); PG8_STAGE(PG8_SA(0, 0), a2, sA0);
            PG8_BAR; PG8_WAIT_L(0); PG8_MMA(1, 0, At, B0); PG8_BAR; PG8_SCHED;
            PG8_STAGE(PG8_SB(0, 1), b2 + hB, voffB);
            PG8_WAIT_V(6); PG8_BAR; PG8_MMA(1, 1, At, B1); PG8_BAR;
            PG8_LDB(B0, 1, 0); PG8_SCHED; PG8_LDA(At, 1, 0); PG8_STAGE(PG8_SA(0, 1), a2 + hA, sA1);
            PG8_WAIT_L(8); PG8_BAR; PG8_WAIT_L(0); PG8_MMA(0, 0, At, B0); PG8_BAR; PG8_SCHED;
            PG8_LDB(B1, 1, 1); PG8_STAGE(PG8_SB(1, 0), b3, voffB);
            PG8_BAR; PG8_WAIT_L(0); PG8_MMA(0, 1, At, B1); PG8_BAR;
            PG8_LDA(At, 1, 1); PG8_STAGE(PG8_SA(1, 0), a3, sA0);
            PG8_BAR; PG8_WAIT_L(0); PG8_MMA(1, 0, At, B0); PG8_BAR; PG8_SCHED;
            PG8_STAGE(PG8_SB(1, 1), b3 + hB, voffB);
            PG8_WAIT_V(6); PG8_BAR; PG8_MMA(1, 1, At, B1); PG8_BAR;
            }
        }
        if constexpr (ALIGN_EPI) { if (wr == 0) PG8_BAR; }
        E(acc, cur, wr, wc, fr, fq); S.done(cur);
        if (!has_next) break;
#pragma unroll
        for (int a = 0; a < 2; ++a)
#pragma unroll
            for (int b = 0; b < 2; ++b)
#pragma unroll
                for (int m = 0; m < 4; ++m)
#pragma unroll
                    for (int n = 0; n < 2; ++n) acc[a][b][m][n] = (f32x4){0.f, 0.f, 0.f, 0.f};
        cur = nxt; cA = nA; cB = nB; ++ui;
        if constexpr (GATHER) { voffA[0] = nvA0[0]; voffA[1] = nvA0[1]; voffA1[0] = nvA1[0]; voffA1[1] = nvA1[1]; }
        if constexpr (ALIGN_EPI) { if (wr == 1) PG8_BAR; }
    }
    PG8_WAIT_V(0);
    if constexpr (!ALIGN_EPI) { if (wr == 0) PG8_BAR; }
    PG8_BAR;
#undef PG8_GIDX
#undef PG8_SA
#undef PG8_SB
#undef PG8_STAGE
#undef PG8_LDA
#undef PG8_LDB
#undef PG8_MMA
#undef PG8_WAIT_V
#undef PG8_WAIT_L
#undef PG8_BAR
#undef PG8_SCHED
}

typedef f32x4 AccT[2][2][4][2];

__device__ __forceinline__ float gelu_tanh(float x) {
    const float z = x * (1.5957691216f + 0.0713548163f * x * x);
    return x * __builtin_amdgcn_rcpf(1.0f + __builtin_amdgcn_exp2f(-1.4426950409f * z));
}
__device__ __forceinline__ u32x2 pack4(f32x4 v) { u32x2 w; w.x = cvt_pk_bf16(v[0], v[1]); w.y = cvt_pk_bf16(v[2], v[3]); return w; }

constexpr float QSCALE = 0.125f * 1.4426950408889634f;
struct EpiWin {
    static constexpr bool PERM = false;
    bf16_t *Q, *K, *V, *UV; const float* ropec; const float* ropes;
    __device__ __forceinline__ void operator()(const AccT& acc, const Unit& u, int wr, int wc, int fr, int fq) const {
        const int sec = u.pn >> 2, row0 = u.pm * BM + wr * 64 + fr;
        if (sec < 2) {
            bf16_t* O = sec == 0 ? Q : K;
            const int colb = (u.pn & 3) * 256 + wc * 32 + 4 * fq; const bool rope = u.pm >= 1;
#pragma unroll
            for (int ai = 0; ai < 2; ++ai)
#pragma unroll
                for (int m = 0; m < 4; ++m) { const int r = row0 + ai * HALF + m * 16; f32x4 cs = (f32x4){1.f, 1.f, 1.f, 1.f}, sn = (f32x4){0.f, 0.f, 0.f, 0.f};
                    if (rope) { const int t = r - CTXL, pos = (wc & 1) ? (t & 63) : (t >> 6); cs = *(const f32x4*)(ropec + pos * 16 + 4 * fq); sn = *(const f32x4*)(ropes + pos * 16 + 4 * fq); }
                    bf16_t* rowp = O + (size_t)r * 1024 + colb;
#pragma unroll
                    for (int bj = 0; bj < 2; ++bj) { const f32x4 x1 = acc[ai][bj][m][0], x2 = acc[ai][bj][m][1];
                        f32x4 o1 = x1 * cs - x2 * sn, o2 = x2 * cs + x1 * sn;
                        if (sec == 0) { o1 = o1 * QSCALE; o2 = o2 * QSCALE; }
                        *(u32x2*)(rowp + bj * HALF) = pack4(o1); *(u32x2*)(rowp + bj * HALF + 16) = pack4(o2); } }
        } else if (sec == 2) {
            const int colb = (u.pn & 3) * 256 + wc * 32 + 4 * fq;
#pragma unroll
            for (int ai = 0; ai < 2; ++ai)
#pragma unroll
                for (int m = 0; m < 4; ++m) { bf16_t* rowp = V + (size_t)(row0 + ai * HALF + m * 16) * 1024 + colb;
#pragma unroll
                    for (int bj = 0; bj < 2; ++bj)
#pragma unroll
                        for (int n = 0; n < 2; ++n) *(u32x2*)(rowp + bj * HALF + n * 16) = pack4(acc[ai][bj][m][n]); }
        } else {
            const int colb = (u.pn - 12) * 256 + wc * 32 + 4 * fq;
#pragma unroll
            for (int ai = 0; ai < 2; ++ai)
#pragma unroll
                for (int m = 0; m < 4; ++m) { bf16_t* rowp = UV + (size_t)(row0 + ai * HALF + m * 16) * 2048 + colb;
#pragma unroll
                    for (int bj = 0; bj < 2; ++bj)
#pragma unroll
                        for (int n = 0; n < 2; ++n) { f32x4 v = acc[ai][bj][m][n];
#pragma unroll
                            for (int j = 0; j < 4; ++j) v[j] = gelu_tanh(v[j]);
                            *(u32x2*)(rowp + bj * HALF + n * 16) = pack4(v); } }
        }
    }
};
template <bool XIN_F32> struct EpiResidN {
    static constexpr bool PERM = false;
    const void* Xin; _Float16* Xout; const float* gate;
    __device__ __forceinline__ void operator()(const AccT& acc, const Unit& u, int wr, int wc, int fr, int fq) const {
        const int row0 = u.pm * BM + wr * 64 + fr, col0 = u.pn * BM + wc * 32 + 4 * fq;
        f32x4 gv[2][2];
#pragma unroll
        for (int bj = 0; bj < 2; ++bj)
#pragma unroll
            for (int n = 0; n < 2; ++n) gv[bj][n] = *(const f32x4*)(gate + col0 + bj * HALF + n * 16);
#pragma unroll
        for (int ai = 0; ai < 2; ++ai)
#pragma unroll
            for (int m = 0; m < 4; ++m) { const size_t ro = (size_t)(row0 + ai * HALF + m * 16) * DM + col0;
#pragma unroll
                for (int bj = 0; bj < 2; ++bj)
#pragma unroll
                    for (int n = 0; n < 2; ++n) { const size_t o = ro + bj * HALF + n * 16;
                        const f32x4 xi = XIN_F32 ? *(const f32x4*)((const float*)Xin + o) : ldx4((const _Float16*)Xin + o);
                        stx4(Xout + o, xi + gv[bj][n] * acc[ai][bj][m][n]); } }
    }
};
template <bool XIN_F32> struct EpiResid {
    static constexpr bool PERM = true;
    const void* Xin; _Float16* Xout; const float* gate;
    __device__ __forceinline__ void operator()(const AccT& acc, const Unit& u, int wr, int wc, int fr, int fq) const {
        const int row0 = u.pm * BM + wr * 64 + fr, col0 = u.pn * BM + wc * 32 + 8 * fq;
        f32x4 gv[2][2];
#pragma unroll
        for (int bj = 0; bj < 2; ++bj)
#pragma unroll
            for (int n = 0; n < 2; ++n) gv[bj][n] = *(const f32x4*)(gate + col0 + bj * HALF + n * 4);
#pragma unroll
        for (int ai = 0; ai < 2; ++ai)
#pragma unroll
            for (int m = 0; m < 4; ++m) { const size_t ro = (size_t)(row0 + ai * HALF + m * 16) * DM + col0;
#pragma unroll
                for (int bj = 0; bj < 2; ++bj) { const size_t o = ro + bj * HALF; f32x4 x0, x1;
                    if (XIN_F32) { x0 = *(const f32x4*)((const float*)Xin + o); x1 = *(const f32x4*)((const float*)Xin + o + 4); }
                    else { const f16x8 h = *(const f16x8*)((const _Float16*)Xin + o);
                        x0 = __builtin_convertvector(__builtin_shufflevector(h, h, 0, 1, 2, 3), f32x4); x1 = __builtin_convertvector(__builtin_shufflevector(h, h, 4, 5, 6, 7), f32x4); }
                    const f16x4 r0 = __builtin_convertvector(x0 + gv[bj][0] * acc[ai][bj][m][0], f16x4), r1 = __builtin_convertvector(x1 + gv[bj][1] * acc[ai][bj][m][1], f16x4);
                    *(f16x8*)(Xout + o) = __builtin_shufflevector(r0, r1, 0, 1, 2, 3, 4, 5, 6, 7); } }
    }
};
struct EpiBf16 {
    static constexpr bool PERM = true;
    bf16_t* O; int ldc; int aux_rows;
    __device__ __forceinline__ void operator()(const AccT& acc, const Unit& u, int wr, int wc, int fr, int fq) const {
        const int row0 = u.aux * aux_rows + u.pm * BM + wr * 64 + fr, col0 = u.pn * BM + wc * 32 + 8 * fq;
#pragma unroll
        for (int ai = 0; ai < 2; ++ai)
#pragma unroll
            for (int m = 0; m < 4; ++m) { bf16_t* rowp = O + (size_t)(row0 + ai * HALF + m * 16) * ldc + col0;
#pragma unroll
                for (int bj = 0; bj < 2; ++bj) { const f32x4 v0 = acc[ai][bj][m][0], v1 = acc[ai][bj][m][1];
                    u32x4 w; w.x = cvt_pk_bf16(v0[0], v0[1]); w.y = cvt_pk_bf16(v0[2], v0[3]); w.z = cvt_pk_bf16(v1[0], v1[1]); w.w = cvt_pk_bf16(v1[2], v1[3]);
                    *(u32x4*)(rowp + bj * HALF) = w; } }
    }
};
struct EpiGateUp {
    static constexpr bool PERM = true;
    bf16_t* ACT;
    __device__ __forceinline__ void operator()(const AccT& acc, const Unit& u, int wr, int wc, int fr, int fq) const {
        const int row0 = u.pm * BM + wr * 64 + fr, col0 = u.pn * 128 + wc * 32 + 8 * fq;
#pragma unroll
        for (int ai = 0; ai < 2; ++ai)
#pragma unroll
            for (int m = 0; m < 4; ++m) { bf16_t* rowp = ACT + (size_t)(row0 + ai * HALF + m * 16) * FE + col0;
                f32x4 o[2];
#pragma unroll
                for (int n = 0; n < 2; ++n) { const f32x4 gt = acc[ai][0][m][n], up = acc[ai][1][m][n];
#pragma unroll
                    for (int j = 0; j < 4; ++j) o[n][j] = gt[j] * up[j] * __builtin_amdgcn_rcpf(1.0f + __builtin_amdgcn_exp2f(-1.4426950409f * gt[j])); }
                u32x4 w; w.x = cvt_pk_bf16(o[0][0], o[0][1]); w.y = cvt_pk_bf16(o[0][2], o[0][3]); w.z = cvt_pk_bf16(o[1][0], o[1][1]); w.w = cvt_pk_bf16(o[1][2], o[1][3]);
                *(u32x4*)rowp = w; }
    }
};
struct EpiDown {
    static constexpr bool PERM = true;
    bf16_t* Y; const float* gate;
    __device__ __forceinline__ void operator()(const AccT& acc, const Unit& u, int wr, int wc, int fr, int fq) const {
        const int row0 = u.pm * BM + wr * 64 + fr, col0 = u.pn * BM + wc * 32 + 8 * fq;
#pragma unroll
        for (int ai = 0; ai < 2; ++ai)
#pragma unroll
            for (int m = 0; m < 4; ++m) { const int r = row0 + ai * HALF + m * 16; const float gr = gate[r]; bf16_t* rowp = Y + (size_t)r * DM + col0;
#pragma unroll
                for (int bj = 0; bj < 2; ++bj) { const f32x4 v0 = acc[ai][bj][m][0] * gr, v1 = acc[ai][bj][m][1] * gr;
                    u32x4 w; w.x = cvt_pk_bf16(v0[0], v0[1]); w.y = cvt_pk_bf16(v0[2], v0[3]); w.z = cvt_pk_bf16(v1[0], v1[1]); w.w = cvt_pk_bf16(v1[2], v1[3]);
                    *(u32x4*)(rowp + bj * HALF) = w; } }
    }
};
}

namespace att {
__device__ __forceinline__ int crow(int r, int hi) { return (r & 3) + 8 * (r >> 2) + 4 * hi; }
__device__ __forceinline__ void sgu_unit(const bf16_t* __restrict__ UV, bf16_t* __restrict__ CAT, const float* __restrict__ w_sp, const float* __restrict__ b_sp,
                                         const float* __restrict__ ln_g, const float* __restrict__ ln_b, int chunk, int g, char* lds) {
  const int tid = threadIdx.x, wid = tid >> 6, lane = tid & 63, r32 = lane & 31, hi = lane >> 5;
  bf16_t* vT = (bf16_t*)lds;
  const int wp = wid >> 1, wd = wid & 1;
  unsigned pkv[16]; f32x4 wsv[16]; u32x4 uwv[4];
#pragma unroll
  for (int i = 0; i < 16; ++i) pkv[i] = *(const unsigned*)(UV + (size_t)(CTXL + chunk * 128 + wid * 16 + i) * DM + 1024 + g * 128 + 2 * lane);
  { const float* Wg = w_sp + (size_t)g * 128 * 128 + (size_t)(wp * 32 + r32) * 128 + hi * 8;
#pragma unroll
    for (int ks = 0; ks < 8; ++ks) { wsv[2 * ks] = *(const f32x4*)(Wg + ks * 16); wsv[2 * ks + 1] = *(const f32x4*)(Wg + ks * 16 + 4); } }
#pragma unroll
  for (int i = 0; i < 4; ++i) { const int ch = tid + 512 * i, p = ch >> 4, d0 = (ch & 15) * 8; uwv[i] = *(const u32x4*)(UV + (size_t)(CTXL + chunk * 128 + p) * DM + g * 128 + d0); }
  { const float lg0 = ln_g[g * 128 + 2 * lane], lg1 = ln_g[g * 128 + 2 * lane + 1], lb0 = ln_b[g * 128 + 2 * lane], lb1 = ln_b[g * 128 + 2 * lane + 1];
#pragma unroll
    for (int i = 0; i < 16; ++i) { const int pos = wid * 16 + i;
      const unsigned pk = pkv[i];
      const float a = bflo(pk), b = bfhi(pk);
      const float mean = wave_sum(a + b) * (1.0f / 128.0f); const float da = a - mean, db = b - mean;
      const float var = wave_sum(da * da + db * db) * (1.0f / 128.0f); const float rstd = 1.0f / sqrtf(var + EPS);
      vT[(2 * lane) * 136 + pos] = (bf16_t)f2bf(da * rstd * lg0 + lb0); vT[(2 * lane + 1) * 136 + pos] = (bf16_t)f2bf(db * rstd * lg1 + lb1); } }
  __syncthreads();
  f32x16 acc[2]; acc[0] = f32x16{}; acc[1] = f32x16{};
#pragma unroll
  for (int ks = 0; ks < 8; ++ks) { const f32x4 w0 = wsv[2 * ks], w1 = wsv[2 * ks + 1];
    u32x4 aw; aw.x = pk2(w0[0], w0[1]); aw.y = pk2(w0[2], w0[3]); aw.z = pk2(w1[0], w1[1]); aw.w = pk2(w1[2], w1[3]);
    const bf16x8 af = __builtin_bit_cast(bf16x8, aw);
#pragma unroll
    for (int nb = 0; nb < 2; ++nb) { const bf16x8 bf = *(const bf16x8*)(vT + (wd * 64 + nb * 32 + r32) * 136 + ks * 16 + hi * 8);
      acc[nb] = __builtin_amdgcn_mfma_f32_32x32x16_bf16(af, bf, acc[nb], 0, 0, 0); } }
  __syncthreads();
  float* mt = (float*)lds;
#pragma unroll
  for (int nb = 0; nb < 2; ++nb) { const int d = wd * 64 + nb * 32 + r32;
#pragma unroll
    for (int r = 0; r < 16; ++r) { const int p = wp * 32 + crow(r, hi); mt[p * 132 + d] = acc[nb][r] + b_sp[g * 128 + p]; } }
  __syncthreads();
#pragma unroll
  for (int i = 0; i < 4; ++i) { const int ch = tid + 512 * i, p = ch >> 4, d0 = (ch & 15) * 8, t = chunk * 128 + p;
    const u32x4 uw = uwv[i];
    const f32x4 m0 = *(const f32x4*)(mt + p * 132 + d0), m1 = *(const f32x4*)(mt + p * 132 + d0 + 4);
    u32x4 o; o.x = pk2(bflo(uw.x) * m0.x, bfhi(uw.x) * m0.y); o.y = pk2(bflo(uw.y) * m0.z, bfhi(uw.y) * m0.w);
    o.z = pk2(bflo(uw.z) * m1.x, bfhi(uw.z) * m1.y); o.w = pk2(bflo(uw.w) * m1.z, bfhi(uw.w) * m1.w);
    *(u32x4*)(CAT + (size_t)t * DM + 1024 + g * 128 + d0) = o; }
  __syncthreads();
}
}


namespace att2 {
using bf16x8_t = bf16x8;
constexpr int NW = 8, QBLK = 32, KVBLK = 64, NSLOT = 3, SLOTB = 16384, DMK = 1024, NT = MC / KVBLK;
constexpr int LDS_K = 0, LDS_V = NSLOT * SLOTB, LDS_WS = 2 * NSLOT * SLOTB, LDS_Q = LDS_WS + NW * 64 * 4, LDS_BYTES_ATT = LDS_Q + NW * 4096;
__device__ __forceinline__ int crow(int r, int hi) { return (r & 3) + 8 * (r >> 2) + 4 * hi; }
#define SBAR() __builtin_amdgcn_sched_barrier(0)
template <int IMM> __device__ __forceinline__ void glds16(const void* sbase, unsigned voff, unsigned lds_dst) { unsigned keep;
  asm volatile("s_mov_b32 %0, m0\n\ts_mov_b32 m0, %3\n\ts_nop 0\n\tglobal_load_lds_dwordx4 %1, %2 offset:%c4\n\ts_mov_b32 m0, %0" : "=&s"(keep) : "v"(voff), "s"(sbase), "s"(lds_dst), "i"(IMM) : "memory"); }
__device__ __forceinline__ float max3f(float a, float b, float c) { float r; asm("v_max3_f32 %0, %1, %2, %3" : "=v"(r) : "v"(a), "v"(b), "v"(c)); return r; }
__device__ __forceinline__ float max2f(float a, float b) { float r; asm("v_max_f32_e32 %0, %1, %2" : "=v"(r) : "v"(a), "v"(b)); return r; }
__device__ __forceinline__ float fadd_s(float a, float b) { float r; asm("v_add_f32_e32 %0, %1, %2" : "=v"(r) : "v"(a), "v"(b)); return r; }
__device__ __forceinline__ float fsub_s(float a, float b) { float r; asm("v_sub_f32_e32 %0, %1, %2" : "=v"(r) : "v"(a), "v"(b)); return r; }
typedef __bf16 bf16x2_t __attribute__((ext_vector_type(2)));
__device__ __forceinline__ unsigned cvtpk_s(float lo, float hi) { f32x2 v = {lo, hi}; bf16x2_t b = __builtin_convertvector(v, bf16x2_t); return __builtin_bit_cast(unsigned, b); }
#define WAIT_BAR(N) asm volatile("s_waitcnt vmcnt(" #N ") lgkmcnt(0)\n\ts_barrier" ::: "memory")
typedef LAS const char* lds_cptr;
typedef short v4i16_t __attribute__((ext_vector_type(4)));
__device__ __forceinline__ void kload8(bf16x8* kf, lds_cptr kp) {
  kf[0] = *(const LAS bf16x8*)(kp);        kf[1] = *(const LAS bf16x8*)(kp + 512);
  kf[2] = *(const LAS bf16x8*)(kp + 2048); kf[3] = *(const LAS bf16x8*)(kp + 2560);
  kf[4] = *(const LAS bf16x8*)(kp + 4096); kf[5] = *(const LAS bf16x8*)(kp + 4608);
  kf[6] = *(const LAS bf16x8*)(kp + 6144); kf[7] = *(const LAS bf16x8*)(kp + 6656);
}
__device__ __forceinline__ void kload2(bf16x8* kf, lds_cptr kp, int j) { kf[2 * j] = *(const LAS bf16x8*)(kp + j * 2048); kf[2 * j + 1] = *(const LAS bf16x8*)(kp + j * 2048 + 512); }
__device__ __forceinline__ s16x4 vtr(lds_cptr p) { return __builtin_bit_cast(s16x4, __builtin_amdgcn_ds_read_tr16_b64_v4i16((LAS v4i16_t*)p)); }
__device__ __forceinline__ float rowmax(const f32x16& p0, const f32x16& p1) {
  float a = max3f(p0[0], p0[1], p1[0]), b = max3f(p0[2], p0[3], p1[1]); a = max3f(a, p1[2], p1[3]);
#pragma unroll
  for (int r = 4; r < 16; r += 4) { a = max3f(a, p0[r], p0[r + 1]); b = max3f(b, p0[r + 2], p0[r + 3]); a = max3f(a, p1[r], p1[r + 1]); b = max3f(b, p1[r + 2], p1[r + 3]); }
  const float m = max2f(a, b);
  auto rr = __builtin_amdgcn_permlane32_swap(__float_as_uint(m), __float_as_uint(m), false, false);
  return max2f(__uint_as_float(rr[0]), __uint_as_float(rr[1]));
}
__device__ __forceinline__ void qkt(f32x16& p0, f32x16& p1, lds_cptr kb, const bf16x8* qr, const f32x16& negm) {
#pragma unroll
  for (int d0 = 0; d0 < 4; ++d0) {
    const bf16x8 b0 = *(const LAS bf16x8*)(kb + d0 * 2048);
    const bf16x8 b1 = *(const LAS bf16x8*)(kb + d0 * 2048 + 512);
    if (d0 == 0) { p0 = __builtin_amdgcn_mfma_f32_32x32x16_bf16(b0, qr[0], negm, 0, 0, 0); p1 = __builtin_amdgcn_mfma_f32_32x32x16_bf16(b1, qr[0], negm, 0, 0, 0); }
    else { p0 = __builtin_amdgcn_mfma_f32_32x32x16_bf16(b0, qr[d0], p0, 0, 0, 0); p1 = __builtin_amdgcn_mfma_f32_32x32x16_bf16(b1, qr[d0], p1, 0, 0, 0); } }
}
__device__ __forceinline__ void pv_last(f32x16* o, int vb, bf16x8 pa0, bf16x8 pa1, bf16x8 pa2, bf16x8 pa3) {
#pragma unroll
  for (int d0 = 0; d0 < 4; ++d0) { s16x4 lo[4], hi[4];
#pragma unroll
    for (int ks = 0; ks < 4; ++ks) {
      asm volatile("ds_read_b64_tr_b16 %0,%1 offset:%c2" : "=&v"(lo[ks]) : "v"(vb), "i"(d0 * 4096 + ks * 1024) : "memory");
      asm volatile("ds_read_b64_tr_b16 %0,%1 offset:%c2" : "=&v"(hi[ks]) : "v"(vb), "i"(d0 * 4096 + ks * 1024 + 512) : "memory"); }
    asm volatile("s_waitcnt lgkmcnt(0)" ::: "memory"); SBAR();
#define PK(k) (bf16x8){lo[k][0], lo[k][1], lo[k][2], lo[k][3], hi[k][0], hi[k][1], hi[k][2], hi[k][3]}
    o[d0] = __builtin_amdgcn_mfma_f32_32x32x16_bf16(pa0, PK(0), o[d0], 0, 0, 0);
    o[d0] = __builtin_amdgcn_mfma_f32_32x32x16_bf16(pa1, PK(1), o[d0], 0, 0, 0);
    o[d0] = __builtin_amdgcn_mfma_f32_32x32x16_bf16(pa2, PK(2), o[d0], 0, 0, 0);
    o[d0] = __builtin_amdgcn_mfma_f32_32x32x16_bf16(pa3, PK(3), o[d0], 0, 0, 0);
#undef PK
  }
}

template <int THRL>
__device__ __forceinline__ void attn_unit(const bf16_t* Q, const bf16_t* __restrict__ K, const bf16_t* __restrict__ V, bf16_t* __restrict__ CAT,
                                          int head, int qb, float lam, float out_scale, const float* __restrict__ g_subln, LAS unsigned char* shm) {
  const int tid = threadIdx.x, lane = tid & 63, r32 = lane & 31, hi = lane >> 5; const int wid = __builtin_amdgcn_readfirstlane(tid >> 6);
  const int comp = wid >> 2, wq = wid & 3;
  if (wid >= 4) __builtin_amdgcn_s_setprio(1);
  const bf16_t* Qw = Q + (size_t)(CTXL + qb * 128 + wq * QBLK) * DMK + head * 128 + comp * 64;
  const bf16_t* Kh = K + head * 128; const bf16_t* Vh = V + head * 128;
  const unsigned lds0 = (unsigned)(uintptr_t)shm;
  LAS float* wsf = (LAS float*)(shm + LDS_WS) + wid * 64;
  const unsigned kvoff = (unsigned)(lane * DMK + wid * 8) * 2u;
  const unsigned vvoff = (unsigned)((16 * (wid & 3) + (lane >> 2)) * DMK + (wid >> 2) * 32 + (lane & 3) * 8) * 2u;
  const unsigned kdst = lds0 + LDS_K + wid * 1024, vdst = lds0 + LDS_V + wid * 1024;
#define DMA_K(t, slot) do { const bf16_t* sb_ = Kh + (long)(t) * KVBLK * DMK; glds16<0>(sb_, kvoff, (unsigned)__builtin_amdgcn_readfirstlane(kdst + (slot))); glds16<0>(sb_ + 64, kvoff, (unsigned)__builtin_amdgcn_readfirstlane(kdst + 8192 + (slot))); } while (0)
#define DMAK1(t, slot) do { glds16<0>(Kh + (long)(t) * KVBLK * DMK, kvoff, (unsigned)__builtin_amdgcn_readfirstlane(kdst + (slot))); SBAR(); } while (0)
#define DMAK2(t, slot) do { glds16<0>(Kh + (long)(t) * KVBLK * DMK + 64, kvoff, (unsigned)__builtin_amdgcn_readfirstlane(kdst + 8192 + (slot))); SBAR(); } while (0)
#define DMAV1(t, slot) do { glds16<0>(Vh + (long)(t) * KVBLK * DMK, vvoff, (unsigned)__builtin_amdgcn_readfirstlane(vdst + (slot))); SBAR(); } while (0)
#define DMAV2(t, slot) do { glds16<0>(Vh + (long)(t) * KVBLK * DMK + 64, vvoff, (unsigned)__builtin_amdgcn_readfirstlane(vdst + 8192 + (slot))); SBAR(); } while (0)
#define DMA_V(t, slot) do { const bf16_t* sb_ = Vh + (long)(t) * KVBLK * DMK; glds16<0>(sb_, vvoff, (unsigned)__builtin_amdgcn_readfirstlane(vdst + (slot))); glds16<0>(sb_ + 64, vvoff, (unsigned)__builtin_amdgcn_readfirstlane(vdst + 8192 + (slot))); } while (0)
  const int vb0 = (int)(lds0 + LDS_V) + ((lane >> 4) & 1) * 32 + (lane & 3) * 8 + (4 * hi + ((lane & 15) >> 2)) * 64;
  bf16x8 kf[8];
  const lds_cptr shm3 = (lds_cptr)shm; const lds_cptr kp0 = shm3 + LDS_K + comp * 8192 + hi * 1024 + r32 * 16;
  const lds_cptr vp0 = shm3 + LDS_V + ((lane >> 4) & 1) * 32 + (lane & 3) * 8 + (4 * hi + ((lane & 15) >> 2)) * 64;
  DMA_K(0, 0); DMA_V(0, 0); DMA_K(1, SLOTB);
  bf16x8 qr[4];
#pragma unroll
  for (int d0 = 0; d0 < 4; ++d0) qr[d0] = *reinterpret_cast<const bf16x8*>(&Qw[(long)r32 * DMK + d0 * 16 + hi * 8]);
  float mhat = 0.f, l_reg = 0.f; f32x16 o[4]; o[0] = f32x16{}; o[1] = f32x16{}; o[2] = f32x16{}; o[3] = f32x16{}; f32x16 negm = f32x16{}; asm volatile("" : "+v"(negm));
  bool resc = false;
#define START(P0, P1) do { const float rm = rowmax(P0, P1); resc = false; \
    { const float dl = rm; mhat = fadd_s(mhat, dl); \
      _Pragma("unroll") for (int r = 0; r < 16; ++r) { P0[r] = fsub_s(P0[r], dl); P1[r] = fsub_s(P1[r], dl); } \
      _Pragma("unroll") for (int r = 0; r < 16; ++r) negm[r] = -mhat; asm volatile("" : "+v"(negm)); } \
    _Pragma("unroll") for (int r = 0; r < 16; ++r) P0[r] = __builtin_amdgcn_exp2f(P0[r]); } while (0)
#define RESC() do { if (resc) { asm volatile("s_waitcnt lgkmcnt(0)" ::: "memory"); \
      _Pragma("unroll") for (int d_ = 0; d_ < 4; ++d_) _Pragma("unroll") for (int r = 0; r < 16; ++r) o[d_][r] *= wsf[crow(r, hi)]; } } while (0)
  f32x16 pA0, pA1, pB0, pB1;
  int sl_prev = 0, sl_cur = 0, sl_next = SLOTB;
#define ROT() do { sl_prev = sl_cur; sl_cur = sl_next; sl_next = (sl_next == (NSLOT - 1) * SLOTB) ? 0 : sl_next + SLOTB; } while (0)
  DMA_K(2, 2 * SLOTB);
  WAIT_BAR(6);
  qkt(pA0, pA1, kp0, qr, negm); asm volatile("s_nop 15\n\ts_nop 7" : "+v"(pA0), "+v"(pA1));
  const lds_cptr qp = shm3 + LDS_Q + wid * 4096 + lane * 16;
#pragma unroll
  for (int d0 = 0; d0 < 4; ++d0) *(LAS bf16x8*)(shm + LDS_Q + wid * 4096 + lane * 16 + d0 * 1024) = qr[d0];
  START(pA0, pA1);
#pragma unroll
  for (int r = 0; r < 16; ++r) pA1[r] = __builtin_amdgcn_exp2f(pA1[r]);
  WAIT_BAR(0);
  DMA_K(3, 0); DMA_V(1, SLOTB);
  ROT();
  kload8(kf, kp0 + sl_cur);
  WAIT_BAR(4);
  s16x4 vlo[4], vhi[4]; u32x4 pw0, pw1, pw2, pw3;
#define PKW(P, B) cvtpk_s(P[B], P[B + 1])
#define PAF(k) __builtin_bit_cast(bf16x8, pw##k)
#define VFR(i) (bf16x8){vlo[i][0], vlo[i][1], vlo[i][2], vlo[i][3], vhi[i][0], vhi[i][1], vhi[i][2], vhi[i][3]}
#define PIN(x) asm volatile("" : "+v"(x))
#define MX3(a, b, c) __builtin_fmaxf(__builtin_fmaxf((a), (b)), (c))
#define GAPA(MF, A0, A1, A2, A3, W0, W1, PW) do { MF; sacc += A0; sacc += A1; sacc += A2; sacc += A3; PIN(sacc); W0; W1; PIN(PW); SBAR(); } while (0)
#define EX(v) __builtin_amdgcn_exp2f(v)
#define GAPB(MF, X, B) do { MF; X[B] = EX(X[B]); X[B + 1] = EX(X[B + 1]); PIN(X); } while (0)
#define VRD(s) do { vlo[(s) & 3] = vtr(vp_ + (((s) & 3) * 4096 + ((s) >> 2) * 1024)); vhi[(s) & 3] = vtr(vp_ + (((s) & 3) * 4096 + ((s) >> 2) * 1024 + 512)); } while (0)
#define KRD(G, j) do { if (G) { kload2(kf, kp0 + sl_next, j); SBAR(); } } while (0)
#define PVS(s, PA, X, B) do { GAPB(o[(s) & 3] = __builtin_amdgcn_mfma_f32_32x32x16_bf16(PA, VFR((s) & 3), o[(s) & 3], 0, 0, 0), X, B); if ((s) + 4 < 16) { VRD((s) + 4); } SBAR(); } while (0)
#define STEP(C0, C1, P0, P1, t, GK, GV, GL) do { SBAR(); \
    const lds_cptr vp_ = vp0 + sl_prev; \
    float sacc = (P0[0] + P0[1]); bf16x8 qa = *(const LAS bf16x8*)(qp), qb_; \
    GAPA(C0 = __builtin_amdgcn_mfma_f32_32x32x16_bf16(kf[0], qa, negm, 0, 0, 0), P0[2], P0[3], P0[4], P0[5],     pw0[0] = PKW(P0, 0), pw0[1] = PKW(P0, 2), pw0); \
    GAPA(C1 = __builtin_amdgcn_mfma_f32_32x32x16_bf16(kf[1], qa, negm, 0, 0, 0), P0[6], P0[7], P0[8], P0[9],     pw0[2] = PKW(P0, 4), pw0[3] = PKW(P0, 6), pw0); qb_ = *(const LAS bf16x8*)(qp + 1024); \
    GAPA(C0 = __builtin_amdgcn_mfma_f32_32x32x16_bf16(kf[2], qb_, C0, 0, 0, 0),   P0[10], P0[11], P0[12], P0[13], pw1[0] = PKW(P0, 8), pw1[1] = PKW(P0, 10), pw1); \
    GAPA(C1 = __builtin_amdgcn_mfma_f32_32x32x16_bf16(kf[3], qb_, C1, 0, 0, 0),   P0[14], P0[15], P1[0], P1[1],   pw1[2] = PKW(P0, 12), pw1[3] = PKW(P0, 14), pw1); qa = *(const LAS bf16x8*)(qp + 2048); \
    VRD(0); SBAR(); GAPA(C0 = __builtin_amdgcn_mfma_f32_32x32x16_bf16(kf[4], qa, C0, 0, 0, 0),   P1[2], P1[3], P1[4], P1[5],     pw2[0] = PKW(P1, 0), pw2[1] = PKW(P1, 2), pw2); \
    VRD(1); SBAR(); GAPA(C1 = __builtin_amdgcn_mfma_f32_32x32x16_bf16(kf[5], qa, C1, 0, 0, 0),   P1[6], P1[7], P1[8], P1[9],     pw2[2] = PKW(P1, 4), pw2[3] = PKW(P1, 6), pw2); qb_ = *(const LAS bf16x8*)(qp + 3072); \
    VRD(2); SBAR(); GAPA(C0 = __builtin_amdgcn_mfma_f32_32x32x16_bf16(kf[6], qb_, C0, 0, 0, 0),   P1[10], P1[11], P1[12], P1[13], pw3[0] = PKW(P1, 8), pw3[1] = PKW(P1, 10), pw3); \
    VRD(3); SBAR(); GAPA(C1 = __builtin_amdgcn_mfma_f32_32x32x16_bf16(kf[7], qb_, C1, 0, 0, 0),   P1[14], P1[15], 0.f, 0.f,       pw3[2] = PKW(P1, 12), pw3[3] = PKW(P1, 14), pw3); \
    l_reg += sacc; \
    { float a = MX3(C0[0], C0[1], C1[0]), b = MX3(C0[2], C0[3], C1[1]); a = MX3(a, C1[2], C1[3]); \
      _Pragma("unroll") for (int r = 4; r < 16; r += 4) { a = MX3(a, C0[r], C0[r + 1]); b = MX3(b, C0[r + 2], C0[r + 3]); a = MX3(a, C1[r], C1[r + 1]); b = MX3(b, C1[r + 2], C1[r + 3]); } \
      float rm = __builtin_fmaxf(a, b); { auto rr = __builtin_amdgcn_permlane32_swap(__float_as_uint(rm), __float_as_uint(rm), false, false); rm = __builtin_fmaxf(__uint_as_float(rr[0]), __uint_as_float(rr[1])); } \
      resc = false; \
      if (__builtin_expect(__any(rm > (float)THRL), 0)) { const float dl = __builtin_fmaxf(rm, 0.f); mhat += dl; \
        _Pragma("unroll") for (int r = 0; r < 16; ++r) { C0[r] -= dl; C1[r] -= dl; } \
        _Pragma("unroll") for (int r = 0; r < 16; ++r) negm[r] = -mhat; asm volatile("" : "+v"(negm)); \
        const float f = __builtin_amdgcn_exp2f(-dl); l_reg *= f; if (hi == 0) wsf[r32] = f; resc = true; } } \
    SBAR(); \
    PVS(0, PAF(0), C0, 0);  if (GK) { DMAK1((t) + 3, sl_cur); } PVS(1, PAF(0), C0, 2);  PVS(2, PAF(0), C0, 4);  if (GK) { DMAK2((t) + 3, sl_cur); } PVS(3, PAF(0), C0, 6); \
    KRD(GL, 0); PVS(4, PAF(1), C0, 8);  if (GV) { DMAV1((t) + 1, sl_next); } PVS(5, PAF(1), C0, 10); KRD(GL, 1); PVS(6, PAF(1), C0, 12); if (GV) { DMAV2((t) + 1, sl_next); } PVS(7, PAF(1), C0, 14); \
    KRD(GL, 2); PVS(8, PAF(2), C1, 0);  PVS(9, PAF(2), C1, 2);  KRD(GL, 3); PVS(10, PAF(2), C1, 4); PVS(11, PAF(2), C1, 6); \
    PVS(12, PAF(3), C1, 8); PVS(13, PAF(3), C1, 10); PVS(14, PAF(3), C1, 12); PVS(15, PAF(3), C1, 14); \
    } while (0)
  int t = 1;
  for (; t + 5 < NT; t += 2) {
    STEP(pB0, pB1, pA0, pA1, t, true, true, true);     WAIT_BAR(4); RESC(); ROT();
    STEP(pA0, pA1, pB0, pB1, t + 1, true, true, true); WAIT_BAR(4); RESC(); ROT();
  }
#define ENDW(tt) do { if ((tt) + 3 < NT) { WAIT_BAR(4); } else if ((tt) + 2 < NT) { WAIT_BAR(2); } else { WAIT_BAR(0); } } while (0)
  for (; t + 1 < NT; t += 2) {
    STEP(pB0, pB1, pA0, pA1, t, (t + 3 < NT), (t + 1 < NT), (t + 1 < NT));         ENDW(t);     RESC(); ROT();
    STEP(pA0, pA1, pB0, pB1, t + 1, (t + 4 < NT), (t + 2 < NT), (t + 2 < NT));     ENDW(t + 1); RESC(); ROT();
  }
  STEP(pB0, pB1, pA0, pA1, NT - 1, false, false, false); RESC();
  { float sacc = pB0[0] + pB0[1];
#pragma unroll
    for (int r = 2; r < 16; ++r) sacc += pB0[r];
#pragma unroll
    for (int r = 0; r < 16; ++r) sacc += pB1[r];
    l_reg += sacc;
    pw0 = (u32x4){PKW(pB0, 0), PKW(pB0, 2), PKW(pB0, 4), PKW(pB0, 6)}; pw1 = (u32x4){PKW(pB0, 8), PKW(pB0, 10), PKW(pB0, 12), PKW(pB0, 14)};
    pw2 = (u32x4){PKW(pB1, 0), PKW(pB1, 2), PKW(pB1, 4), PKW(pB1, 6)}; pw3 = (u32x4){PKW(pB1, 8), PKW(pB1, 10), PKW(pB1, 12), PKW(pB1, 14)};
    SBAR(); pv_last(o, vb0 + sl_cur, PAF(0), PAF(1), PAF(2), PAF(3)); }
  { auto rr = __builtin_amdgcn_permlane32_swap(__float_as_uint(l_reg), __float_as_uint(l_reg), false, false); l_reg = __uint_as_float(rr[0]) + __uint_as_float(rr[1]); }
  if (hi == 0) wsf[32 + r32] = l_reg; asm volatile("s_waitcnt lgkmcnt(0)" ::: "memory");
  float rli[16];
#pragma unroll
  for (int r = 0; r < 16; ++r) rli[r] = __builtin_amdgcn_rcpf(wsf[32 + crow(r, hi)]);
  asm volatile("s_waitcnt lgkmcnt(0)\n\ts_barrier" ::: "memory");
  LAS float* buf = (LAS float*)shm;
  if (comp == 1) {
#pragma unroll
    for (int r = 0; r < 16; ++r) { const int orow = wq * QBLK + crow(r, hi);
#pragma unroll
      for (int d0 = 0; d0 < 4; ++d0) buf[orow * 128 + d0 * 32 + r32] = o[d0][r] * rli[r] * lam; }
  }
  asm volatile("s_waitcnt lgkmcnt(0)\n\ts_barrier" ::: "memory");
  if (comp == 0) {
#pragma unroll
    for (int r = 0; r < 16; ++r) { const int orow = wq * QBLK + crow(r, hi);
#pragma unroll
      for (int d0 = 0; d0 < 4; ++d0) { const int ix = orow * 128 + d0 * 32 + r32; buf[ix] = o[d0][r] * rli[r] - buf[ix]; } }
  }
  asm volatile("s_waitcnt lgkmcnt(0)\n\ts_barrier" ::: "memory");
  { const float g0 = g_subln[lane * 2] * out_scale, g1 = g_subln[lane * 2 + 1] * out_scale;
#pragma unroll 4
    for (int i = 0; i < 16; ++i) { const int row = wid * 16 + i; const f32x2 v = *(const LAS f32x2*)(buf + row * 128 + lane * 2);
      const float ss = wave_sum(v.x * v.x + v.y * v.y); const float rstd = 1.0f / sqrtf(ss * (1.0f / 128.0f) + EPS);
      *(unsigned*)(CAT + (size_t)(qb * 128 + row) * DM + head * 128 + lane * 2) = pk2(v.x * rstd * g0, v.y * rstd * g1); } }
  asm volatile("s_waitcnt vmcnt(0) lgkmcnt(0)\n\ts_barrier" ::: "memory");
  if (wid >= 4) __builtin_amdgcn_s_setprio(0);
#undef DMA_K
#undef DMA_V
#undef DMAK1
#undef DMAK2
#undef DMAV1
#undef DMAV2
#undef START
#undef RESC
#undef ROT
#undef PKW
#undef PAF
#undef VFR
#undef PIN
#undef MX3
#undef GAPA
#undef GAPB
#undef EX
#undef VRD
#undef KRD
#undef PVS
#undef STEP
#undef ENDW
}
#undef SBAR
#undef WAIT_BAR
}

namespace fft {
constexpr int XST = 72, ZST = 136, LDS_X = 0, LDS_Z = 2 * 128 * XST * 2, LDS_A1 = LDS_Z + 2 * 64 * ZST * 2, LDS_A2 = LDS_A1 + 128 * 136 * 2;
__device__ __forceinline__ int crow(int r, int hi) { return (r & 3) + 8 * (r >> 2) + 4 * hi; }
__device__ __forceinline__ void fft_phase(const bf16_t* __restrict__ WCT, bf16_t* __restrict__ FB, const bf16_t* __restrict__ A1T, const bf16_t* __restrict__ A2T, const float* __restrict__ TW, char* lds, int G) {
  const int tid = threadIdx.x, wid = tid >> 6, lane = tid & 63, r32 = lane & 31, hi = lane >> 5;
  bf16_t* Xs = (bf16_t*)(lds + LDS_X); bf16_t* Zs = (bf16_t*)(lds + LDS_Z);
  const int mb = wid & 3, nbp = wid >> 2;
  bf16x8 a2[8];
  bf16_t* A1s = (bf16_t*)(lds + LDS_A1);
#pragma unroll
  for (int q = 0; q < 4; ++q) { const int i = tid + 512 * q, row = i >> 4, c8 = (i & 15) * 8; *(u32x4*)(A1s + row * 136 + c8) = *(const u32x4*)(A1T + row * 128 + c8); }
#pragma unroll
  for (int ks = 0; ks < 8; ++ks) a2[ks] = *(const bf16x8*)(A2T + (32 * mb + r32) * 256 + 16 * (ks + 8) + 8 * hi);
  bf16_t* A2s = (bf16_t*)(lds + LDS_A2);
#pragma unroll
  for (int q = 0; q < 4; ++q) { const int i = tid + 512 * q, row = i >> 4, c8 = (i & 15) * 8; *(u32x4*)(A2s + row * 136 + c8) = *(const u32x4*)(A2T + row * 256 + c8); }
  f32x2 tw[2][8];
#pragma unroll
  for (int nbi = 0; nbi < 2; ++nbi)
#pragma unroll
    for (int q = 0; q < 8; ++q) { const int k1 = 16 * mb + 4 * (q >> 1) + 2 * hi + (q & 1), t2 = 32 * (2 * nbp + nbi) + r32; tw[nbi][q] = *(const f32x2*)(TW + 2 * (k1 * 128 + t2)); }
  const int k1o = 32 * nbp + r32;
#define FFT_LOADX(cp) do { const bf16_t* src = WCT + (size_t)(2 * (cp)) * 8192; \
        _Pragma("unroll") for (int pass = 0; pass < 4; ++pass) { const int p = tid + 512 * pass, ri = p >> 10, e = (p & 1023) * 8; pv[pass] = *(const u32x4*)(src + (size_t)ri * 8192 + e); } } while (0)
#define FFT_COLUMN(ncp, hasn, neg, OUT) do { \
      { _Pragma("unroll") for (int pass = 0; pass < 4; ++pass) { const int p = tid + 512 * pass, ri = p >> 10, e = (p & 1023) * 8, t2 = e >> 6, t1 = e & 63; \
          *(u32x4*)(Xs + (ri * 128 + t2) * XST + t1) = pv[pass]; } } \
      const unsigned sgn = (neg) ? 0x80008000u : 0u; \
      __syncthreads(); \
      if (hasn) FFT_LOADX(ncp); \
      f32x16 acc[2]; acc[0] = f32x16{}; acc[1] = f32x16{}; \
      _Pragma("unroll") for (int ks = 0; ks < 8; ++ks) \
        _Pragma("unroll") for (int nbi = 0; nbi < 2; ++nbi) { const int t2 = 32 * (2 * nbp + nbi) + r32; \
          u32x4 bw = *(const u32x4*)(Xs + ((ks >> 2) * 128 + t2) * XST + (ks & 3) * 16 + 8 * hi); if (ks >= 4) { bw.x ^= sgn; bw.y ^= sgn; bw.z ^= sgn; bw.w ^= sgn; } const bf16x8 bfr = __builtin_bit_cast(bf16x8, bw); \
          acc[nbi] = __builtin_amdgcn_mfma_f32_32x32x16_bf16(*(const bf16x8*)(A1s + (32 * mb + r32) * 136 + 16 * ks + 8 * hi), bfr, acc[nbi], 0, 0, 0); } \
      _Pragma("unroll") for (int nbi = 0; nbi < 2; ++nbi) { const int t2 = 32 * (2 * nbp + nbi) + r32; \
        _Pragma("unroll") for (int q = 0; q < 8; ++q) { const float yr = acc[nbi][2 * q], yi = acc[nbi][2 * q + 1]; const f32x2 cs = tw[nbi][q]; \
          const int k1 = 16 * mb + 4 * (q >> 1) + 2 * hi + (q & 1); \
          const unsigned zz = cvt2_bf16(yr * cs.x + yi * cs.y, yi * cs.x - yr * cs.y); Zs[k1 * ZST + t2] = (bf16_t)zz; Zs[(64 + k1) * ZST + t2] = (bf16_t)(zz >> 16); } } \
      __syncthreads(); \
      OUT = f32x16{}; \
      _Pragma("unroll") for (int ks = 0; ks < 16; ++ks) { const bf16x8 bfr = *(const bf16x8*)(Zs + ((ks >> 3) * 64 + k1o) * ZST + (ks & 7) * 16 + 8 * hi); \
        OUT = __builtin_amdgcn_mfma_f32_32x32x16_bf16(ks < 8 ? *(const bf16x8*)(A2s + (32 * mb + r32) * 136 + 16 * ks + 8 * hi) : a2[ks & 7], bfr, OUT, 0, 0, 0); } } while (0)
#define FB_AT(col, k) (FB + ((size_t)((col) >> 3) * 8192 + (k)) * 8 + ((col) & 7))
  constexpr float SC = 1.0f / 2048.0f;
  for (int unit = blockIdx.x; unit < 256; unit += G) {
    const int g = unit >> 6, cb = unit & 63;
    bf16_t* fb = FB + (size_t)(g * 64 + cb) * 8192 * 8;
    auto cpof = [&](int c) { return (c <= 255) ? g * 256 + c : (c == 256 ? 1024 + g : g * 256 + (512 - c)); };
    u32x4 pv[4];
    FFT_LOADX(cpof(8 * cb));
#pragma unroll 1
    for (int half = 0; half < 2; ++half) { u32x2 o[16];
#pragma unroll
      for (int jp = 0; jp < 2; ++jp) { f32x16 ea, eb;
        { const int c = 8 * cb + 4 * half + 2 * jp; const bool ng = c > 256; FFT_COLUMN(cpof(c + 1), true, ng, ea); }
        { const int c = 8 * cb + 4 * half + 2 * jp + 1; const bool ng = c > 256; const bool hn = (c & 7) != 7; FFT_COLUMN(cpof(c + 1), hn, ng, eb); }
#pragma unroll
        for (int r = 0; r < 16; ++r) o[r][jp] = pk2(ea[r] * SC, eb[r] * SC); }
#pragma unroll
      for (int r = 0; r < 16; ++r) { const int k = k1o + 64 * (32 * mb + crow(r, hi)); *(u32x2*)(fb + (size_t)k * 8 + 4 * half) = o[r]; } }
  }
#undef FFT_LOADX
#undef FFT_COLUMN
#undef FB_AT
  __syncthreads();
}
}

struct Args {
    const float *x, *c, *ctx, *c_ctx, *w_mod, *b_mod, *g_mix, *g_ffn, *w_in, *w_out, *lq1, *lk1, *lq2, *lk2, *g_subln, *ln_g, *ln_b, *w_sp, *b_sp, *w_fo, *w_r, *w_gate, *w_up, *w_down, *g_final;
    float* out; unsigned char* ws; int lo, hi;
};


struct Ctx {
    const LAS unsigned long long* PT;
    __device__ __forceinline__ const void* ld(int i) const { const unsigned long long v = PT[i]; const unsigned l = __builtin_amdgcn_readfirstlane((unsigned)v), h = __builtin_amdgcn_readfirstlane((unsigned)(v >> 32));
        return (const void*)(const GAS void*)(((unsigned long long)h << 32) | l); }
    __device__ __forceinline__ const float* x() const { return (const float*)ld(0); }
    __device__ __forceinline__ const float* c() const { return (const float*)ld(1); }
    __device__ __forceinline__ const float* ctx() const { return (const float*)ld(2); }
    __device__ __forceinline__ const float* c_ctx() const { return (const float*)ld(3); }
    __device__ __forceinline__ const float* w_mod() const { return (const float*)ld(4); }
    __device__ __forceinline__ const float* b_mod() const { return (const float*)ld(5); }
    __device__ __forceinline__ const float* g_mix() const { return (const float*)ld(6); }
    __device__ __forceinline__ const float* g_ffn() const { return (const float*)ld(7); }
    __device__ __forceinline__ const float* w_in() const { return (const float*)ld(8); }
    __device__ __forceinline__ const float* w_out() const { return (const float*)ld(9); }
    __device__ __forceinline__ const float* lq1() const { return (const float*)ld(10); }
    __device__ __forceinline__ const float* lk1() const { return (const float*)ld(11); }
    __device__ __forceinline__ const float* lq2() const { return (const float*)ld(12); }
    __device__ __forceinline__ const float* lk2() const { return (const float*)ld(13); }
    __device__ __forceinline__ const float* g_subln() const { return (const float*)ld(14); }
    __device__ __forceinline__ const float* ln_g() const { return (const float*)ld(15); }
    __device__ __forceinline__ const float* ln_b() const { return (const float*)ld(16); }
    __device__ __forceinline__ const float* w_sp() const { return (const float*)ld(17); }
    __device__ __forceinline__ const float* b_sp() const { return (const float*)ld(18); }
    __device__ __forceinline__ const float* w_fo() const { return (const float*)ld(19); }
    __device__ __forceinline__ const float* w_r() const { return (const float*)ld(20); }
    __device__ __forceinline__ const float* w_gate() const { return (const float*)ld(21); }
    __device__ __forceinline__ const float* w_up() const { return (const float*)ld(22); }
    __device__ __forceinline__ const float* w_down() const { return (const float*)ld(23); }
    __device__ __forceinline__ const float* g_final() const { return (const float*)ld(24); }
    __device__ __forceinline__ float* out() const { return (float*)ld(25); }
    __device__ __forceinline__ unsigned char* ws() const { return (unsigned char*)ld(26); }
};

__device__ __forceinline__ void transpose_item(const float* W, int K, int N, bf16_t* WT, int row_off, int ilv, LAS float* scr, int item, int lane) {
    const int nblk = N / 32, kb = item / nblk, nb = item % nblk, k0 = 64 * kb, n0 = 32 * nb;
#pragma unroll 8
    for (int i = 0; i < 32; ++i) { const int kk = 2 * i + (lane >> 5); scr[kk * 33 + (lane & 31)] = __builtin_nontemporal_load(W + (size_t)(k0 + kk) * N + n0 + (lane & 31)); }
    asm volatile("s_waitcnt lgkmcnt(0)" ::: "memory");
    const int c = lane & 7;
#pragma unroll
    for (int j = 0; j < 4; ++j) { const int n = (lane >> 3) + 8 * j; const LAS float* s = scr + (8 * c) * 33 + n;
        u32x4 o; o.x = pk2(s[0 * 33], s[1 * 33]); o.y = pk2(s[2 * 33], s[3 * 33]); o.z = pk2(s[4 * 33], s[5 * 33]); o.w = pk2(s[6 * 33], s[7 * 33]);
        const int ng = n0 + n, drow = row_off + (ilv ? ((ng >> 7) * 256 + (ng & 127)) : ng);
        *(u32x4*)(WT + (size_t)drow * K + k0 + 8 * c) = o; }
    asm volatile("s_waitcnt lgkmcnt(0)" ::: "memory");
}
struct CvtItem { const float* src; bf16_t* dst; int N, K, row_off, ilv, k0, n0; };
__device__ __forceinline__ void cvt_load(const CvtItem& d, f32x4 (&v)[8], int lane) {
    const float* p = d.src + (size_t)(d.k0 + (lane >> 3)) * d.N + d.n0 + (lane & 7) * 4;
#pragma unroll
    for (int q = 0; q < 8; ++q) v[q] = __builtin_nontemporal_load((const f32x4*)(p + (size_t)(8 * q) * d.N));
}
__device__ __forceinline__ void cvt_store(const CvtItem& d, const f32x4 (&v)[8], LAS float* scr, int lane) {
    const int rr = lane >> 3, c4 = (lane & 7) * 4;
#pragma unroll
    for (int q = 0; q < 8; ++q) { LAS float* t = scr + (8 * q + rr) * 33 + c4; t[0] = v[q].x; t[1] = v[q].y; t[2] = v[q].z; t[3] = v[q].w; }
    asm volatile("s_waitcnt lgkmcnt(0)" ::: "memory");
    const int c = lane & 7;
#pragma unroll
    for (int j = 0; j < 4; ++j) { const int n = (lane >> 3) + 8 * j; const LAS float* s = scr + (8 * c) * 33 + n;
        u32x4 o; o.x = pk2(s[0 * 33], s[1 * 33]); o.y = pk2(s[2 * 33], s[3 * 33]); o.z = pk2(s[4 * 33], s[5 * 33]); o.w = pk2(s[6 * 33], s[7 * 33]);
        const int ng = d.n0 + n, drow = d.row_off + (d.ilv ? ((ng >> 7) * 256 + (ng & 127)) : ng);
        __builtin_nontemporal_store(o, (u32x4*)(d.dst + (size_t)drow * d.K + d.k0 + 8 * c)); }
    asm volatile("s_waitcnt lgkmcnt(0)" ::: "memory");
}
constexpr int MOE_ITEMS = NE * (2 * (DM / 64) * (FE / 32) + (FE / 64) * (DM / 32));
__device__ __forceinline__ void convert_moe_items(const Ctx& a, int layer, LAS unsigned char* lds, int it0, int it1, int widx, int nw, int wave, int lane) {
    LAS float* scr = (LAS float*)(lds + wave * 16384);
    bf16_t* WGU = (bf16_t*)(a.ws() + WS_WGU + (size_t)layer * WGU_BYTES); bf16_t* WD = (bf16_t*)(a.ws() + WS_WD + (size_t)layer * WD_BYTES);
    constexpr int I_G = (DM / 64) * (FE / 32), I_D = (FE / 64) * (DM / 32);
    constexpr int PER_E = 2 * I_G + I_D;
    const float *wg = a.w_gate(), *wu = a.w_up(), *wd = a.w_down();
    auto decode = [&](int it) { CvtItem d; const int e = it / PER_E; int r = it % PER_E; const size_t eo = ((size_t)layer * NE + e) * (size_t)DM * FE;
        if (r < I_G)          { d.src = wg + eo; d.dst = WGU; d.N = FE; d.K = DM; d.row_off = e * 2048; d.ilv = 1; }
        else if (r < 2 * I_G) { r -= I_G; d.src = wu + eo; d.dst = WGU; d.N = FE; d.K = DM; d.row_off = e * 2048 + 128; d.ilv = 1; }
        else                  { r -= 2 * I_G; d.src = wd + eo; d.dst = WD; d.N = DM; d.K = FE; d.row_off = e * 2048; d.ilv = 0; }
        const int nblk = d.N / 32; d.k0 = 64 * (r / nblk); d.n0 = 32 * (r % nblk); return d; };
    int it = it0 + widx;
    if (it >= it1) return;
    f32x4 va[8], vb[8]; CvtItem da = decode(it), db = da; bool hb = (it + nw < it1);
    cvt_load(da, va, lane);
    if (hb) { db = decode(it + nw); cvt_load(db, vb, lane); }
    for (;;) {
        cvt_store(da, va, scr, lane);
        it += 2 * nw; const bool ha = (it < it1);
        if (ha) { da = decode(it); cvt_load(da, va, lane); }
        if (!hb) break;
        cvt_store(db, vb, scr, lane);
        hb = (it + nw < it1);
        if (hb) { db = decode(it + nw); cvt_load(db, vb, lane); }
        if (!ha) break;
    }
}
constexpr int L0_A = 12288, L0_B = 20480, L1_A = 45056;
__device__ __forceinline__ void p0_prologue(const Ctx& a, LAS unsigned char* lds, int G) {
    const int tid = threadIdx.x, lane = tid & 63, wave = __builtin_amdgcn_readfirstlane(tid >> 6);
    float* MODL = (float*)(a.ws() + WS_MODL); float* MODC = (float*)(a.ws() + WS_MODC);
    {
        LAS float* s_l = (LAS float*)lds; LAS float* s_c = s_l + 2048; LAS float* red = s_c + 2048;
        for (int k = tid; k < 2048; k += NTHR) { const float v = a.c()[k], w = a.c_ctx()[k]; s_l[k] = v / (1.0f + __expf(-v)); s_c[k] = w / (1.0f + __expf(-w)); }
        __syncthreads();
        const int cg = tid % 24, kg = tid / 24;
        for (int u = blockIdx.x; u < 256; u += G) {
            const int layer = u >> 7, n0 = (u & 127) * 96;
            f32x4 al = (f32x4){0.f, 0.f, 0.f, 0.f}, ac = al;
            if (kg < 21) {
                const float* W = a.w_mod() + (size_t)layer * DM * 12288 + n0 + 4 * cg;
#pragma unroll 8
                for (int k = kg; k < 2048; k += 21) { const f32x4 w = __builtin_nontemporal_load((const f32x4*)(W + (size_t)k * 12288)); al += s_l[k] * w; ac += s_c[k] * w; }
#pragma unroll
                for (int j = 0; j < 4; ++j) { red[(kg * 96 + 4 * cg + j) * 2] = al[j]; red[(kg * 96 + 4 * cg + j) * 2 + 1] = ac[j]; }
            }
            __syncthreads();
            if (tid < 96) { float sl = 0.f, sc = 0.f;
                for (int q = 0; q < 21; ++q) { sl += red[(q * 96 + tid) * 2]; sc += red[(q * 96 + tid) * 2 + 1]; }
                const float b = a.b_mod()[layer * 12288 + n0 + tid];
                MODL[layer * 12288 + n0 + tid] = sl + b;
                if (layer == 0 && n0 + tid < 4096) MODC[n0 + tid] = sc + b; }
            __syncthreads();
        }
    }
    {
        LAS float* tab = (LAS float*)lds;
        for (int j = tid; j < 8192; j += NTHR) tab[j] = cospif((float)j * (1.0f / 4096.0f));
        __syncthreads();
        const int gt = blockIdx.x * NTHR + tid, NT_ = G * NTHR;
        float* RC = (float*)(a.ws() + WS_ROPE); float* RS = RC + 128 * 16;
        for (int i = gt; i < 128 * 16; i += NT_) { const int pos = i >> 4, j = i & 15; const float inv = powf(10000.0f, -(float)j * (1.0f / 16.0f)); const float ang = (float)pos * inv; RC[i] = cosf(ang); RS[i] = sinf(ang); }
        bf16_t* CS = (bf16_t*)(a.ws() + WS_CS);
        for (int i = gt; i < 512 * 512; i += NT_) { const int r = i >> 9, d = i & 511, m = r >> 1, ri = r & 1; const int j = (((m * d) & 511) * 16 + (ri ? 2048 : 0)) & 8191; CS[i] = (bf16_t)f2bf(tab[j]); }
        bf16_t* A1 = (bf16_t*)(a.ws() + WS_A1);
        for (int i = gt; i < 128 * 128; i += NT_) { const int m1 = i >> 7, k = i & 127, k1 = m1 >> 1, rp = m1 & 1, ri = k >> 6, t1 = k & 63; int j = ((t1 * k1) & 63) * 128;
            if (rp == 0 && ri == 1) j -= 2048; if (rp == 1 && ri == 0) j += 2048; A1[i] = (bf16_t)f2bf(tab[j & 8191]); }
        bf16_t* A2 = (bf16_t*)(a.ws() + WS_A2);
        for (int i = gt; i < 128 * 256; i += NT_) { const int k2 = i >> 8, k = i & 255, ri = k >> 7, t2 = k & 127; int j = ((t2 * k2) & 127) * 64; if (ri) j -= 2048; A2[i] = (bf16_t)f2bf(tab[j & 8191]); }
        float* TW = (float*)(a.ws() + WS_TW);
        for (int i = gt; i < 64 * 128; i += NT_) { const int k1 = i >> 7, t2 = i & 127, j = t2 * k1; TW[2 * i] = tab[j]; TW[2 * i + 1] = tab[(j - 2048) & 8191]; }
        __syncthreads();
    }
    {
        const int gw = blockIdx.x * NWAVES + wave, NGW = G * NWAVES;
        LAS float* scr = (LAS float*)(lds + wave * 16384);
        constexpr int I_IN = (DM / 64) * (INC / 32), I_SQ = (DM / 64) * (DM / 32);
        for (int it = gw; it < I_IN + 2 * I_SQ; it += NGW) {
            int r = it;
            if (r < I_IN) { transpose_item(a.w_in(), DM, INC, (bf16_t*)(a.ws() + WS_WIN), 0, 0, scr, r, lane); continue; } r -= I_IN;
            if (r < I_SQ) { transpose_item(a.w_out(), DM, DM, (bf16_t*)(a.ws() + WS_WOUT), 0, 0, scr, r, lane); continue; } r -= I_SQ;
            transpose_item(a.w_fo(), DM, DM, (bf16_t*)(a.ws() + WS_WFO), 0, 0, scr, r, lane);
        }
        convert_moe_items(a, 0, lds, 0, L0_A, gw, NGW, wave, lane);
    }
}

__device__ __forceinline__ void norm_mod_row(const float* xrow, const float* gain, const float* shift, const float* scale, bf16_t* orow, int lane) {
    f32x4 v[8]; float ss = 0.f;
#pragma unroll
    for (int j = 0; j < 8; ++j) { v[j] = *(const f32x4*)(xrow + j * 256 + lane * 4); ss += (v[j].x * v[j].x + v[j].y * v[j].y) + (v[j].z * v[j].z + v[j].w * v[j].w); }
    const float rstd = 1.0f / sqrtf(wave_sum(ss) * (1.0f / DM) + EPS);
#pragma unroll
    for (int j = 0; j < 8; ++j) { const int c = j * 256 + lane * 4; const f32x4 g = *(const f32x4*)(gain + c), sh = *(const f32x4*)(shift + c), sc = *(const f32x4*)(scale + c);
        const f32x4 y = v[j] * rstd * g * (1.0f + sc) + sh;
        u32x2 w; w.x = pk2(y.x, y.y); w.y = pk2(y.z, y.w); *(u32x2*)(orow + c) = w; }
}

__device__ __forceinline__ void router_phase(const Ctx& a, int layer, LAS unsigned char* lds, int G) {
    const int tid = threadIdx.x, lane = tid & 63, wave = __builtin_amdgcn_readfirstlane(tid >> 6);
    constexpr int ROWB = 4112;
    LAS unsigned char* XT = lds; LAS float* RS = (LAS float*)(lds + 32 * ROWB); LAS float* PART = (LAS float*)lds;
    const _Float16* X = (const _Float16*)(a.ws() + WS_X); bf16_t* H2 = (bf16_t*)(a.ws() + WS_H2); float* AFF = (float*)(a.ws() + WS_AFF);
    const float* mod = (const float*)(a.ws() + WS_MODL) + layer * 12288; const float* gain = a.g_ffn() + layer * DM;
    const int m = lane & 15, kq = lane >> 4;
    int unit = blockIdx.x;
    f16x4 nx[4][8];
    if (unit < SEQ / 32) {
#pragma unroll
        for (int i = 0; i < 4; ++i) {
#pragma unroll
            for (int j = 0; j < 8; ++j) nx[i][j] = *(const f16x4*)(X + (size_t)(unit * 32 + wave * 4 + i) * DM + j * 256 + lane * 4); } }
    f32x4 ca[8], cb[8];
#pragma unroll
    for (int j = 0; j < 8; ++j) { const int c = j * 256 + lane * 4; ca[j] = *(const f32x4*)(gain + c) * (1.0f + *(const f32x4*)(mod + 4 * DM + c)); cb[j] = *(const f32x4*)(mod + 3 * DM + c); }
    const float bias = ((const float*)(a.ws() + WS_WRB))[layer * 16 + m];
    for (; unit < SEQ / 32; unit += G) {
        const int r0 = unit * 32 + wave * 4;
#pragma unroll
        for (int i = 0; i < 4; ++i) {
            const int row = r0 + i; f32x4 v[8]; float ss = 0.f;
            LAS unsigned char* xt = XT + (wave * 4 + i) * ROWB + lane * 8;
#pragma unroll
            for (int j = 0; j < 8; ++j) { *(LAS f16x4*)(xt + j * 512) = nx[i][j]; v[j] = __builtin_convertvector(nx[i][j], f32x4);
                ss += (v[j].x * v[j].x + v[j].y * v[j].y) + (v[j].z * v[j].z + v[j].w * v[j].w); }
            { const int nrow = (unit + G) * 32 + wave * 4 + i;
              if (nrow < SEQ) {
#pragma unroll
                for (int j = 0; j < 8; ++j) nx[i][j] = *(const f16x4*)(X + (size_t)nrow * DM + j * 256 + lane * 4); } }
            asm volatile("" ::: "memory");
            const float rstd = 1.0f / sqrtf(wave_sum(ss) * (1.0f / DM) + EPS);
            if (lane == 0) RS[wave * 4 + i] = rstd;
#pragma unroll
            for (int j = 0; j < 8; ++j) { const int c = j * 256 + lane * 4;
                const f32x4 h = v[j] * rstd * ca[j] + cb[j];
                u32x2 w; w.x = pk2(h.x, h.y); w.y = pk2(h.z, h.w); *(u32x2*)(H2 + (size_t)row * DM + c) = w; }
        }
        f16x8 bh[8], bl[8];
        { const f16x8* WRP = (const f16x8*)(a.ws() + WS_WRP) + (size_t)layer * 2 * 4096 + wave * 512 + lane;
#pragma unroll
          for (int s = 0; s < 8; ++s) { bh[s] = WRP[s * 64]; bl[s] = WRP[4096 + s * 64]; } }
        __syncthreads();
        f32x4 acc0 = {0.f, 0.f, 0.f, 0.f}, acc1 = {0.f, 0.f, 0.f, 0.f};
        { const LAS unsigned char* ap = XT + m * ROWB + (wave * 256 + kq * 8) * 2;
#pragma unroll
          for (int s = 0; s < 8; ++s) { const f16x8 a0 = *(const LAS f16x8*)(ap + s * 64), a1 = *(const LAS f16x8*)(ap + 16 * ROWB + s * 64);
            acc0 = __builtin_amdgcn_mfma_f32_16x16x32_f16(a0, bh[s], acc0, 0, 0, 0); acc0 = __builtin_amdgcn_mfma_f32_16x16x32_f16(a0, bl[s], acc0, 0, 0, 0);
            acc1 = __builtin_amdgcn_mfma_f32_16x16x32_f16(a1, bh[s], acc1, 0, 0, 0); acc1 = __builtin_amdgcn_mfma_f32_16x16x32_f16(a1, bl[s], acc1, 0, 0, 0); } }
        __syncthreads();
        *(LAS f32x4*)(PART + ((wave * 2 + 0) * 64 + lane) * 4) = acc0; *(LAS f32x4*)(PART + ((wave * 2 + 1) * 64 + lane) * 4) = acc1;
        __syncthreads();
        { const int mt = wave >> 2, r = wave & 3; float sum = 0.f;
#pragma unroll
          for (int w = 0; w < 8; ++w) sum += PART[((w * 2 + mt) * 64 + lane) * 4 + r];
          const int lr = 16 * mt + 4 * kq + r;
          const float lg = sum * (RS[lr] * (1.0f / 64.0f)) + bias;
          float mx = lg; mx = fmaxf(mx, dpp_f(mx, 0)); mx = fmaxf(mx, dpp_f(mx, 1)); mx = fmaxf(mx, dpp_f(mx, 2)); mx = fmaxf(mx, dpp_f(mx, 3));
          const float pe = expf(lg - mx); float sm = pe; sm += dpp_f(sm, 0); sm += dpp_f(sm, 1); sm += dpp_f(sm, 2); sm += dpp_f(sm, 3);
          AFF[(size_t)m * SEQ + unit * 32 + lr] = pe * (1.0f / sm); }
        __syncthreads();
    }
}

__device__ __forceinline__ void topk_expert(const Ctx& a, int e, LAS unsigned char* lds) {
    const int tid = threadIdx.x, lane = tid & 63;
    LAS unsigned* hist = (LAS unsigned*)lds; LAS unsigned* bc = hist + 256; LAS unsigned* cg = bc + 16; LAS unsigned* ce = cg + 512;
    const float* aff = (const float*)(a.ws() + WS_AFF) + (size_t)e * SEQ;
    int* IDX = (int*)(a.ws() + WS_IDX) + e * CAP; float* GATE = (float*)(a.ws() + WS_GATE) + e * CAP; int* POS = (int*)(a.ws() + WS_POS) + (size_t)e * SEQ;
    unsigned key[16];
#pragma unroll
    for (int j = 0; j < 4; ++j) { const u32x4 v = *(const u32x4*)(aff + tid * 16 + j * 4); key[4 * j] = v.x; key[4 * j + 1] = v.y; key[4 * j + 2] = v.z; key[4 * j + 3] = v.w; }
    unsigned prefix = 0u, mask = 0u, remaining = CAP;
    for (int pass = 0; pass < 4; ++pass) {
        const int shift = 24 - 8 * pass;
        if (tid < 256) hist[tid] = 0u;
        __syncthreads();
#pragma unroll
        for (int j = 0; j < 16; ++j) if ((key[j] & mask) == prefix) __hip_atomic_fetch_add(&hist[(key[j] >> shift) & 255u], 1u, __ATOMIC_RELAXED, __HIP_MEMORY_SCOPE_WORKGROUP);
        __syncthreads();
        if (tid < 64) {
            const unsigned h0 = hist[255 - 4 * lane], h1 = hist[254 - 4 * lane], h2 = hist[253 - 4 * lane], h3 = hist[252 - 4 * lane];
            const unsigned s = h0 + h1 + h2 + h3; unsigned inc = s;
#pragma unroll
            for (int o = 1; o < 64; o <<= 1) { const unsigned v = __shfl_up(inc, o); if (lane >= o) inc += v; }
            const unsigned exc = inc - s;
            if (exc < remaining && remaining <= inc) {
                unsigned c = exc; unsigned b;
                if (c + h0 >= remaining) b = 255 - 4 * lane;
                else { c += h0; if (c + h1 >= remaining) b = 254 - 4 * lane; else { c += h1; if (c + h2 >= remaining) b = 253 - 4 * lane; else { c += h2; b = 252 - 4 * lane; } } }
                bc[0] = b; bc[1] = remaining - c;
            }
        }
        __syncthreads();
        prefix |= bc[0] << shift; mask |= 255u << shift; remaining = bc[1];
        __syncthreads();
    }
    const unsigned T = prefix, need = remaining;
    unsigned ngt = 0u, neq = 0u;
#pragma unroll
    for (int j = 0; j < 16; ++j) { ngt += key[j] > T ? 1u : 0u; neq += key[j] == T ? 1u : 0u; }
    cg[tid] = ngt; ce[tid] = neq;
    __syncthreads();
    if (tid < 64) {
        unsigned av[8], bv[8], sa = 0u, sb = 0u;
#pragma unroll
        for (int q = 0; q < 8; ++q) { av[q] = cg[lane * 8 + q]; bv[q] = ce[lane * 8 + q]; sa += av[q]; sb += bv[q]; }
        unsigned ia = sa, ib = sb;
#pragma unroll
        for (int o = 1; o < 64; o <<= 1) { const unsigned va = __shfl_up(ia, o), vb = __shfl_up(ib, o); if (lane >= o) { ia += va; ib += vb; } }
        unsigned ea = ia - sa, eb = ib - sb;
#pragma unroll
        for (int q = 0; q < 8; ++q) { cg[lane * 8 + q] = ea; ea += av[q]; ce[lane * 8 + q] = eb; eb += bv[q]; }
        if (lane == 63) bc[2] = ia;
    }
    __syncthreads();
    unsigned og = cg[tid], oe = ce[tid]; const unsigned tg = bc[2];
#pragma unroll
    for (int j = 0; j < 16; ++j) { const int token = tid * 16 + j; int slot = -1;
        if (key[j] > T) slot = (int)(og++);
        else if (key[j] == T) { if (oe < need) slot = (int)(tg + oe); ++oe; }
        POS[token] = slot;
        if (slot >= 0) { IDX[slot] = token; GATE[slot] = __uint_as_float(key[j]); } }
    __syncthreads();
}

__device__ __forceinline__ void combine_phase(const Ctx& a, int layer, int G) {
    const int tid = threadIdx.x, lane = tid & 63, wave = __builtin_amdgcn_readfirstlane(tid >> 6);
    _Float16* X = (_Float16*)(a.ws() + WS_X); const bf16_t* Y = (const bf16_t*)(a.ws() + WS_Y); const int* POS = (const int*)(a.ws() + WS_POS);
    const float* modl = (const float*)(a.ws() + WS_MODL);
    const float* gf = modl + layer * 12288 + 5 * DM;
    const int gw = blockIdx.x * NWAVES + wave, NGW = G * NWAVES;
    int pl[4]; f16x4 nx[4][8];
#pragma unroll
    for (int i = 0; i < 4; ++i) { const int row = gw + i * NGW; pl[i] = -1;
        if (row < SEQ) { pl[i] = (lane < NE) ? POS[(size_t)lane * SEQ + row] : -1;
#pragma unroll
            for (int j = 0; j < 8; ++j) nx[i][j] = *(const f16x4*)(X + (size_t)row * DM + j * 256 + lane * 4); } }
    for (int base = gw; base < SEQ; base += 4 * NGW) {
#pragma unroll
      for (int i = 0; i < 4; ++i) { const int row = base + i * NGW;
       if (row < SEQ) {
        _Float16* xr = X + (size_t)row * DM; f32x4 v[8], sum[8];
        const int plc = pl[i]; unsigned long long sel = __ballot(plc >= 0);
#pragma unroll
        for (int j = 0; j < 8; ++j) { v[j] = __builtin_convertvector(nx[i][j], f32x4); sum[j] = (f32x4){0.f, 0.f, 0.f, 0.f}; }
        { const int nrow = row + 4 * NGW;
          if (nrow < SEQ) { pl[i] = (lane < NE) ? POS[(size_t)lane * SEQ + nrow] : -1;
#pragma unroll
            for (int j = 0; j < 8; ++j) nx[i][j] = *(const f16x4*)(X + (size_t)nrow * DM + j * 256 + lane * 4); } }
        while (sel) { const int e0 = __builtin_ctzll(sel); sel &= sel - 1;
            const bf16_t* y0 = Y + (size_t)(e0 * CAP + __builtin_amdgcn_readlane(plc, e0)) * DM + lane * 4;
            u32x2 w0[8];
#pragma unroll
            for (int j = 0; j < 8; ++j) w0[j] = *(const u32x2*)(y0 + j * 256);
#pragma unroll
            for (int j = 0; j < 8; ++j) sum[j] += (f32x4){bflo(w0[j].x), bfhi(w0[j].x), bflo(w0[j].y), bfhi(w0[j].y)}; }
        float ss = 0.f;
#pragma unroll
        for (int j = 0; j < 8; ++j) { const int c = j * 256 + lane * 4; v[j] = v[j] + *(const f32x4*)(gf + c) * sum[j];
            ss += (v[j].x * v[j].x + v[j].y * v[j].y) + (v[j].z * v[j].z + v[j].w * v[j].w); }
        const float rstd = 1.0f / sqrtf(wave_sum(ss) * (1.0f / DM) + EPS);
        if (layer == 0) {
            bf16_t* orow = (bf16_t*)(a.ws() + WS_HCAT) + (size_t)row * DM; const float* m1 = modl + 12288; const float* gain = a.g_mix() + DM;
            float nyq[4] = {0.f, 0.f, 0.f, 0.f};
#pragma unroll
            for (int j = 0; j < 8; ++j) { const int c = j * 256 + lane * 4; stx4(xr + c, v[j]);
                const f32x4 y = v[j] * rstd * *(const f32x4*)(gain + c) * (1.0f + *(const f32x4*)(m1 + DM + c)) + *(const f32x4*)(m1 + c);
                u32x2 w; w.x = pk2(y.x, y.y); w.y = pk2(y.z, y.w); *(u32x2*)(orow + c) = w;
                nyq[j >> 1] += (bflo(w.x) - bfhi(w.x)) + (bflo(w.y) - bfhi(w.y)); }
            { bf16_t* WCT = (bf16_t*)(a.ws() + WS_WCT); const int n = (row & 127) * 64 + (row >> 7);
                float mine = 0.f;
#pragma unroll
                for (int g = 0; g < 4; ++g) { const float sg = wave_sum(nyq[g]); mine = (lane == g) ? sg : mine; }
                if (lane < 4) { WCT[(size_t)(2048 + 2 * lane) * 8192 + n] = (bf16_t)f2bf(mine); WCT[(size_t)(2049 + 2 * lane) * 8192 + n] = 0; } }
        } else {
            float* orow = a.out() + (size_t)row * DM;
#pragma unroll
            for (int j = 0; j < 8; ++j) { const int c = j * 256 + lane * 4; *(f32x4*)(orow + c) = v[j] * rstd * *(const f32x4*)(a.g_final() + c); }
        }
       } }
    }
}

#define PHASE_FN static __device__ __forceinline__ void
#define PH_PRO extern __shared__ __attribute__((aligned(16))) unsigned char lds_raw[]; LAS unsigned char* lds = (LAS unsigned char*)lds_raw; (void)lds; \
    const int tid = threadIdx.x, lane = tid & 63, wave = __builtin_amdgcn_readfirstlane(tid >> 6), G = gridDim.x; (void)lane; (void)wave; \
    Ctx a; a.PT = (const LAS unsigned long long*)(lds + LDSCTL_OFF + 64); const int gw = blockIdx.x * NWAVES + wave, NGW = G * NWAVES; (void)gw; (void)NGW;

__device__ __forceinline__ void router_prep(const Ctx& a, int nb, int tid, int lane, int wave) {
    const float* MODL = (const float*)(a.ws() + WS_MODL);
    for (int it = blockIdx.x * NTHR + tid; it < 2 * 4096; it += nb * NTHR) { const int layer = it >> 12, kc = (it >> 4) & 255, n = it & 15;
        const float* w_r = a.w_r() + (size_t)layer * DM * NE; const float* gain = a.g_ffn() + layer * DM; const float* sc = MODL + layer * 12288 + 4 * DM;
        f16x8 hi, lo;
#pragma unroll
        for (int i = 0; i < 8; ++i) { const int c = kc * 8 + i; const float wv = 64.0f * gain[c] * (1.0f + sc[c]) * w_r[c * NE + n];
            const _Float16 h = (_Float16)wv; hi[i] = h; lo[i] = (_Float16)(wv - (float)h); }
        f16x8* WRP = (f16x8*)(a.ws() + WS_WRP) + (size_t)layer * 2 * 4096;
        WRP[kc * 16 + n] = hi; WRP[4096 + kc * 16 + n] = lo; }
    const int gwb = blockIdx.x * NWAVES + wave, ngw = nb * NWAVES;
    if (gwb >= ngw - 32 && gwb < ngw) { const int q = gwb - (ngw - 32), layer = q >> 4, e = q & 15;
        const float* w_r = a.w_r() + (size_t)layer * DM * NE; const float* sh = MODL + layer * 12288 + 3 * DM; float acc = 0.f;
#pragma unroll 8
        for (int i = 0; i < 32; ++i) { const int c = lane + 64 * i; acc = fmaf(sh[c], w_r[c * NE + e], acc); }
        acc = wave_sum(acc);
        if (lane == 0) ((float*)(a.ws() + WS_WRB))[q] = acc; }
}
PHASE_FN ph_prologue() { PH_PRO; p0_prologue(a, lds, G); }
PHASE_FN ph_hcat() { PH_PRO;
    const float* MODL = (const float*)(a.ws() + WS_MODL); const float* MODC = (const float*)(a.ws() + WS_MODC); bf16_t* HCAT = (bf16_t*)(a.ws() + WS_HCAT);
    const float* ctx = a.ctx(); const float* x = a.x(); const float* gm = a.g_mix();
    f32x4 nx[4][8];
#pragma unroll
    for (int i = 0; i < 4; ++i) { const int row = gw + i * NGW;
        if (row < SEQ) {
#pragma unroll
            for (int j = 0; j < 8; ++j) nx[i][j] = __builtin_nontemporal_load((const f32x4*)(x + (size_t)row * DM + j * 256 + lane * 4)); } }
    for (int r = blockIdx.x; r < CTXL; r += G) { LAS float* red = (LAS float*)lds; const int c = wave * 256 + lane * 4;
        const f32x4 cv = *(const f32x4*)(ctx + (size_t)r * DM + c), g4 = *(const f32x4*)(gm + c), s4 = *(const f32x4*)(MODC + DM + c), h4 = *(const f32x4*)(MODC + c);
        const float ps = wave_sum((cv.x * cv.x + cv.y * cv.y) + (cv.z * cv.z + cv.w * cv.w));
        if (lane == 0) red[wave] = ps;
        __syncthreads();
        float tot = 0.f;
#pragma unroll
        for (int w = 0; w < NWAVES; ++w) tot += red[w];
        const float rstd = 1.0f / sqrtf(tot * (1.0f / DM) + EPS);
        const f32x4 y = cv * rstd * g4 * (1.0f + s4) + h4;
        u32x2 w; w.x = pk2(y.x, y.y); w.y = pk2(y.z, y.w); *(u32x2*)(HCAT + (size_t)r * DM + c) = w;
        __syncthreads(); }
    for (int base = gw; base < SEQ; base += 4 * NGW) {
#pragma unroll
        for (int i = 0; i < 4; ++i) { const int row = base + i * NGW;
            if (row < SEQ) {
                float ss = 0.f;
#pragma unroll
                for (int j = 0; j < 8; ++j) { const f32x4 t = nx[i][j]; ss += (t.x * t.x + t.y * t.y) + (t.z * t.z + t.w * t.w); }
                const float rstd = 1.0f / sqrtf(wave_sum(ss) * (1.0f / DM) + EPS);
                bf16_t* orow = HCAT + (size_t)(CTXL + row) * DM;
#pragma unroll
                for (int j = 0; j < 8; ++j) { const int c = j * 256 + lane * 4; const f32x4 y = nx[i][j] * rstd * (*(const f32x4*)(gm + c) * (1.0f + *(const f32x4*)(MODL + DM + c))) + *(const f32x4*)(MODL + c);
                    u32x2 w; w.x = pk2(y.x, y.y); w.y = pk2(y.z, y.w); *(u32x2*)(orow + c) = w; }
                const int nrow = row + 4 * NGW;
                if (nrow < SEQ) {
#pragma unroll
                    for (int j = 0; j < 8; ++j) nx[i][j] = __builtin_nontemporal_load((const f32x4*)(x + (size_t)nrow * DM + j * 256 + lane * 4)); }
            } }
    }
}
PHASE_FN ph_win() { PH_PRO;
    unsigned char* ws = a.ws();
    const pg8::Geo g = pg8::geo_rowmajor(ws + WS_HCAT, DM, ws + WS_WIN, DM, DM);
    pg8::WinOrder S; S.init_win(G, (int)blockIdx.x);
    pg8::EpiWin E{(bf16_t*)(ws + WS_Q), (bf16_t*)(ws + WS_K), (bf16_t*)(ws + WS_V), (bf16_t*)(ws + WS_UV), (const float*)(ws + WS_ROPE), (const float*)(ws + WS_ROPE) + 128 * 16};
    pg8::gemm_phase<pg8::EpiWin, pg8::WinOrder, true, true>(lds, g, S, E);
    { const int nu = S.total(), maxu = (nu + G - 1) / G, nfull = nu - (maxu - 1) * G;
      if ((int)blockIdx.x >= nfull && nfull < G) convert_moe_items(a, 0, lds, L0_B, MOE_ITEMS, ((int)blockIdx.x - nfull) * NWAVES + wave, (G - nfull) * NWAVES, wave, lane);
      else if (nfull >= G) { convert_moe_items(a, 0, lds, L0_B, MOE_ITEMS, gw, NGW, wave, lane); router_prep(a, G, tid, lane, wave); }
      else router_prep(a, nfull, tid, lane, wave); }
}
PHASE_FN ph_attn() { PH_PRO;
    unsigned char* ws = a.ws();
    float lam;
    { const float q1 = a.lq1()[lane] * a.lk1()[lane], q2 = a.lq2()[lane] * a.lk2()[lane]; lam = expf(wave_sum(q1)) - expf(wave_sum(q2)) + 0.2f; }
    const float* gs = a.g_subln();
    for (int i = blockIdx.x; i < 512; i += G)
        att2::attn_unit<8>((const bf16_t*)(ws + WS_Q), (const bf16_t*)(ws + WS_K), (const bf16_t*)(ws + WS_V), (bf16_t*)(ws + WS_CAT), i & 7, i >> 3, lam, 0.8f, gs, lds);
}
PHASE_FN ph_sgu() { PH_PRO;
    unsigned char* ws = a.ws();
    const float *w_sp = a.w_sp(), *b_sp = a.b_sp(), *ln_g = a.ln_g(), *ln_b = a.ln_b();
    for (int i = blockIdx.x; i < 512; i += G)
        att::sgu_unit((const bf16_t*)(ws + WS_UV), (bf16_t*)(ws + WS_CAT), w_sp, b_sp, ln_g, ln_b, i >> 3, i & 7, (char*)lds_raw);
}
PHASE_FN ph_wout() { PH_PRO;
    unsigned char* ws = a.ws();
    const int GH = (G >= 2) ? G / 2 : G;
    if ((int)blockIdx.x < GH) {
        const pg8::Geo g = pg8::geo_rowmajor(ws + WS_CAT, DM, ws + WS_WOUT, DM, DM);
        pg8::StaticOrder S; S.init(SEQ, DM, GH, (int)blockIdx.x);
        pg8::EpiResidN<true> E{a.x(), (_Float16*)(ws + WS_X), (const float*)(ws + WS_MODL) + 2 * DM};
        pg8::gemm_phase<pg8::EpiResidN<true>, pg8::StaticOrder, true, true>(lds, g, S, E);
        if (GH == G) convert_moe_items(a, 1, lds, 0, L1_A, gw, NGW, wave, lane);
    } else convert_moe_items(a, 1, lds, 0, L1_A, ((int)blockIdx.x - GH) * NWAVES + wave, (G - GH) * NWAVES, wave, lane);
}
PHASE_FN ph_stepa() { PH_PRO;
    unsigned char* ws = a.ws();
    pg8::Geo g = pg8::geo_rowmajor(ws + WS_CS, 512, ws + WS_HCAT, DM, 512);
    g.aB = 1024;
    g.bmode = 1; g.hB = (size_t)2 * g.ldb2; g.tB = (size_t)4 * g.ldb2;
    pg8::StepAOrder S{G, (int)blockIdx.x};
    pg8::EpiBf16 E{(bf16_t*)(ws + WS_WCT), SEQ, 512};
    pg8::gemm_phase<pg8::EpiBf16, pg8::StepAOrder, true, true>(lds, g, S, E);
}
PHASE_FN ph_dft() { PH_PRO;
    unsigned char* ws = a.ws();
    fft::fft_phase((const bf16_t*)(ws + WS_WCT), (bf16_t*)(ws + WS_F), (const bf16_t*)(ws + WS_A1), (const bf16_t*)(ws + WS_A2), (const float*)(ws + WS_TW), (char*)lds_raw, G);
}
PHASE_FN ph_wfo() { PH_PRO;
    unsigned char* ws = a.ws();
    pg8::Geo g = pg8::geo_rowmajor(ws + WS_F, DM, ws + WS_WFO, DM, DM);
    g.amode = 1; g.kA = 8 * 131072; g.hA = 2048; g.tA = 4096;
    pg8::StaticOrder S; S.init(SEQ, DM, G, (int)blockIdx.x);
    pg8::EpiResid<false> E{(const void*)(ws + WS_X), (_Float16*)(ws + WS_X), (const float*)(ws + WS_MODL) + 12288 + 2 * DM};
    pg8::gemm_phase<pg8::EpiResid<false>, pg8::StaticOrder, true, true>(lds, g, S, E);
}
PHASE_FN ph_router(int layer) { PH_PRO; router_phase(a, layer, lds, G); }
PHASE_FN ph_topk(int layer) { PH_PRO; for (int e = blockIdx.x; e < NE; e += G) topk_expert(a, e, lds);
    if ((int)blockIdx.x >= NE || G <= NE) { const int widx = (G <= NE) ? gw : ((int)blockIdx.x - NE) * NWAVES + wave, nw = (G <= NE) ? NGW : (G - NE) * NWAVES;
        if (layer == 0) convert_moe_items(a, 0, lds, L0_A, L0_B, widx, nw, wave, lane); else convert_moe_items(a, 1, lds, L1_A, MOE_ITEMS, widx, nw, wave, lane); } }
PHASE_FN ph_gather() { PH_PRO;
    unsigned char* ws = a.ws();
    const int* IDX = (const int*)(ws + WS_IDX); const bf16_t* H2 = (const bf16_t*)(ws + WS_H2); bf16_t* XS = (bf16_t*)(ws + WS_XS);
    for (int r = gw; r < MR; r += NGW) { const int t = IDX[r]; const u32x4* s = (const u32x4*)(H2 + (size_t)t * DM) + lane; u32x4* d = (u32x4*)(XS + (size_t)r * DM) + lane;
#pragma unroll
        for (int j = 0; j < 4; ++j) d[64 * j] = s[64 * j]; }
}
PHASE_FN ph_gateup(int layer) { PH_PRO;
    unsigned char* ws = a.ws();
    pg8::Geo g = pg8::geo_rowmajor(ws + WS_H2, DM, ws + WS_WGU + (size_t)layer * WGU_BYTES, DM, DM);
    g.aB = (size_t)2048 * DM * 2; g.hA = 0; g.tA = 0;
    pg8::MoeOrder S; S.init(MR, 2048, G, (int)blockIdx.x);
    pg8::EpiGateUp E{(bf16_t*)(ws + WS_ACT)};
    pg8::gemm_phase<pg8::EpiGateUp, pg8::MoeOrder, true, true, true>(lds, g, S, E, (const int*)(ws + WS_IDX));
}
PHASE_FN ph_down(int layer) { PH_PRO;
    unsigned char* ws = a.ws();
    pg8::Geo g = pg8::geo_rowmajor(ws + WS_ACT, FE, ws + WS_WD + (size_t)layer * WD_BYTES, FE, FE);
    g.aB = (size_t)2048 * FE * 2;
    pg8::MoeOrder S; S.init(MR, DM, G, (int)blockIdx.x);
    pg8::EpiDown E{(bf16_t*)(ws + WS_Y), (const float*)(ws + WS_GATE)};
    pg8::gemm_phase<pg8::EpiDown, pg8::MoeOrder, true, true>(lds, g, S, E);
}
PHASE_FN ph_combine(int layer) { PH_PRO; combine_phase(a, layer, G); }

__global__ void __launch_bounds__(NTHR, 2) fwd(Args ka) {
    extern __shared__ __attribute__((aligned(16))) unsigned char lds_raw[];
    LAS unsigned char* lds = (LAS unsigned char*)lds_raw;
    const int tid = threadIdx.x;
    const int lo = ka.lo, hi = ka.hi;
    for (int u = tid; u < 16; u += NTHR) ((LAS unsigned*)(lds + LDSCTL_OFF))[u] = 0u;
    LAS unsigned long long* PTW = (LAS unsigned long long*)(lds + LDSCTL_OFF + 64);
    if (tid == 0) {
        PTW[0] = (unsigned long long)ka.x;
        PTW[1] = (unsigned long long)ka.c;
        PTW[2] = (unsigned long long)ka.ctx;
        PTW[3] = (unsigned long long)ka.c_ctx;
        PTW[4] = (unsigned long long)ka.w_mod;
        PTW[5] = (unsigned long long)ka.b_mod;
        PTW[6] = (unsigned long long)ka.g_mix;
        PTW[7] = (unsigned long long)ka.g_ffn;
        PTW[8] = (unsigned long long)ka.w_in;
        PTW[9] = (unsigned long long)ka.w_out;
        PTW[10] = (unsigned long long)ka.lq1;
        PTW[11] = (unsigned long long)ka.lk1;
        PTW[12] = (unsigned long long)ka.lq2;
        PTW[13] = (unsigned long long)ka.lk2;
        PTW[14] = (unsigned long long)ka.g_subln;
        PTW[15] = (unsigned long long)ka.ln_g;
        PTW[16] = (unsigned long long)ka.ln_b;
        PTW[17] = (unsigned long long)ka.w_sp;
        PTW[18] = (unsigned long long)ka.b_sp;
        PTW[19] = (unsigned long long)ka.w_fo;
        PTW[20] = (unsigned long long)ka.w_r;
        PTW[21] = (unsigned long long)ka.w_gate;
        PTW[22] = (unsigned long long)ka.w_up;
        PTW[23] = (unsigned long long)ka.w_down;
        PTW[24] = (unsigned long long)ka.g_final;
        PTW[25] = (unsigned long long)ka.out; PTW[26] = (unsigned long long)ka.ws;
    }
    __syncthreads();
    XcdBarrier bar; bar.bar = (unsigned*)(ka.ws + WS_CTL); bar.x = 0; bar.st = nullptr;
    if (hi - lo > 1) bar = xcd_barrier_post((unsigned*)(ka.ws + WS_CTL), (volatile LAS unsigned*)(lds + LDSCTL_OFF));
#ifndef PHMASK
#define PHMASK 0xFFFFFFu
#endif
#define IN(k) (((PHMASK >> ((k) == 21 ? 3 : (k) == 22 ? 10 : (k))) & 1u) && lo <= ((k) == 21 ? 3 : (k) == 22 ? 10 : (k)) && ((k) == 21 ? 3 : (k) == 22 ? 10 : (k)) < hi)
#define SEAM(k) do { if (IN(k) && IN((k) + 1)) xcd_barrier(bar); } while (0)
#ifndef TPROBE
#define TPROBE -1
#endif
#ifndef TSIDE
#define TSIDE 0
#endif
#ifndef TAMP
#define TAMP 9
#endif
#define RUNPH(k, call) do { if (IN(k)) { if (TPROBE == (k)) { const unsigned long long t0_ = __builtin_amdgcn_s_memrealtime(); call; __syncthreads(); \
        const unsigned long long t1_ = __builtin_amdgcn_s_memrealtime(); const bool on_ = TSIDE == 0 || (TSIDE == 1 ? (int)blockIdx.x < (int)gridDim.x / 2 : (int)blockIdx.x >= (int)gridDim.x / 2); \
        if (on_) { const unsigned long long end_ = t1_ + (unsigned long long)TAMP * (t1_ - t0_); while (__builtin_amdgcn_s_memrealtime() < end_) __builtin_amdgcn_s_sleep(8); } } else { call; } } } while (0)
    RUNPH(0, ph_prologue());             SEAM(0);
    RUNPH(1, ph_hcat());                 SEAM(1);
    RUNPH(2, ph_win());                  SEAM(2);
    RUNPH(3, ph_attn());                 RUNPH(21, ph_sgu()); SEAM(3);
    RUNPH(4, ph_wout());                 SEAM(4);
    RUNPH(5, ph_router(0));              SEAM(5);
    RUNPH(6, ph_topk(0));                if (IN(6) && IN(8)) xcd_barrier(bar);
    RUNPH(8, ph_gateup(0));              SEAM(8);
    RUNPH(9, ph_down(0));                SEAM(9);
    RUNPH(10, ph_combine(0));            SEAM(10);
    RUNPH(11, ph_stepa());               SEAM(11);
    RUNPH(12, ph_dft());                 SEAM(12);
    RUNPH(13, ph_wfo());                 SEAM(13);
    RUNPH(14, ph_router(1));             SEAM(14);
    RUNPH(15, ph_topk(1));               if (IN(15) && IN(17)) xcd_barrier(bar);
    RUNPH(17, ph_gateup(1));             SEAM(17);
    RUNPH(18, ph_down(1));               SEAM(18);
    RUNPH(19, ph_combine(1));
#undef RUNPH
#undef IN
#undef SEAM
}

extern "C" void kernel_launch(void* const* d_in, const int* in_sizes, int n_in, void* d_out, int out_size, void* d_ws, size_t ws_size, hipStream_t stream) {
    static int grid = 0;
    if (grid == 0) {
        if (n_in != 25 || in_sizes[0] != SEQ * DM || out_size != SEQ * DM || ws_size < WS_END) {
            fprintf(stderr, "kernel_launch: unexpected shapes: n_in %d in0 %d out %d ws %zu (need %zu)\n", n_in, n_in > 0 ? in_sizes[0] : -1, out_size, ws_size, (size_t)WS_END); grid = -1; return; }
        int dev = 0, cus = 0, per_cu = 0;
        if (hipGetDevice(&dev) != hipSuccess || hipDeviceGetAttribute(&cus, hipDeviceAttributeMultiprocessorCount, dev) != hipSuccess) { grid = -1; return; }
        if (hipFuncSetAttribute((const void*)fwd, hipFuncAttributeMaxDynamicSharedMemorySize, LDS_BYTES) != hipSuccess) { fprintf(stderr, "kernel_launch: hipFuncSetAttribute failed\n"); grid = -1; return; }
        if (hipOccupancyMaxActiveBlocksPerMultiprocessor(&per_cu, (const void*)fwd, NTHR, LDS_BYTES) != hipSuccess || per_cu < 1) fprintf(stderr, "kernel_launch: occupancy query says %d\n", per_cu);
        (void)hipGetLastError();
        grid = cus;
    }
    if (grid < 0) return;
    (void)hipMemsetAsync((char*)d_ws + WS_CTL, 0, CTL_BYTES, stream);
    Args a{};
    const float** p = (const float**)&a;
    for (int i = 0; i < 25; ++i) p[i] = (const float*)d_in[i];
    a.out = (float*)d_out; a.ws = (unsigned char*)d_ws;
#ifndef ONE_LAUNCH
    for (int ph = 0; ph < NPH; ++ph) { a.lo = ph; a.hi = ph + 1; hipLaunchKernelGGL(fwd, dim3(grid), dim3(NTHR), LDS_BYTES, stream, a); }
#else
    a.lo = 0; a.hi = NPH; hipLaunchKernelGGL(fwd, dim3(grid), dim3(NTHR), LDS_BYTES, stream, a);
#endif
    const hipError_t le = hipPeekAtLastError();
    if (le != hipSuccess) fprintf(stderr, "kernel_launch: launch failed: %s\n", hipGetErrorName(le));
}
```

```cpp
#include <hip/hip_runtime.h>
#include <hip/hip_bf16.h>
#include <cstdio>
#include <cstdint>
#define ONE_LAUNCH 1

#define GAS __attribute__((address_space(1)))
#define LAS __attribute__((address_space(3)))
typedef unsigned short bf16_t;
typedef short bf16x8 __attribute__((ext_vector_type(8)));
typedef short s16x4 __attribute__((ext_vector_type(4)));
typedef float f32x2 __attribute__((ext_vector_type(2)));
typedef float f32x4 __attribute__((ext_vector_type(4)));
typedef float f32x16 __attribute__((ext_vector_type(16)));
typedef unsigned u32x2 __attribute__((ext_vector_type(2)));
typedef _Float16 f16x4 __attribute__((ext_vector_type(4)));
typedef unsigned u32x4 __attribute__((ext_vector_type(4)));
typedef _Float16 f16x8 __attribute__((ext_vector_type(8)));

constexpr int DM = 2048, SEQ = 8192, CTXL = 256, MC = SEQ + CTXL, INC = 5120, NE = 16, CAP = 1024, FE = 1024, MR = NE * CAP;
constexpr float EPS = 1e-6f;
constexpr int NWAVES = 8, NTHR = 512;
constexpr int NPH = 20;

constexpr size_t al256(size_t x) { return (x + 255) / 256 * 256; }
constexpr size_t WS_CTL = 0, CTL_BYTES = 65536;
constexpr size_t WS_MODL = WS_CTL + CTL_BYTES;
constexpr size_t WS_MODC = WS_MODL + 2 * 12288 * 4;
constexpr size_t WS_ROPE = WS_MODC + 4096 * 4;
constexpr size_t WS_CS = WS_ROPE + 2 * 128 * 16 * 4;
constexpr size_t WS_WIN = WS_CS + 1024 * 512 * 2;
constexpr size_t WS_WOUT = WS_WIN + (size_t)INC * DM * 2;
constexpr size_t WS_WFO = WS_WOUT + (size_t)DM * DM * 2;
constexpr size_t WGU_BYTES = (size_t)NE * 2048 * DM * 2, WD_BYTES = (size_t)NE * DM * FE * 2;
constexpr size_t WS_WGU = WS_WFO + (size_t)DM * DM * 2;
constexpr size_t WS_WD = WS_WGU + 2 * WGU_BYTES;
constexpr size_t WS_HCAT = WS_WD + 2 * WD_BYTES;
constexpr size_t WS_Q = WS_HCAT + (size_t)MC * DM * 2;
constexpr size_t WS_K = WS_Q + (size_t)MC * 1024 * 2;
constexpr size_t WS_V = WS_K + (size_t)MC * 1024 * 2;
constexpr size_t WS_UV = WS_V + (size_t)MC * 1024 * 2;
constexpr size_t WS_CAT = WS_UV + (size_t)MC * DM * 2;
constexpr size_t WS_X = WS_CAT + (size_t)SEQ * DM * 2;
constexpr size_t WS_H2 = WS_X + (size_t)SEQ * DM * 4;
constexpr size_t WS_AFF = WS_H2 + (size_t)SEQ * DM * 2;
constexpr size_t WS_IDX = WS_AFF + (size_t)NE * SEQ * 4;
constexpr size_t WS_GATE = WS_IDX + (size_t)MR * 4;
constexpr size_t WS_POS = WS_GATE + (size_t)MR * 4;
constexpr size_t WS_XS = WS_POS + (size_t)NE * SEQ * 4;
constexpr size_t WS_WRP = WS_XS;
constexpr size_t WS_WRB = WS_WRP + 2 * 2 * 4096 * 16;
constexpr size_t WS_ACT = WS_XS + (size_t)MR * DM * 2;
constexpr size_t WS_Y = WS_ACT + (size_t)MR * FE * 2;
constexpr size_t WS_WCT = WS_Y + (size_t)MR * DM * 2;
constexpr size_t WS_F = WS_WCT + (size_t)4096 * 8192 * 2;
constexpr size_t WS_A1 = WS_F + (size_t)SEQ * DM * 2;
constexpr size_t WS_A2 = WS_A1 + 128 * 128 * 2;
constexpr size_t WS_TW = WS_A2 + 128 * 256 * 2;
constexpr size_t WS_END = WS_TW + 64 * 128 * 2 * 4;

constexpr int LDS_BYTES = 147456, LDSCTL_OFF = 146944;

__device__ __forceinline__ unsigned f2bf(float f) { unsigned u = __builtin_bit_cast(unsigned, f); return (u + 0x7fffu + ((u >> 16) & 1u)) >> 16; }
__device__ __forceinline__ unsigned pk2(float lo, float hi) { return f2bf(lo) | (f2bf(hi) << 16); }
__device__ __forceinline__ float bflo(unsigned w) { return __builtin_bit_cast(float, w << 16); }
__device__ __forceinline__ float bfhi(unsigned w) { return __builtin_bit_cast(float, w & 0xffff0000u); }
__device__ __forceinline__ unsigned cvt2_bf16(float lo, float hi) { unsigned r; asm("v_cvt_pk_bf16_f32 %0, %1, %2" : "=v"(r) : "v"(lo), "v"(hi)); return r; }
__device__ __forceinline__ unsigned cvt_pk_bf16(float lo, float hi) { unsigned r; asm volatile("v_cvt_pk_bf16_f32 %0, %1, %2" : "=v"(r) : "v"(lo), "v"(hi)); return r; }
__device__ __forceinline__ float dpp_f(float v, int ctrl_sel) {
    const int x = __builtin_bit_cast(int, v);
    int r;
    switch (ctrl_sel) {
        case 0: r = __builtin_amdgcn_update_dpp(0, x, 0xB1, 0xF, 0xF, true); break;
        case 1: r = __builtin_amdgcn_update_dpp(0, x, 0x4E, 0xF, 0xF, true); break;
        case 2: r = __builtin_amdgcn_update_dpp(0, x, 0x141, 0xF, 0xF, true); break;
        default: r = __builtin_amdgcn_update_dpp(0, x, 0x140, 0xF, 0xF, true); break;
    }
    return __builtin_bit_cast(float, r);
}
__device__ __forceinline__ float wave_sum(float v) {
    v += dpp_f(v, 0); v += dpp_f(v, 1); v += dpp_f(v, 2); v += dpp_f(v, 3);
    { auto rr = __builtin_amdgcn_permlane16_swap(__float_as_uint(v), __float_as_uint(v), false, false); v = __uint_as_float(rr[0]) + __uint_as_float(rr[1]); }
    { auto rr = __builtin_amdgcn_permlane32_swap(__float_as_uint(v), __float_as_uint(v), false, false); v = __uint_as_float(rr[0]) + __uint_as_float(rr[1]); }
    return v;
}
__device__ __forceinline__ f32x4 ldx4(const _Float16* p) { return __builtin_convertvector(*(const f16x4*)p, f32x4); }
__device__ __forceinline__ void stx4(_Float16* p, f32x4 v) { *(f16x4*)p = __builtin_convertvector(v, f16x4); }
__device__ __forceinline__ float wave_max(float v) {
#pragma unroll
    for (int o = 1; o < 64; o <<= 1) v = fmaxf(v, __shfl_xor(v, o));
    return v;
}

#define XB_TMO      128
#define XB_XCNT(j)  (256  + 64 * (j))
#define XB_XSUB(j)  (1280 + 64 * (j))
#define XB_XGEN(j)  (2304 + 64 * (j))
#define XB_TOP      3328
#define XB_TOPGEN   3392
#define XCD_BAR_WORDS 3456
#define XB_SPIN_CAP (1u << 18)
__device__ __forceinline__ unsigned xb_ld(unsigned* p)              { return __hip_atomic_load(p, __ATOMIC_RELAXED, __HIP_MEMORY_SCOPE_AGENT); }
__device__ __forceinline__ unsigned xb_add(unsigned* p, unsigned v) { return __hip_atomic_fetch_add(p, v, __ATOMIC_RELAXED, __HIP_MEMORY_SCOPE_AGENT); }
__device__ __forceinline__ unsigned xb_xcc_id() { return (unsigned)__builtin_amdgcn_s_getreg((3 << 11) | 20) & 0xFu; }
#define XB_SPIN(cond, bar) do { unsigned _sp = 0; while (cond) { __builtin_amdgcn_s_sleep(1); \
    if ((++_sp & 255u) == 0u) { if (xb_ld(&(bar)[XB_TMO])) break; if (_sp > XB_SPIN_CAP) { atomicAdd(&(bar)[XB_TMO], 1u); break; } } } } while (0)
struct XcdBarrier { unsigned* bar; unsigned x; volatile LAS unsigned* st; };
__device__ __forceinline__ XcdBarrier xcd_barrier_post(unsigned* bar, volatile LAS unsigned* st) {
    XcdBarrier b; b.bar = bar; b.x = xb_xcc_id(); b.st = st;
    if (threadIdx.x == 0) (void)xb_add(&bar[XB_XCNT(b.x)], 1u);
    return b;
}
__device__ __forceinline__ void xcd_barrier_complete(unsigned* bar, unsigned x, unsigned& nloc, unsigned& nx) {
    const unsigned G = gridDim.x * gridDim.y * gridDim.z;
    unsigned sum, cnt, mine, sp = 0u;
    for (;;) {
        sum = 0u; cnt = 0u; mine = 0u;
#pragma unroll
        for (unsigned j = 0; j < 16; ++j) { const unsigned c = xb_ld(&bar[XB_XCNT(j)]); sum += c; cnt += (c > 0u) ? 1u : 0u; mine = (j == x) ? c : mine; }
        if (sum == G) break;
        __builtin_amdgcn_s_sleep(1);
        if ((++sp & 255u) == 0u) { if (xb_ld(&bar[XB_TMO])) break; if (sp > XB_SPIN_CAP) { atomicAdd(&bar[XB_TMO], 1u); break; } }
    }
    nloc = mine > 0u ? mine : 1u; nx = cnt > 0u ? cnt : 1u;
}
__device__ __forceinline__ void xcd_barrier(const XcdBarrier& b) {
    asm volatile("s_waitcnt vmcnt(0)" ::: "memory");
    __syncthreads();
    if (threadIdx.x == 0) {
        unsigned* bar = b.bar;
        __builtin_amdgcn_s_waitcnt(0);
        unsigned nloc = b.st[0], nx = b.st[1];
        if (nloc == 0u) { xcd_barrier_complete(bar, b.x, nloc, nx); b.st[0] = nloc; b.st[1] = nx; }
        const unsigned old = xb_add(&bar[XB_XSUB(b.x)], 1u);
        const unsigned gen = old / nloc;
        if (old + 1u == (gen + 1u) * nloc) {
            __builtin_amdgcn_fence(__ATOMIC_RELEASE, "agent");
            asm volatile("s_waitcnt vmcnt(0)" ::: "memory");
            const unsigned og = xb_add(&bar[XB_TOP], 1u);
            const unsigned tg = og / nx;
            if (og + 1u == (tg + 1u) * nx) xb_add(&bar[XB_TOPGEN], 1u);
            else XB_SPIN(xb_ld(&bar[XB_TOPGEN]) == tg, bar);
            __builtin_amdgcn_fence(__ATOMIC_ACQUIRE, "agent");
            xb_add(&bar[XB_XGEN(b.x)], 1u);
            asm volatile("s_waitcnt vmcnt(0)" ::: "memory");
        } else {
            XB_SPIN(xb_ld(&bar[XB_XGEN(b.x)]) == gen, bar);
            __builtin_amdgcn_fence(__ATOMIC_ACQUIRE, "agent");
            asm volatile("s_waitcnt vmcnt(0)" ::: "memory");
        }
    }
    __syncthreads();
}

namespace pg8 {
constexpr int BM = 256, BK = 64, HALF = 128, HTB = HALF * BK * 2, STAGE_BYTES = 8 * HTB, NXCD = 8, WGM = 8;
__host__ __device__ __forceinline__ int lds_byte(int r, int c) { const int st = (r >> 4) * 2 + (c >> 5), rr = r & 15, cc = c & 31, ob = rr * 64 + cc * 2; return st * 1024 + (ob ^ (((ob >> 9) & 1) << 5)); }
__host__ __device__ __forceinline__ void stage_rc(int b, int& R, int& C) { const int st = b / 1024, sb = b % 1024, swz = sb ^ (((sb >> 9) & 1) << 5); R = (st >> 1) * 16 + swz / 64; C = (st & 1) * 32 + (swz % 64) / 2; }
__host__ __device__ __forceinline__ int perm32(int rho) { const int n = rho >> 4, i = rho & 15; return 8 * (i >> 2) + 4 * n + (i & 3); }

struct Unit { int pm, pn, aux; };
struct Geo {
    const char* A; const char* B;
    unsigned lda2, ldb2, kA, kB;
    size_t hA, hB, tA, tB, aA, aB;
    int nt, amode, bmode;
    __device__ __forceinline__ size_t offA(const Unit& u) const { return (size_t)u.pm * tA + (size_t)u.aux * aA; }
    __device__ __forceinline__ size_t offB(const Unit& u) const { return (size_t)u.pn * tB + (size_t)u.aux * aB; }
};
__device__ __forceinline__ Geo geo_rowmajor(const void* A, int lda, const void* B, int ldb, int K) {
    Geo g; g.A = (const char*)A; g.B = (const char*)B; g.lda2 = lda * 2; g.ldb2 = ldb * 2; g.kA = 128; g.kB = 128;
    g.hA = (size_t)128 * lda * 2; g.hB = (size_t)128 * ldb * 2; g.tA = 2 * g.hA; g.tB = 2 * g.hB; g.aA = 0; g.aB = 0; g.nt = K / 64; g.amode = 0; g.bmode = 0; return g;
}

struct StaticOrder {
    int nM, nN, nwg, G, c;
    __device__ void init(int M, int N, int G_, int c_) { nM = M / BM; nN = N / BM; nwg = nM * nN; G = G_; c = c_; }
    __device__ bool next(int i, Unit& u) const {
        const long L = (long)i * G + c; if (L >= nwg) return false;
        int wgid = (int)L; { const int q = nwg / NXCD, r = nwg % NXCD, xcd = wgid % NXCD, off = wgid / NXCD; wgid = (xcd < r ? xcd * (q + 1) : r * (q + 1) + (xcd - r) * q) + off; }
        const int nig = WGM * nN, gid = wgid / nig, fm = gid * WGM, gsz = (nM - fm) < WGM ? (nM - fm) : WGM;
        u.pm = fm + ((wgid % nig) % gsz); u.pn = (wgid % nig) / gsz; u.aux = 0; return true;
    }
    __device__ __forceinline__ void a_ready(const Unit&) const {}
    __device__ __forceinline__ void done(const Unit&) const {}
};
struct WinOrder : StaticOrder {
    __device__ void init_win(int G_, int c_) { init(SEQ, INC, G_, c_); }
    __device__ int total() const { return nwg + 8; }
    __device__ bool next(int i, Unit& u) const {
        const long L = (long)i * G + c;
        if (L < nwg) { StaticOrder::next(i, u); u.pm += 1; return true; }
        if (L < nwg + 8) { u.pm = 0; u.pn = 4 + (int)(L - nwg); u.aux = 0; return true; }
        return false; }
};
struct MoeOrder : StaticOrder {
    __device__ bool next(int i, Unit& u) const { if (!StaticOrder::next(i, u)) return false; u.aux = u.pm >> 2; return true; }
};
struct StepAOrder {
    int G, c;
    __device__ bool next(int i, Unit& u) const { const int L = i * G + c; if (L >= 256) return false; u.aux = L >> 6; const int r = L & 63; u.pm = r & 1; u.pn = r >> 1; return true; }
    __device__ __forceinline__ void a_ready(const Unit&) const {}
    __device__ __forceinline__ void done(const Unit&) const {}
};

template <class Epi, class Sched, bool ALIGN_EPI, bool SP2, bool GATHER = false>
__device__ __forceinline__ void gemm_phase(LAS unsigned char* lds, const Geo g, const Sched& S, const Epi& E, const int* gidx = nullptr) {
    const int tid = threadIdx.x, wid = __builtin_amdgcn_readfirstlane(tid >> 6), lane = tid & 63, wr = wid >> 2, wc = wid & 3, fr = lane & 15, fq = lane >> 4;
    const int nt = g.nt;
    unsigned voffA[2], voffB[2], voffA1[2], nvA0[2], nvA1[2]; int gR[2]; unsigned gC[2];
#pragma unroll
    for (int i = 0; i < 2; ++i) { int R, C; stage_rc(tid * 16 + i * 8192, R, C); const int Rb = Epi::PERM ? ((R & ~31) + perm32(R & 31)) : R; gR[i] = R; gC[i] = (unsigned)C * 2u;
        voffA[i] = g.amode ? (unsigned)(C >> 3) * 131072u + (unsigned)R * 16u : (unsigned)R * g.lda2 + (unsigned)C * 2u;
        voffB[i] = (unsigned)(g.bmode ? ((Rb & 63) * 128 + (Rb >> 6)) : Rb) * g.ldb2 + (unsigned)C * 2u; }
    const size_t kA = g.kA, kB = g.kB, hA = g.hA, hB = g.hB;
    const unsigned ldsw = (unsigned)wid * 1024u;
    const int aoff = lds_byte(wr * 64 + fr, fq * 8), boff = lds_byte(wc * 32 + fr, fq * 8);
#define PG8_GIDX(dst0, dst1, u) do { _Pragma("unroll") for (int _i = 0; _i < 2; ++_i) { \
        dst0[_i] = (unsigned)gidx[(u).pm * BM + gR[_i]] * g.lda2 + gC[_i]; dst1[_i] = (unsigned)gidx[(u).pm * BM + HALF + gR[_i]] * g.lda2 + gC[_i]; } } while (0)
#define PG8_SA(b, h) (((b) * 2 + (h)) * HTB)
#define PG8_SB(b, h) ((4 + (b) * 2 + (h)) * HTB)
#define PG8_STAGE(bufoff, gbase, voff) do { _Pragma("unroll") for (int _i = 0; _i < 2; ++_i) \
        __builtin_amdgcn_global_load_lds((const unsigned*)((const char*)(gbase) + (voff)[_i]), (LAS unsigned*)(lds + (bufoff) + ldsw + _i * 8192), 16, 0, 0); } while (0)
#define PG8_LDA(dst, b, h) do { _Pragma("unroll") for (int m = 0; m < 4; ++m) _Pragma("unroll") for (int k = 0; k < 2; ++k) dst[m][k] = *(const LAS bf16x8*)(lds + PG8_SA(b, h) + aoff + m * 2048 + k * 1024); } while (0)
#define PG8_LDB(dst, b, h) do { _Pragma("unroll") for (int n = 0; n < 2; ++n) _Pragma("unroll") for (int k = 0; k < 2; ++k) dst[n][k] = *(const LAS bf16x8*)(lds + PG8_SB(b, h) + boff + n * 2048 + k * 1024); } while (0)
#define PG8_MMA(ai, bj, At, Bt) do { __builtin_amdgcn_s_setprio(1); _Pragma("unroll") for (int m = 0; m < 4; ++m) _Pragma("unroll") for (int n = 0; n < 2; ++n) _Pragma("unroll") for (int k = 0; k < 2; ++k) \
        acc[ai][bj][m][n] = __builtin_amdgcn_mfma_f32_16x16x32_bf16(Bt[n][k], At[m][k], acc[ai][bj][m][n], 0, 0, 0); __builtin_amdgcn_s_setprio(0); } while (0)
#define PG8_WAIT_V(n) asm volatile("s_waitcnt vmcnt(" #n ")" ::: "memory")
#define PG8_WAIT_L(n) asm volatile("s_waitcnt lgkmcnt(" #n ")" ::: "memory")
#define PG8_BAR __builtin_amdgcn_s_barrier()
#define PG8_SCHED __builtin_amdgcn_sched_barrier(0)
    Unit cur, nxt; int ui = 0;
    if (!S.next(0, cur)) return;
    f32x4 acc[2][2][4][2];
#pragma unroll
    for (int a = 0; a < 2; ++a)
#pragma unroll
        for (int b = 0; b < 2; ++b)
#pragma unroll
            for (int m = 0; m < 4; ++m)
#pragma unroll
                for (int n = 0; n < 2; ++n) acc[a][b][m][n] = (f32x4){0.f, 0.f, 0.f, 0.f};
    bf16x8 At[4][2], B0[2][2], B1[2][2];
    const char* cA = g.A + g.offA(cur); const char* cB = g.B + g.offB(cur);
    S.a_ready(cur);
    if constexpr (GATHER) { PG8_GIDX(voffA, voffA1, cur); } else { voffA1[0] = voffA[0]; voffA1[1] = voffA[1]; }
    if constexpr (SP2) {
        PG8_STAGE(PG8_SB(0, 0), cB, voffB); PG8_STAGE(PG8_SB(0, 1), cB + hB, voffB); PG8_STAGE(PG8_SA(0, 0), cA, voffA); PG8_STAGE(PG8_SA(0, 1), cA + hA, voffA1);
        if (wr == 1) PG8_BAR;
        PG8_WAIT_V(2); PG8_BAR;
        PG8_STAGE(PG8_SB(1, 0), cB + kB, voffB); PG8_STAGE(PG8_SA(1, 0), cA + kA, voffA); PG8_STAGE(PG8_SB(1, 1), cB + hB + kB, voffB);
        PG8_WAIT_V(6); PG8_BAR;
    } else {
        PG8_STAGE(PG8_SB(0, 0), cB, voffB); PG8_STAGE(PG8_SA(0, 0), cA, voffA); PG8_STAGE(PG8_SB(0, 1), cB + hB, voffB); PG8_STAGE(PG8_SA(0, 1), cA + hA, voffA1);
        if (wr == 1) PG8_BAR;
        PG8_WAIT_V(4); PG8_BAR;
        PG8_STAGE(PG8_SB(1, 0), cB + kB, voffB); PG8_STAGE(PG8_SA(1, 0), cA + kA, voffA); PG8_STAGE(PG8_SB(1, 1), cB + hB + kB, voffB);
        PG8_WAIT_V(6); PG8_BAR;
    }
    for (;;) {
        const bool has_next = S.next(ui + 1, nxt);
        const char* nA = has_next ? g.A + g.offA(nxt) : cA; const char* nB = has_next ? g.B + g.offB(nxt) : cB;
        if constexpr (GATHER) { if (has_next) { PG8_GIDX(nvA0, nvA1, nxt); } else { nvA0[0] = voffA[0]; nvA0[1] = voffA[1]; nvA1[0] = voffA1[0]; nvA1[1] = voffA1[1]; } }
        for (int t = 0; t < nt; t += 2) {
            const bool last = (t == nt - 2);
            unsigned sA0[2], sA1[2];
            if constexpr (GATHER) { sA0[0] = last ? nvA0[0] : voffA[0]; sA0[1] = last ? nvA0[1] : voffA[1]; sA1[0] = last ? nvA1[0] : voffA1[0]; sA1[1] = last ? nvA1[1] : voffA1[1]; }
            else { sA0[0] = voffA[0]; sA0[1] = voffA[1]; sA1[0] = voffA[0]; sA1[1] = voffA[1]; }
            const char* a1 = cA + (size_t)(t + 1) * kA;
            const char* a2 = last ? nA : cA + (size_t)(t + 2) * kA; const char* b2 = last ? nB : cB + (size_t)(t + 2) * kB;
            const char* a3 = a2 + kA; const char* b3 = b2 + kB;
            if (last && has_next) S.a_ready(nxt);
            if constexpr (SP2) {
            PG8_LDB(B0, 0, 0); PG8_LDB(B1, 0, 1); PG8_SCHED; PG8_LDA(At, 0, 0); PG8_STAGE(PG8_SA(1, 1), a1 + hA, voffA1);
            PG8_WAIT_V(8); PG8_WAIT_L(0); PG8_BAR; PG8_MMA(0, 0, At, B0); PG8_MMA(0, 1, At, B1); PG8_BAR; PG8_SCHED;
            PG8_LDA(At, 0, 1); PG8_STAGE(PG8_SB(0, 0), b2, voffB); PG8_STAGE(PG8_SB(0, 1), b2 + hB, voffB); PG8_STAGE(PG8_SA(0, 0), a2, sA0);
            PG8_WAIT_V(8); PG8_WAIT_L(0); PG8_BAR; PG8_MMA(1, 0, At, B0); PG8_MMA(1, 1, At, B1); PG8_BAR; PG8_SCHED;
            PG8_LDB(B0, 1, 0); PG8_LDB(B1, 1, 1); PG8_SCHED; PG8_LDA(At, 1, 0); PG8_STAGE(PG8_SA(0, 1), a2 + hA, sA1);
            PG8_WAIT_V(8); PG8_WAIT_L(0); PG8_BAR; PG8_MMA(0, 0, At, B0); PG8_MMA(0, 1, At, B1); PG8_BAR; PG8_SCHED;
            PG8_LDA(At, 1, 1); PG8_STAGE(PG8_SB(1, 0), b3, voffB); PG8_STAGE(PG8_SB(1, 1), b3 + hB, voffB); PG8_STAGE(PG8_SA(1, 0), a3, sA0);
            PG8_WAIT_V(8); PG8_WAIT_L(0); PG8_BAR; PG8_MMA(1, 0, At, B0); PG8_MMA(1, 1, At, B1); PG8_BAR; PG8_SCHED;
            } else {
            PG8_LDB(B0, 0, 0); PG8_SCHED; PG8_LDA(At, 0, 0); PG8_STAGE(PG8_SA(1, 1), a1 + hA, voffA1);
            PG8_WAIT_L(8); PG8_BAR; PG8_WAIT_L(0); PG8_MMA(0, 0, At, B0); PG8_BAR; PG8_SCHED;
            PG8_LDB(B1, 0, 1); PG8_STAGE(PG8_SB(0, 0), b2, voffB);
            PG8_BAR; PG8_WAIT_L(0); PG8_MMA(0, 1, At, B1); PG8_BAR;
            PG8_LDA(At, 0, 1); PG8_STAGE(PG8_SA(0, 0), a2, sA0);
            PG8_BAR; PG8_WAIT_L(0); PG8_MMA(1, 0, At, B0); PG8_BAR; PG8_SCHED;
            PG8_STAGE(PG8_SB(0, 1), b2 + hB, voffB);
            PG8_WAIT_V(6); PG8_BAR; PG8_MMA(1, 1, At, B1); PG8_BAR;
            PG8_LDB(B0, 1, 0); PG8_SCHED; PG8_LDA(At, 1, 0); PG8_STAGE(PG8_SA(0, 1), a2 + hA, sA1);
            PG8_WAIT_L(8); PG8_BAR; PG8_WAIT_L(0); PG8_MMA(0, 0, At, B0); PG8_BAR; PG8_SCHED;
            PG8_LDB(B1, 1, 1); PG8_STAGE(PG8_SB(1, 0), b3, voffB);
            PG8_BAR; PG8_WAIT_L(0); PG8_MMA(0, 1, At, B1); PG8_BAR;
            PG8_LDA(At, 1, 1); PG8_STAGE(PG8_SA(1, 0), a3, sA0);
            PG8_BAR; PG8_WAIT_L(0); PG8_MMA(1, 0, At, B0); PG8_BAR; PG8_SCHED;
            PG8_STAGE(PG8_SB(1, 1), b3 + hB, voffB);
            PG8_WAIT_V(6); PG8_BAR; PG8_MMA(1, 1, At, B1); PG8_BAR;
            }
        }
        if constexpr (ALIGN_EPI) { if (wr == 0) PG8_BAR; }
        E(acc, cur, wr, wc, fr, fq); S.done(cur);
        if (!has_next) break;
#pragma unroll
        for (int a = 0; a < 2; ++a)
#pragma unroll
            for (int b = 0; b < 2; ++b)
#pragma unroll
                for (int m = 0; m < 4; ++m)
#pragma unroll
                    for (int n = 0; n < 2; ++n) acc[a][b][m][n] = (f32x4){0.f, 0.f, 0.f, 0.f};
        cur = nxt; cA = nA; cB = nB; ++ui;
        if constexpr (GATHER) { voffA[0] = nvA0[0]; voffA[1] = nvA0[1]; voffA1[0] = nvA1[0]; voffA1[1] = nvA1[1]; }
        if constexpr (ALIGN_EPI) { if (wr == 1) PG8_BAR; }
    }
    PG8_WAIT_V(0);
    if constexpr (!ALIGN_EPI) { if (wr == 0) PG8_BAR; }
    PG8_BAR;
#undef PG8_GIDX
#undef PG8_SA
#undef PG8_SB
#undef PG8_STAGE
#undef PG8_LDA
#undef PG8_LDB
#undef PG8_MMA
#undef PG8_WAIT_V
#undef PG8_WAIT_L
#undef PG8_BAR
#undef PG8_SCHED
}

typedef f32x4 AccT[2][2][4][2];

__device__ __forceinline__ float gelu_tanh(float x) {
    const float z = x * (1.5957691216f + 0.0713548163f * x * x);
    return x * __builtin_amdgcn_rcpf(1.0f + __builtin_amdgcn_exp2f(-1.4426950409f * z));
}
__device__ __forceinline__ u32x2 pack4(f32x4 v) { u32x2 w; w.x = cvt_pk_bf16(v[0], v[1]); w.y = cvt_pk_bf16(v[2], v[3]); return w; }

constexpr float QSCALE = 0.125f * 1.4426950408889634f;
struct EpiWin {
    static constexpr bool PERM = false;
    bf16_t *Q, *K, *V, *UV; const float* ropec; const float* ropes;
    __device__ __forceinline__ void operator()(const AccT& acc, const Unit& u, int wr, int wc, int fr, int fq) const {
        const int sec = u.pn >> 2, row0 = u.pm * BM + wr * 64 + fr;
        if (sec < 2) {
            bf16_t* O = sec == 0 ? Q : K;
            const int colb = (u.pn & 3) * 256 + wc * 32 + 4 * fq; const bool rope = u.pm >= 1;
#pragma unroll
            for (int ai = 0; ai < 2; ++ai)
#pragma unroll
                for (int m = 0; m < 4; ++m) { const int r = row0 + ai * HALF + m * 16; f32x4 cs = (f32x4){1.f, 1.f, 1.f, 1.f}, sn = (f32x4){0.f, 0.f, 0.f, 0.f};
                    if (rope) { const int t = r - CTXL, pos = (wc & 1) ? (t & 63) : (t >> 6); cs = *(const f32x4*)(ropec + pos * 16 + 4 * fq); sn = *(const f32x4*)(ropes + pos * 16 + 4 * fq); }
                    bf16_t* rowp = O + (size_t)r * 1024 + colb;
#pragma unroll
                    for (int bj = 0; bj < 2; ++bj) { const f32x4 x1 = acc[ai][bj][m][0], x2 = acc[ai][bj][m][1];
                        f32x4 o1 = x1 * cs - x2 * sn, o2 = x2 * cs + x1 * sn;
                        if (sec == 0) { o1 = o1 * QSCALE; o2 = o2 * QSCALE; }
                        *(u32x2*)(rowp + bj * HALF) = pack4(o1); *(u32x2*)(rowp + bj * HALF + 16) = pack4(o2); } }
        } else if (sec == 2) {
            const int colb = (u.pn & 3) * 256 + wc * 32 + 4 * fq;
#pragma unroll
            for (int ai = 0; ai < 2; ++ai)
#pragma unroll
                for (int m = 0; m < 4; ++m) { bf16_t* rowp = V + (size_t)(row0 + ai * HALF + m * 16) * 1024 + colb;
#pragma unroll
                    for (int bj = 0; bj < 2; ++bj)
#pragma unroll
                        for (int n = 0; n < 2; ++n) *(u32x2*)(rowp + bj * HALF + n * 16) = pack4(acc[ai][bj][m][n]); }
        } else {
            const int colb = (u.pn - 12) * 256 + wc * 32 + 4 * fq;
#pragma unroll
            for (int ai = 0; ai < 2; ++ai)
#pragma unroll
                for (int m = 0; m < 4; ++m) { bf16_t* rowp = UV + (size_t)(row0 + ai * HALF + m * 16) * 2048 + colb;
#pragma unroll
                    for (int bj = 0; bj < 2; ++bj)
#pragma unroll
                        for (int n = 0; n < 2; ++n) { f32x4 v = acc[ai][bj][m][n];
#pragma unroll
                            for (int j = 0; j < 4; ++j) v[j] = gelu_tanh(v[j]);
                            *(u32x2*)(rowp + bj * HALF + n * 16) = pack4(v); } }
        }
    }
};
template <bool XIN_F32> struct EpiResidN {
    static constexpr bool PERM = false;
    const void* Xin; _Float16* Xout; const float* gate;
    __device__ __forceinline__ void operator()(const AccT& acc, const Unit& u, int wr, int wc, int fr, int fq) const {
        const int row0 = u.pm * BM + wr * 64 + fr, col0 = u.pn * BM + wc * 32 + 4 * fq;
        f32x4 gv[2][2];
#pragma unroll
        for (int bj = 0; bj < 2; ++bj)
#pragma unroll
            for (int n = 0; n < 2; ++n) gv[bj][n] = *(const f32x4*)(gate + col0 + bj * HALF + n * 16);
#pragma unroll
        for (int ai = 0; ai < 2; ++ai)
#pragma unroll
            for (int m = 0; m < 4; ++m) { const size_t ro = (size_t)(row0 + ai * HALF + m * 16) * DM + col0;
#pragma unroll
                for (int bj = 0; bj < 2; ++bj)
#pragma unroll
                    for (int n = 0; n < 2; ++n) { const size_t o = ro + bj * HALF + n * 16;
                        const f32x4 xi = XIN_F32 ? *(const f32x4*)((const float*)Xin + o) : ldx4((const _Float16*)Xin + o);
                        stx4(Xout + o, xi + gv[bj][n] * acc[ai][bj][m][n]); } }
    }
};
template <bool XIN_F32> struct EpiResid {
    static constexpr bool PERM = true;
    const void* Xin; _Float16* Xout; const float* gate;
    __device__ __forceinline__ void operator()(const AccT& acc, const Unit& u, int wr, int wc, int fr, int fq) const {
        const int row0 = u.pm * BM + wr * 64 + fr, col0 = u.pn * BM + wc * 32 + 8 * fq;
        f32x4 gv[2][2];
#pragma unroll
        for (int bj = 0; bj < 2; ++bj)
#pragma unroll
            for (int n = 0; n < 2; ++n) gv[bj][n] = *(const f32x4*)(gate + col0 + bj * HALF + n * 4);
#pragma unroll
        for (int ai = 0; ai < 2; ++ai)
#pragma unroll
            for (int m = 0; m < 4; ++m) { const size_t ro = (size_t)(row0 + ai * HALF + m * 16) * DM + col0;
#pragma unroll
                for (int bj = 0; bj < 2; ++bj) { const size_t o = ro + bj * HALF; f32x4 x0, x1;
                    if (XIN_F32) { x0 = *(const f32x4*)((const float*)Xin + o); x1 = *(const f32x4*)((const float*)Xin + o + 4); }
                    else { const f16x8 h = *(const f16x8*)((const _Float16*)Xin + o);
                        x0 = __builtin_convertvector(__builtin_shufflevector(h, h, 0, 1, 2, 3), f32x4); x1 = __builtin_convertvector(__builtin_shufflevector(h, h, 4, 5, 6, 7), f32x4); }
                    const f16x4 r0 = __builtin_convertvector(x0 + gv[bj][0] * acc[ai][bj][m][0], f16x4), r1 = __builtin_convertvector(x1 + gv[bj][1] * acc[ai][bj][m][1], f16x4);
                    *(f16x8*)(Xout + o) = __builtin_shufflevector(r0, r1, 0, 1, 2, 3, 4, 5, 6, 7); } }
    }
};
struct EpiBf16 {
    static constexpr bool PERM = true;
    bf16_t* O; int ldc; int aux_rows;
    __device__ __forceinline__ void operator()(const AccT& acc, const Unit& u, int wr, int wc, int fr, int fq) const {
        const int row0 = u.aux * aux_rows + u.pm * BM + wr * 64 + fr, col0 = u.pn * BM + wc * 32 + 8 * fq;
#pragma unroll
        for (int ai = 0; ai < 2; ++ai)
#pragma unroll
            for (int m = 0; m < 4; ++m) { bf16_t* rowp = O + (size_t)(row0 + ai * HALF + m * 16) * ldc + col0;
#pragma unroll
                for (int bj = 0; bj < 2; ++bj) { const f32x4 v0 = acc[ai][bj][m][0], v1 = acc[ai][bj][m][1];
                    u32x4 w; w.x = cvt_pk_bf16(v0[0], v0[1]); w.y = cvt_pk_bf16(v0[2], v0[3]); w.z = cvt_pk_bf16(v1[0], v1[1]); w.w = cvt_pk_bf16(v1[2], v1[3]);
                    *(u32x4*)(rowp + bj * HALF) = w; } }
    }
};
struct EpiGateUp {
    static constexpr bool PERM = true;
    bf16_t* ACT;
    __device__ __forceinline__ void operator()(const AccT& acc, const Unit& u, int wr, int wc, int fr, int fq) const {
        const int row0 = u.pm * BM + wr * 64 + fr, col0 = u.pn * 128 + wc * 32 + 8 * fq;
#pragma unroll
        for (int ai = 0; ai < 2; ++ai)
#pragma unroll
            for (int m = 0; m < 4; ++m) { bf16_t* rowp = ACT + (size_t)(row0 + ai * HALF + m * 16) * FE + col0;
                f32x4 o[2];
#pragma unroll
                for (int n = 0; n < 2; ++n) { const f32x4 gt = acc[ai][0][m][n], up = acc[ai][1][m][n];
#pragma unroll
                    for (int j = 0; j < 4; ++j) o[n][j] = gt[j] * up[j] * __builtin_amdgcn_rcpf(1.0f + __builtin_amdgcn_exp2f(-1.4426950409f * gt[j])); }
                u32x4 w; w.x = cvt_pk_bf16(o[0][0], o[0][1]); w.y = cvt_pk_bf16(o[0][2], o[0][3]); w.z = cvt_pk_bf16(o[1][0], o[1][1]); w.w = cvt_pk_bf16(o[1][2], o[1][3]);
                *(u32x4*)rowp = w; }
    }
};
struct EpiDown {
    static constexpr bool PERM = true;
    bf16_t* Y; const float* gate;
    __device__ __forceinline__ void operator()(const AccT& acc, const Unit& u, int wr, int wc, int fr, int fq) const {
        const int row0 = u.pm * BM + wr * 64 + fr, col0 = u.pn * BM + wc * 32 + 8 * fq;
#pragma unroll
        for (int ai = 0; ai < 2; ++ai)
#pragma unroll
            for (int m = 0; m < 4; ++m) { const int r = row0 + ai * HALF + m * 16; const float gr = gate[r]; bf16_t* rowp = Y + (size_t)r * DM + col0;
#pragma unroll
                for (int bj = 0; bj < 2; ++bj) { const f32x4 v0 = acc[ai][bj][m][0] * gr, v1 = acc[ai][bj][m][1] * gr;
                    u32x4 w; w.x = cvt_pk_bf16(v0[0], v0[1]); w.y = cvt_pk_bf16(v0[2], v0[3]); w.z = cvt_pk_bf16(v1[0], v1[1]); w.w = cvt_pk_bf16(v1[2], v1[3]);
                    *(u32x4*)(rowp + bj * HALF) = w; } }
    }
};
}

namespace att {
__device__ __forceinline__ int crow(int r, int hi) { return (r & 3) + 8 * (r >> 2) + 4 * hi; }
__device__ __forceinline__ void sgu_unit(const bf16_t* __restrict__ UV, bf16_t* __restrict__ CAT, const float* __restrict__ w_sp, const float* __restrict__ b_sp,
                                         const float* __restrict__ ln_g, const float* __restrict__ ln_b, int chunk, int g, char* lds) {
  const int tid = threadIdx.x, wid = tid >> 6, lane = tid & 63, r32 = lane & 31, hi = lane >> 5;
  bf16_t* vT = (bf16_t*)lds;
  const int wp = wid >> 1, wd = wid & 1;
  unsigned pkv[16]; f32x4 wsv[16]; u32x4 uwv[4];
#pragma unroll
  for (int i = 0; i < 16; ++i) pkv[i] = *(const unsigned*)(UV + (size_t)(CTXL + chunk * 128 + wid * 16 + i) * DM + 1024 + g * 128 + 2 * lane);
  { const float* Wg = w_sp + (size_t)g * 128 * 128 + (size_t)(wp * 32 + r32) * 128 + hi * 8;
#pragma unroll
    for (int ks = 0; ks < 8; ++ks) { wsv[2 * ks] = *(const f32x4*)(Wg + ks * 16); wsv[2 * ks + 1] = *(const f32x4*)(Wg + ks * 16 + 4); } }
#pragma unroll
  for (int i = 0; i < 4; ++i) { const int ch = tid + 512 * i, p = ch >> 4, d0 = (ch & 15) * 8; uwv[i] = *(const u32x4*)(UV + (size_t)(CTXL + chunk * 128 + p) * DM + g * 128 + d0); }
  { const float lg0 = ln_g[g * 128 + 2 * lane], lg1 = ln_g[g * 128 + 2 * lane + 1], lb0 = ln_b[g * 128 + 2 * lane], lb1 = ln_b[g * 128 + 2 * lane + 1];
#pragma unroll
    for (int i = 0; i < 16; ++i) { const int pos = wid * 16 + i;
      const unsigned pk = pkv[i];
      const float a = bflo(pk), b = bfhi(pk);
      const float mean = wave_sum(a + b) * (1.0f / 128.0f); const float da = a - mean, db = b - mean;
      const float var = wave_sum(da * da + db * db) * (1.0f / 128.0f); const float rstd = 1.0f / sqrtf(var + EPS);
      vT[(2 * lane) * 136 + pos] = (bf16_t)f2bf(da * rstd * lg0 + lb0); vT[(2 * lane + 1) * 136 + pos] = (bf16_t)f2bf(db * rstd * lg1 + lb1); } }
  __syncthreads();
  f32x16 acc[2]; acc[0] = f32x16{}; acc[1] = f32x16{};
#pragma unroll
  for (int ks = 0; ks < 8; ++ks) { const f32x4 w0 = wsv[2 * ks], w1 = wsv[2 * ks + 1];
    u32x4 aw; aw.x = pk2(w0[0], w0[1]); aw.y = pk2(w0[2], w0[3]); aw.z = pk2(w1[0], w1[1]); aw.w = pk2(w1[2], w1[3]);
    const bf16x8 af = __builtin_bit_cast(bf16x8, aw);
#pragma unroll
    for (int nb = 0; nb < 2; ++nb) { const bf16x8 bf = *(const bf16x8*)(vT + (wd * 64 + nb * 32 + r32) * 136 + ks * 16 + hi * 8);
      acc[nb] = __builtin_amdgcn_mfma_f32_32x32x16_bf16(af, bf, acc[nb], 0, 0, 0); } }
  __syncthreads();
  float* mt = (float*)lds;
#pragma unroll
  for (int nb = 0; nb < 2; ++nb) { const int d = wd * 64 + nb * 32 + r32;
#pragma unroll
    for (int r = 0; r < 16; ++r) { const int p = wp * 32 + crow(r, hi); mt[p * 132 + d] = acc[nb][r] + b_sp[g * 128 + p]; } }
  __syncthreads();
#pragma unroll
  for (int i = 0; i < 4; ++i) { const int ch = tid + 512 * i, p = ch >> 4, d0 = (ch & 15) * 8, t = chunk * 128 + p;
    const u32x4 uw = uwv[i];
    const f32x4 m0 = *(const f32x4*)(mt + p * 132 + d0), m1 = *(const f32x4*)(mt + p * 132 + d0 + 4);
    u32x4 o; o.x = pk2(bflo(uw.x) * m0.x, bfhi(uw.x) * m0.y); o.y = pk2(bflo(uw.y) * m0.z, bfhi(uw.y) * m0.w);
    o.z = pk2(bflo(uw.z) * m1.x, bfhi(uw.z) * m1.y); o.w = pk2(bflo(uw.w) * m1.z, bfhi(uw.w) * m1.w);
    *(u32x4*)(CAT + (size_t)t * DM + 1024 + g * 128 + d0) = o; }
  __syncthreads();
}
}


namespace att2 {
using bf16x8_t = bf16x8;
constexpr int NW = 8, QBLK = 32, KVBLK = 64, NSLOT = 3, SLOTB = 16384, DMK = 1024, NT = MC / KVBLK;
constexpr int LDS_K = 0, LDS_V = NSLOT * SLOTB, LDS_WS = 2 * NSLOT * SLOTB, LDS_Q = LDS_WS + NW * 64 * 4, LDS_BYTES_ATT = LDS_Q + NW * 4096;
__device__ __forceinline__ int crow(int r, int hi) { return (r & 3) + 8 * (r >> 2) + 4 * hi; }
#define SBAR() __builtin_amdgcn_sched_barrier(0)
template <int IMM> __device__ __forceinline__ void glds16(const void* sbase, unsigned voff, unsigned lds_dst) { unsigned keep;
  asm volatile("s_mov_b32 %0, m0\n\ts_mov_b32 m0, %3\n\ts_nop 0\n\tglobal_load_lds_dwordx4 %1, %2 offset:%c4\n\ts_mov_b32 m0, %0" : "=&s"(keep) : "v"(voff), "s"(sbase), "s"(lds_dst), "i"(IMM) : "memory"); }
__device__ __forceinline__ float max3f(float a, float b, float c) { float r; asm("v_max3_f32 %0, %1, %2, %3" : "=v"(r) : "v"(a), "v"(b), "v"(c)); return r; }
__device__ __forceinline__ float max2f(float a, float b) { float r; asm("v_max_f32_e32 %0, %1, %2" : "=v"(r) : "v"(a), "v"(b)); return r; }
__device__ __forceinline__ float fadd_s(float a, float b) { float r; asm("v_add_f32_e32 %0, %1, %2" : "=v"(r) : "v"(a), "v"(b)); return r; }
__device__ __forceinline__ float fsub_s(float a, float b) { float r; asm("v_sub_f32_e32 %0, %1, %2" : "=v"(r) : "v"(a), "v"(b)); return r; }
typedef __bf16 bf16x2_t __attribute__((ext_vector_type(2)));
__device__ __forceinline__ unsigned cvtpk_s(float lo, float hi) { f32x2 v = {lo, hi}; bf16x2_t b = __builtin_convertvector(v, bf16x2_t); return __builtin_bit_cast(unsigned, b); }
#define WAIT_BAR(N) asm volatile("s_waitcnt vmcnt(" #N ") lgkmcnt(0)\n\ts_barrier" ::: "memory")
typedef LAS const char* lds_cptr;
typedef short v4i16_t __attribute__((ext_vector_type(4)));
__device__ __forceinline__ void kload8(bf16x8* kf, lds_cptr kp) {
  kf[0] = *(const LAS bf16x8*)(kp);        kf[1] = *(const LAS bf16x8*)(kp + 512);
  kf[2] = *(const LAS bf16x8*)(kp + 2048); kf[3] = *(const LAS bf16x8*)(kp + 2560);
  kf[4] = *(const LAS bf16x8*)(kp + 4096); kf[5] = *(const LAS bf16x8*)(kp + 4608);
  kf[6] = *(const LAS bf16x8*)(kp + 6144); kf[7] = *(const LAS bf16x8*)(kp + 6656);
}
__device__ __forceinline__ void kload2(bf16x8* kf, lds_cptr kp, int j) { kf[2 * j] = *(const LAS bf16x8*)(kp + j * 2048); kf[2 * j + 1] = *(const LAS bf16x8*)(kp + j * 2048 + 512); }
__device__ __forceinline__ s16x4 vtr(lds_cptr p) { return __builtin_bit_cast(s16x4, __builtin_amdgcn_ds_read_tr16_b64_v4i16((LAS v4i16_t*)p)); }
__device__ __forceinline__ float rowmax(const f32x16& p0, const f32x16& p1) {
  float a = max3f(p0[0], p0[1], p1[0]), b = max3f(p0[2], p0[3], p1[1]); a = max3f(a, p1[2], p1[3]);
#pragma unroll
  for (int r = 4; r < 16; r += 4) { a = max3f(a, p0[r], p0[r + 1]); b = max3f(b, p0[r + 2], p0[r + 3]); a = max3f(a, p1[r], p1[r + 1]); b = max3f(b, p1[r + 2], p1[r + 3]); }
  const float m = max2f(a, b);
  auto rr = __builtin_amdgcn_permlane32_swap(__float_as_uint(m), __float_as_uint(m), false, false);
  return max2f(__uint_as_float(rr[0]), __uint_as_float(rr[1]));
}
__device__ __forceinline__ void qkt(f32x16& p0, f32x16& p1, lds_cptr kb, const bf16x8* qr, const f32x16& negm) {
#pragma unroll
  for (int d0 = 0; d0 < 4; ++d0) {
    const bf16x8 b0 = *(const LAS bf16x8*)(kb + d0 * 2048);
    const bf16x8 b1 = *(const LAS bf16x8*)(kb + d0 * 2048 + 512);
    if (d0 == 0) { p0 = __builtin_amdgcn_mfma_f32_32x32x16_bf16(b0, qr[0], negm, 0, 0, 0); p1 = __builtin_amdgcn_mfma_f32_32x32x16_bf16(b1, qr[0], negm, 0, 0, 0); }
    else { p0 = __builtin_amdgcn_mfma_f32_32x32x16_bf16(b0, qr[d0], p0, 0, 0, 0); p1 = __builtin_amdgcn_mfma_f32_32x32x16_bf16(b1, qr[d0], p1, 0, 0, 0); } }
}
__device__ __forceinline__ void pv_last(f32x16* o, int vb, bf16x8 pa0, bf16x8 pa1, bf16x8 pa2, bf16x8 pa3) {
#pragma unroll
  for (int d0 = 0; d0 < 4; ++d0) { s16x4 lo[4], hi[4];
#pragma unroll
    for (int ks = 0; ks < 4; ++ks) {
      asm volatile("ds_read_b64_tr_b16 %0,%1 offset:%c2" : "=&v"(lo[ks]) : "v"(vb), "i"(d0 * 4096 + ks * 1024) : "memory");
      asm volatile("ds_read_b64_tr_b16 %0,%1 offset:%c2" : "=&v"(hi[ks]) : "v"(vb), "i"(d0 * 4096 + ks * 1024 + 512) : "memory"); }
    asm volatile("s_waitcnt lgkmcnt(0)" ::: "memory"); SBAR();
#define PK(k) (bf16x8){lo[k][0], lo[k][1], lo[k][2], lo[k][3], hi[k][0], hi[k][1], hi[k][2], hi[k][3]}
    o[d0] = __builtin_amdgcn_mfma_f32_32x32x16_bf16(pa0, PK(0), o[d0], 0, 0, 0);
    o[d0] = __builtin_amdgcn_mfma_f32_32x32x16_bf16(pa1, PK(1), o[d0], 0, 0, 0);
    o[d0] = __builtin_amdgcn_mfma_f32_32x32x16_bf16(pa2, PK(2), o[d0], 0, 0, 0);
    o[d0] = __builtin_amdgcn_mfma_f32_32x32x16_bf16(pa3, PK(3), o[d0], 0, 0, 0);
#undef PK
  }
}

template <int THRL>
__device__ __forceinline__ void attn_unit(const bf16_t* Q, const bf16_t* __restrict__ K, const bf16_t* __restrict__ V, bf16_t* __restrict__ CAT,
                                          int head, int qb, float lam, float out_scale, const float* __restrict__ g_subln, LAS unsigned char* shm) {
  const int tid = threadIdx.x, lane = tid & 63, r32 = lane & 31, hi = lane >> 5; const int wid = __builtin_amdgcn_readfirstlane(tid >> 6);
  const int comp = wid >> 2, wq = wid & 3;
  if (wid >= 4) __builtin_amdgcn_s_setprio(1);
  const bf16_t* Qw = Q + (size_t)(CTXL + qb * 128 + wq * QBLK) * DMK + head * 128 + comp * 64;
  const bf16_t* Kh = K + head * 128; const bf16_t* Vh = V + head * 128;
  const unsigned lds0 = (unsigned)(uintptr_t)shm;
  LAS float* wsf = (LAS float*)(shm + LDS_WS) + wid * 64;
  const unsigned kvoff = (unsigned)(lane * DMK + wid * 8) * 2u;
  const unsigned vvoff = (unsigned)((16 * (wid & 3) + (lane >> 2)) * DMK + (wid >> 2) * 32 + (lane & 3) * 8) * 2u;
  const unsigned kdst = lds0 + LDS_K + wid * 1024, vdst = lds0 + LDS_V + wid * 1024;
#define DMA_K(t, slot) do { const bf16_t* sb_ = Kh + (long)(t) * KVBLK * DMK; glds16<0>(sb_, kvoff, (unsigned)__builtin_amdgcn_readfirstlane(kdst + (slot))); glds16<0>(sb_ + 64, kvoff, (unsigned)__builtin_amdgcn_readfirstlane(kdst + 8192 + (slot))); } while (0)
#define DMAK1(t, slot) do { glds16<0>(Kh + (long)(t) * KVBLK * DMK, kvoff, (unsigned)__builtin_amdgcn_readfirstlane(kdst + (slot))); SBAR(); } while (0)
#define DMAK2(t, slot) do { glds16<0>(Kh + (long)(t) * KVBLK * DMK + 64, kvoff, (unsigned)__builtin_amdgcn_readfirstlane(kdst + 8192 + (slot))); SBAR(); } while (0)
#define DMAV1(t, slot) do { glds16<0>(Vh + (long)(t) * KVBLK * DMK, vvoff, (unsigned)__builtin_amdgcn_readfirstlane(vdst + (slot))); SBAR(); } while (0)
#define DMAV2(t, slot) do { glds16<0>(Vh + (long)(t) * KVBLK * DMK + 64, vvoff, (unsigned)__builtin_amdgcn_readfirstlane(vdst + 8192 + (slot))); SBAR(); } while (0)
#define DMA_V(t, slot) do { const bf16_t* sb_ = Vh + (long)(t) * KVBLK * DMK; glds16<0>(sb_, vvoff, (unsigned)__builtin_amdgcn_readfirstlane(vdst + (slot))); glds16<0>(sb_ + 64, vvoff, (unsigned)__builtin_amdgcn_readfirstlane(vdst + 8192 + (slot))); } while (0)
  const int vb0 = (int)(lds0 + LDS_V) + ((lane >> 4) & 1) * 32 + (lane & 3) * 8 + (4 * hi + ((lane & 15) >> 2)) * 64;
  bf16x8 kf[8];
  const lds_cptr shm3 = (lds_cptr)shm; const lds_cptr kp0 = shm3 + LDS_K + comp * 8192 + hi * 1024 + r32 * 16;
  const lds_cptr vp0 = shm3 + LDS_V + ((lane >> 4) & 1) * 32 + (lane & 3) * 8 + (4 * hi + ((lane & 15) >> 2)) * 64;
  DMA_K(0, 0); DMA_V(0, 0); DMA_K(1, SLOTB);
  bf16x8 qr[4];
#pragma unroll
  for (int d0 = 0; d0 < 4; ++d0) qr[d0] = *reinterpret_cast<const bf16x8*>(&Qw[(long)r32 * DMK + d0 * 16 + hi * 8]);
  float mhat = 0.f, l_reg = 0.f; f32x16 o[4]; o[0] = f32x16{}; o[1] = f32x16{}; o[2] = f32x16{}; o[3] = f32x16{}; f32x16 negm = f32x16{}; asm volatile("" : "+v"(negm));
  bool resc = false;
#define START(P0, P1) do { const float rm = rowmax(P0, P1); resc = false; \
    { const float dl = rm; mhat = fadd_s(mhat, dl); \
      _Pragma("unroll") for (int r = 0; r < 16; ++r) { P0[r] = fsub_s(P0[r], dl); P1[r] = fsub_s(P1[r], dl); } \
      _Pragma("unroll") for (int r = 0; r < 16; ++r) negm[r] = -mhat; asm volatile("" : "+v"(negm)); } \
    _Pragma("unroll") for (int r = 0; r < 16; ++r) P0[r] = __builtin_amdgcn_exp2f(P0[r]); } while (0)
#define RESC() do { if (resc) { asm volatile("s_waitcnt lgkmcnt(0)" ::: "memory"); \
      _Pragma("unroll") for (int d_ = 0; d_ < 4; ++d_) _Pragma("unroll") for (int r = 0; r < 16; ++r) o[d_][r] *= wsf[crow(r, hi)]; } } while (0)
  f32x16 pA0, pA1, pB0, pB1;
  int sl_prev = 0, sl_cur = 0, sl_next = SLOTB;
#define ROT() do { sl_prev = sl_cur; sl_cur = sl_next; sl_next = (sl_next == (NSLOT - 1) * SLOTB) ? 0 : sl_next + SLOTB; } while (0)
  DMA_K(2, 2 * SLOTB);
  WAIT_BAR(6);
  qkt(pA0, pA1, kp0, qr, negm); asm volatile("s_nop 15\n\ts_nop 7" : "+v"(pA0), "+v"(pA1));
  const lds_cptr qp = shm3 + LDS_Q + wid * 4096 + lane * 16;
#pragma unroll
  for (int d0 = 0; d0 < 4; ++d0) *(LAS bf16x8*)(shm + LDS_Q + wid * 4096 + lane * 16 + d0 * 1024) = qr[d0];
  START(pA0, pA1);
#pragma unroll
  for (int r = 0; r < 16; ++r) pA1[r] = __builtin_amdgcn_exp2f(pA1[r]);
  WAIT_BAR(0);
  DMA_K(3, 0); DMA_V(1, SLOTB);
  ROT();
  kload8(kf, kp0 + sl_cur);
  WAIT_BAR(4);
  s16x4 vlo[4], vhi[4]; u32x4 pw0, pw1, pw2, pw3;
#define PKW(P, B) cvtpk_s(P[B], P[B + 1])
#define PAF(k) __builtin_bit_cast(bf16x8, pw##k)
#define VFR(i) (bf16x8){vlo[i][0], vlo[i][1], vlo[i][2], vlo[i][3], vhi[i][0], vhi[i][1], vhi[i][2], vhi[i][3]}
#define PIN(x) asm volatile("" : "+v"(x))
#define MX3(a, b, c) __builtin_fmaxf(__builtin_fmaxf((a), (b)), (c))
#define GAPA(MF, A0, A1, A2, A3, W0, W1, PW) do { MF; sacc += A0; sacc += A1; sacc += A2; sacc += A3; PIN(sacc); W0; W1; PIN(PW); SBAR(); } while (0)
#define EX(v) __builtin_amdgcn_exp2f(v)
#define GAPB(MF, X, B) do { MF; X[B] = EX(X[B]); X[B + 1] = EX(X[B + 1]); PIN(X); } while (0)
#define VRD(s) do { vlo[(s) & 3] = vtr(vp_ + (((s) & 3) * 4096 + ((s) >> 2) * 1024)); vhi[(s) & 3] = vtr(vp_ + (((s) & 3) * 4096 + ((s) >> 2) * 1024 + 512)); } while (0)
#define KRD(G, j) do { if (G) { kload2(kf, kp0 + sl_next, j); SBAR(); } } while (0)
#define PVS(s, PA, X, B) do { GAPB(o[(s) & 3] = __builtin_amdgcn_mfma_f32_32x32x16_bf16(PA, VFR((s) & 3), o[(s) & 3], 0, 0, 0), X, B); if ((s) + 4 < 16) { VRD((s) + 4); } SBAR(); } while (0)
#define STEP(C0, C1, P0, P1, t, GK, GV, GL) do { SBAR(); \
    const lds_cptr vp_ = vp0 + sl_prev; \
    float sacc = (P0[0] + P0[1]); bf16x8 qa = *(const LAS bf16x8*)(qp), qb_; \
    GAPA(C0 = __builtin_amdgcn_mfma_f32_32x32x16_bf16(kf[0], qa, negm, 0, 0, 0), P0[2], P0[3], P0[4], P0[5],     pw0[0] = PKW(P0, 0), pw0[1] = PKW(P0, 2), pw0); \
    GAPA(C1 = __builtin_amdgcn_mfma_f32_32x32x16_bf16(kf[1], qa, negm, 0, 0, 0), P0[6], P0[7], P0[8], P0[9],     pw0[2] = PKW(P0, 4), pw0[3] = PKW(P0, 6), pw0); qb_ = *(const LAS bf16x8*)(qp + 1024); \
    GAPA(C0 = __builtin_amdgcn_mfma_f32_32x32x16_bf16(kf[2], qb_, C0, 0, 0, 0),   P0[10], P0[11], P0[12], P0[13], pw1[0] = PKW(P0, 8), pw1[1] = PKW(P0, 10), pw1); \
    GAPA(C1 = __builtin_amdgcn_mfma_f32_32x32x16_bf16(kf[3], qb_, C1, 0, 0, 0),   P0[14], P0[15], P1[0], P1[1],   pw1[2] = PKW(P0, 12), pw1[3] = PKW(P0, 14), pw1); qa = *(const LAS bf16x8*)(qp + 2048); \
    VRD(0); SBAR(); GAPA(C0 = __builtin_amdgcn_mfma_f32_32x32x16_bf16(kf[4], qa, C0, 0, 0, 0),   P1[2], P1[3], P1[4], P1[5],     pw2[0] = PKW(P1, 0), pw2[1] = PKW(P1, 2), pw2); \
    VRD(1); SBAR(); GAPA(C1 = __builtin_amdgcn_mfma_f32_32x32x16_bf16(kf[5], qa, C1, 0, 0, 0),   P1[6], P1[7], P1[8], P1[9],     pw2[2] = PKW(P1, 4), pw2[3] = PKW(P1, 6), pw2); qb_ = *(const LAS bf16x8*)(qp + 3072); \
    VRD(2); SBAR(); GAPA(C0 = __builtin_amdgcn_mfma_f32_32x32x16_bf16(kf[6], qb_, C0, 0, 0, 0),   P1[10], P1[11], P1[12], P1[13], pw3[0] = PKW(P1, 8), pw3[1] = PKW(P1, 10), pw3); \
    VRD(3); SBAR(); GAPA(C1 = __builtin_amdgcn_mfma_f32_32x32x16_bf16(kf[7], qb_, C1, 0, 0, 0),   P1[14], P1[15], 0.f, 0.f,       pw3[2] = PKW(P1, 12), pw3[3] = PKW(P1, 14), pw3); \
    l_reg += sacc; \
    { float a = MX3(C0[0], C0[1], C1[0]), b = MX3(C0[2], C0[3], C1[1]); a = MX3(a, C1[2], C1[3]); \
      _Pragma("unroll") for (int r = 4; r < 16; r += 4) { a = MX3(a, C0[r], C0[r + 1]); b = MX3(b, C0[r + 2], C0[r + 3]); a = MX3(a, C1[r], C1[r + 1]); b = MX3(b, C1[r + 2], C1[r + 3]); } \
      float rm = __builtin_fmaxf(a, b); { auto rr = __builtin_amdgcn_permlane32_swap(__float_as_uint(rm), __float_as_uint(rm), false, false); rm = __builtin_fmaxf(__uint_as_float(rr[0]), __uint_as_float(rr[1])); } \
      resc = false; \
      if (__builtin_expect(__any(rm > (float)THRL), 0)) { const float dl = __builtin_fmaxf(rm, 0.f); mhat += dl; \
        _Pragma("unroll") for (int r = 0; r < 16; ++r) { C0[r] -= dl; C1[r] -= dl; } \
        _Pragma("unroll") for (int r = 0; r < 16; ++r) negm[r] = -mhat; asm volatile("" : "+v"(negm)); \
        const float f = __builtin_amdgcn_exp2f(-dl); l_reg *= f; if (hi == 0) wsf[r32] = f; resc = true; } } \
    SBAR(); \
    PVS(0, PAF(0), C0, 0);  if (GK) { DMAK1((t) + 3, sl_cur); } PVS(1, PAF(0), C0, 2);  PVS(2, PAF(0), C0, 4);  if (GK) { DMAK2((t) + 3, sl_cur); } PVS(3, PAF(0), C0, 6); \
    KRD(GL, 0); PVS(4, PAF(1), C0, 8);  if (GV) { DMAV1((t) + 1, sl_next); } PVS(5, PAF(1), C0, 10); KRD(GL, 1); PVS(6, PAF(1), C0, 12); if (GV) { DMAV2((t) + 1, sl_next); } PVS(7, PAF(1), C0, 14); \
    KRD(GL, 2); PVS(8, PAF(2), C1, 0);  PVS(9, PAF(2), C1, 2);  KRD(GL, 3); PVS(10, PAF(2), C1, 4); PVS(11, PAF(2), C1, 6); \
    PVS(12, PAF(3), C1, 8); PVS(13, PAF(3), C1, 10); PVS(14, PAF(3), C1, 12); PVS(15, PAF(3), C1, 14); \
    } while (0)
  int t = 1;
  for (; t + 5 < NT; t += 2) {
    STEP(pB0, pB1, pA0, pA1, t, true, true, true);     WAIT_BAR(4); RESC(); ROT();
    STEP(pA0, pA1, pB0, pB1, t + 1, true, true, true); WAIT_BAR(4); RESC(); ROT();
  }
#define ENDW(tt) do { if ((tt) + 3 < NT) { WAIT_BAR(4); } else if ((tt) + 2 < NT) { WAIT_BAR(2); } else { WAIT_BAR(0); } } while (0)
  for (; t + 1 < NT; t += 2) {
    STEP(pB0, pB1, pA0, pA1, t, (t + 3 < NT), (t + 1 < NT), (t + 1 < NT));         ENDW(t);     RESC(); ROT();
    STEP(pA0, pA1, pB0, pB1, t + 1, (t + 4 < NT), (t + 2 < NT), (t + 2 < NT));     ENDW(t + 1); RESC(); ROT();
  }
  STEP(pB0, pB1, pA0, pA1, NT - 1, false, false, false); RESC();
  { float sacc = pB0[0] + pB0[1];
#pragma unroll
    for (int r = 2; r < 16; ++r) sacc += pB0[r];
#pragma unroll
    for (int r = 0; r < 16; ++r) sacc += pB1[r];
    l_reg += sacc;
    pw0 = (u32x4){PKW(pB0, 0), PKW(pB0, 2), PKW(pB0, 4), PKW(pB0, 6)}; pw1 = (u32x4){PKW(pB0, 8), PKW(pB0, 10), PKW(pB0, 12), PKW(pB0, 14)};
    pw2 = (u32x4){PKW(pB1, 0), PKW(pB1, 2), PKW(pB1, 4), PKW(pB1, 6)}; pw3 = (u32x4){PKW(pB1, 8), PKW(pB1, 10), PKW(pB1, 12), PKW(pB1, 14)};
    SBAR(); pv_last(o, vb0 + sl_cur, PAF(0), PAF(1), PAF(2), PAF(3)); }
  { auto rr = __builtin_amdgcn_permlane32_swap(__float_as_uint(l_reg), __float_as_uint(l_reg), false, false); l_reg = __uint_as_float(rr[0]) + __uint_as_float(rr[1]); }
  if (hi == 0) wsf[32 + r32] = l_reg; asm volatile("s_waitcnt lgkmcnt(0)" ::: "memory");
  float rli[16];
#pragma unroll
  for (int r = 0; r < 16; ++r) rli[r] = __builtin_amdgcn_rcpf(wsf[32 + crow(r, hi)]);
  asm volatile("s_waitcnt lgkmcnt(0)\n\ts_barrier" ::: "memory");
  LAS float* buf = (LAS float*)shm;
  if (comp == 1) {
#pragma unroll
    for (int r = 0; r < 16; ++r) { const int orow = wq * QBLK + crow(r, hi);
#pragma unroll
      for (int d0 = 0; d0 < 4; ++d0) buf[orow * 128 + d0 * 32 + r32] = o[d0][r] * rli[r] * lam; }
  }
  asm volatile("s_waitcnt lgkmcnt(0)\n\ts_barrier" ::: "memory");
  if (comp == 0) {
#pragma unroll
    for (int r = 0; r < 16; ++r) { const int orow = wq * QBLK + crow(r, hi);
#pragma unroll
      for (int d0 = 0; d0 < 4; ++d0) { const int ix = orow * 128 + d0 * 32 + r32; buf[ix] = o[d0][r] * rli[r] - buf[ix]; } }
  }
  asm volatile("s_waitcnt lgkmcnt(0)\n\ts_barrier" ::: "memory");
  { const float g0 = g_subln[lane * 2] * out_scale, g1 = g_subln[lane * 2 + 1] * out_scale;
#pragma unroll 4
    for (int i = 0; i < 16; ++i) { const int row = wid * 16 + i; const f32x2 v = *(const LAS f32x2*)(buf + row * 128 + lane * 2);
      const float ss = wave_sum(v.x * v.x + v.y * v.y); const float rstd = 1.0f / sqrtf(ss * (1.0f / 128.0f) + EPS);
      *(unsigned*)(CAT + (size_t)(qb * 128 + row) * DM + head * 128 + lane * 2) = pk2(v.x * rstd * g0, v.y * rstd * g1); } }
  asm volatile("s_waitcnt vmcnt(0) lgkmcnt(0)\n\ts_barrier" ::: "memory");
  if (wid >= 4) __builtin_amdgcn_s_setprio(0);
#undef DMA_K
#undef DMA_V
#undef DMAK1
#undef DMAK2
#undef DMAV1
#undef DMAV2
#undef START
#undef RESC
#undef ROT
#undef PKW
#undef PAF
#undef VFR
#undef PIN
#undef MX3
#undef GAPA
#undef GAPB
#undef EX
#undef VRD
#undef KRD
#undef PVS
#undef STEP
#undef ENDW
}
#undef SBAR
#undef WAIT_BAR
}

namespace fft {
constexpr int XST = 72, ZST = 136, LDS_X = 0, LDS_Z = 2 * 128 * XST * 2, LDS_A1 = LDS_Z + 2 * 64 * ZST * 2, LDS_A2 = LDS_A1 + 128 * 136 * 2;
__device__ __forceinline__ int crow(int r, int hi) { return (r & 3) + 8 * (r >> 2) + 4 * hi; }
__device__ __forceinline__ void fft_phase(const bf16_t* __restrict__ WCT, bf16_t* __restrict__ FB, const bf16_t* __restrict__ A1T, const bf16_t* __restrict__ A2T, const float* __restrict__ TW, char* lds, int G) {
  const int tid = threadIdx.x, wid = tid >> 6, lane = tid & 63, r32 = lane & 31, hi = lane >> 5;
  bf16_t* Xs = (bf16_t*)(lds + LDS_X); bf16_t* Zs = (bf16_t*)(lds + LDS_Z);
  const int mb = wid & 3, nbp = wid >> 2;
  bf16x8 a2[8];
  bf16_t* A1s = (bf16_t*)(lds + LDS_A1);
#pragma unroll
  for (int q = 0; q < 4; ++q) { const int i = tid + 512 * q, row = i >> 4, c8 = (i & 15) * 8; *(u32x4*)(A1s + row * 136 + c8) = *(const u32x4*)(A1T + row * 128 + c8); }
#pragma unroll
  for (int ks = 0; ks < 8; ++ks) a2[ks] = *(const bf16x8*)(A2T + (32 * mb + r32) * 256 + 16 * (ks + 8) + 8 * hi);
  bf16_t* A2s = (bf16_t*)(lds + LDS_A2);
#pragma unroll
  for (int q = 0; q < 4; ++q) { const int i = tid + 512 * q, row = i >> 4, c8 = (i & 15) * 8; *(u32x4*)(A2s + row * 136 + c8) = *(const u32x4*)(A2T + row * 256 + c8); }
  f32x2 tw[2][8];
#pragma unroll
  for (int nbi = 0; nbi < 2; ++nbi)
#pragma unroll
    for (int q = 0; q < 8; ++q) { const int k1 = 16 * mb + 4 * (q >> 1) + 2 * hi + (q & 1), t2 = 32 * (2 * nbp + nbi) + r32; tw[nbi][q] = *(const f32x2*)(TW + 2 * (k1 * 128 + t2)); }
  const int k1o = 32 * nbp + r32;
#define FFT_LOADX(cp) do { const bf16_t* src = WCT + (size_t)(2 * (cp)) * 8192; \
        _Pragma("unroll") for (int pass = 0; pass < 4; ++pass) { const int p = tid + 512 * pass, ri = p >> 10, e = (p & 1023) * 8; pv[pass] = *(const u32x4*)(src + (size_t)ri * 8192 + e); } } while (0)
#define FFT_COLUMN(ncp, hasn, neg, OUT) do { \
      { _Pragma("unroll") for (int pass = 0; pass < 4; ++pass) { const int p = tid + 512 * pass, ri = p >> 10, e = (p & 1023) * 8, t2 = e >> 6, t1 = e & 63; \
          *(u32x4*)(Xs + (ri * 128 + t2) * XST + t1) = pv[pass]; } } \
      const unsigned sgn = (neg) ? 0x80008000u : 0u; \
      __syncthreads(); \
      if (hasn) FFT_LOADX(ncp); \
      f32x16 acc[2]; acc[0] = f32x16{}; acc[1] = f32x16{}; \
      _Pragma("unroll") for (int ks = 0; ks < 8; ++ks) \
        _Pragma("unroll") for (int nbi = 0; nbi < 2; ++nbi) { const int t2 = 32 * (2 * nbp + nbi) + r32; \
          u32x4 bw = *(const u32x4*)(Xs + ((ks >> 2) * 128 + t2) * XST + (ks & 3) * 16 + 8 * hi); if (ks >= 4) { bw.x ^= sgn; bw.y ^= sgn; bw.z ^= sgn; bw.w ^= sgn; } const bf16x8 bfr = __builtin_bit_cast(bf16x8, bw); \
          acc[nbi] = __builtin_amdgcn_mfma_f32_32x32x16_bf16(*(const bf16x8*)(A1s + (32 * mb + r32) * 136 + 16 * ks + 8 * hi), bfr, acc[nbi], 0, 0, 0); } \
      _Pragma("unroll") for (int nbi = 0; nbi < 2; ++nbi) { const int t2 = 32 * (2 * nbp + nbi) + r32; \
        _Pragma("unroll") for (int q = 0; q < 8; ++q) { const float yr = acc[nbi][2 * q], yi = acc[nbi][2 * q + 1]; const f32x2 cs = tw[nbi][q]; \
          const int k1 = 16 * mb + 4 * (q >> 1) + 2 * hi + (q & 1); \
          const unsigned zz = cvt2_bf16(yr * cs.x + yi * cs.y, yi * cs.x - yr * cs.y); Zs[k1 * ZST + t2] = (bf16_t)zz; Zs[(64 + k1) * ZST + t2] = (bf16_t)(zz >> 16); } } \
      __syncthreads(); \
      OUT = f32x16{}; \
      _Pragma("unroll") for (int ks = 0; ks < 16; ++ks) { const bf16x8 bfr = *(const bf16x8*)(Zs + ((ks >> 3) * 64 + k1o) * ZST + (ks & 7) * 16 + 8 * hi); \
        OUT = __builtin_amdgcn_mfma_f32_32x32x16_bf16(ks < 8 ? *(const bf16x8*)(A2s + (32 * mb + r32) * 136 + 16 * ks + 8 * hi) : a2[ks & 7], bfr, OUT, 0, 0, 0); } } while (0)
#define FB_AT(col, k) (FB + ((size_t)((col) >> 3) * 8192 + (k)) * 8 + ((col) & 7))
  constexpr float SC = 1.0f / 2048.0f;
  for (int unit = blockIdx.x; unit < 256; unit += G) {
    const int g = unit >> 6, cb = unit & 63;
    bf16_t* fb = FB + (size_t)(g * 64 + cb) * 8192 * 8;
    auto cpof = [&](int c) { return (c <= 255) ? g * 256 + c : (c == 256 ? 1024 + g : g * 256 + (512 - c)); };
    u32x4 pv[4];
    FFT_LOADX(cpof(8 * cb));
#pragma unroll 1
    for (int half = 0; half < 2; ++half) { u32x2 o[16];
#pragma unroll
      for (int jp = 0; jp < 2; ++jp) { f32x16 ea, eb;
        { const int c = 8 * cb + 4 * half + 2 * jp; const bool ng = c > 256; FFT_COLUMN(cpof(c + 1), true, ng, ea); }
        { const int c = 8 * cb + 4 * half + 2 * jp + 1; const bool ng = c > 256; const bool hn = (c & 7) != 7; FFT_COLUMN(cpof(c + 1), hn, ng, eb); }
#pragma unroll
        for (int r = 0; r < 16; ++r) o[r][jp] = pk2(ea[r] * SC, eb[r] * SC); }
#pragma unroll
      for (int r = 0; r < 16; ++r) { const int k = k1o + 64 * (32 * mb + crow(r, hi)); *(u32x2*)(fb + (size_t)k * 8 + 4 * half) = o[r]; } }
  }
#undef FFT_LOADX
#undef FFT_COLUMN
#undef FB_AT
  __syncthreads();
}
}

struct Args {
    const float *x, *c, *ctx, *c_ctx, *w_mod, *b_mod, *g_mix, *g_ffn, *w_in, *w_out, *lq1, *lk1, *lq2, *lk2, *g_subln, *ln_g, *ln_b, *w_sp, *b_sp, *w_fo, *w_r, *w_gate, *w_up, *w_down, *g_final;
    float* out; unsigned char* ws; int lo, hi;
};


struct Ctx {
    const LAS unsigned long long* PT;
    __device__ __forceinline__ const void* ld(int i) const { const unsigned long long v = PT[i]; const unsigned l = __builtin_amdgcn_readfirstlane((unsigned)v), h = __builtin_amdgcn_readfirstlane((unsigned)(v >> 32));
        return (const void*)(const GAS void*)(((unsigned long long)h << 32) | l); }
    __device__ __forceinline__ const float* x() const { return (const float*)ld(0); }
    __device__ __forceinline__ const float* c() const { return (const float*)ld(1); }
    __device__ __forceinline__ const float* ctx() const { return (const float*)ld(2); }
    __device__ __forceinline__ const float* c_ctx() const { return (const float*)ld(3); }
    __device__ __forceinline__ const float* w_mod() const { return (const float*)ld(4); }
    __device__ __forceinline__ const float* b_mod() const { return (const float*)ld(5); }
    __device__ __forceinline__ const float* g_mix() const { return (const float*)ld(6); }
    __device__ __forceinline__ const float* g_ffn() const { return (const float*)ld(7); }
    __device__ __forceinline__ const float* w_in() const { return (const float*)ld(8); }
    __device__ __forceinline__ const float* w_out() const { return (const float*)ld(9); }
    __device__ __forceinline__ const float* lq1() const { return (const float*)ld(10); }
    __device__ __forceinline__ const float* lk1() const { return (const float*)ld(11); }
    __device__ __forceinline__ const float* lq2() const { return (const float*)ld(12); }
    __device__ __forceinline__ const float* lk2() const { return (const float*)ld(13); }
    __device__ __forceinline__ const float* g_subln() const { return (const float*)ld(14); }
    __device__ __forceinline__ const float* ln_g() const { return (const float*)ld(15); }
    __device__ __forceinline__ const float* ln_b() const { return (const float*)ld(16); }
    __device__ __forceinline__ const float* w_sp() const { return (const float*)ld(17); }
    __device__ __forceinline__ const float* b_sp() const { return (const float*)ld(18); }
    __device__ __forceinline__ const float* w_fo() const { return (const float*)ld(19); }
    __device__ __forceinline__ const float* w_r() const { return (const float*)ld(20); }
    __device__ __forceinline__ const float* w_gate() const { return (const float*)ld(21); }
    __device__ __forceinline__ const float* w_up() const { return (const float*)ld(22); }
    __device__ __forceinline__ const float* w_down() const { return (const float*)ld(23); }
    __device__ __forceinline__ const float* g_final() const { return (const float*)ld(24); }
    __device__ __forceinline__ float* out() const { return (float*)ld(25); }
    __device__ __forceinline__ unsigned char* ws() const { return (unsigned char*)ld(26); }
};

__device__ __forceinline__ void transpose_item(const float* W, int K, int N, bf16_t* WT, int row_off, int ilv, LAS float* scr, int item, int lane) {
    const int nblk = N / 32, kb = item / nblk, nb = item % nblk, k0 = 64 * kb, n0 = 32 * nb;
#pragma unroll 8
    for (int i = 0; i < 32; ++i) { const int kk = 2 * i + (lane >> 5); scr[kk * 33 + (lane & 31)] = __builtin_nontemporal_load(W + (size_t)(k0 + kk) * N + n0 + (lane & 31)); }
    asm volatile("s_waitcnt lgkmcnt(0)" ::: "memory");
    const int c = lane & 7;
#pragma unroll
    for (int j = 0; j < 4; ++j) { const int n = (lane >> 3) + 8 * j; const LAS float* s = scr + (8 * c) * 33 + n;
        u32x4 o; o.x = pk2(s[0 * 33], s[1 * 33]); o.y = pk2(s[2 * 33], s[3 * 33]); o.z = pk2(s[4 * 33], s[5 * 33]); o.w = pk2(s[6 * 33], s[7 * 33]);
        const int ng = n0 + n, drow = row_off + (ilv ? ((ng >> 7) * 256 + (ng & 127)) : ng);
        *(u32x4*)(WT + (size_t)drow * K + k0 + 8 * c) = o; }
    asm volatile("s_waitcnt lgkmcnt(0)" ::: "memory");
}
struct CvtItem { const float* src; bf16_t* dst; int N, K, row_off, ilv, k0, n0; };
__device__ __forceinline__ void cvt_load(const CvtItem& d, f32x4 (&v)[8], int lane) {
    const float* p = d.src + (size_t)(d.k0 + (lane >> 3)) * d.N + d.n0 + (lane & 7) * 4;
#pragma unroll
    for (int q = 0; q < 8; ++q) v[q] = __builtin_nontemporal_load((const f32x4*)(p + (size_t)(8 * q) * d.N));
}
__device__ __forceinline__ void cvt_store(const CvtItem& d, const f32x4 (&v)[8], LAS float* scr, int lane) {
    const int rr = lane >> 3, c4 = (lane & 7) * 4;
#pragma unroll
    for (int q = 0; q < 8; ++q) { LAS float* t = scr + (8 * q + rr) * 33 + c4; t[0] = v[q].x; t[1] = v[q].y; t[2] = v[q].z; t[3] = v[q].w; }
    asm volatile("s_waitcnt lgkmcnt(0)" ::: "memory");
    const int c = lane & 7;
#pragma unroll
    for (int j = 0; j < 4; ++j) { const int n = (lane >> 3) + 8 * j; const LAS float* s = scr + (8 * c) * 33 + n;
        u32x4 o; o.x = pk2(s[0 * 33], s[1 * 33]); o.y = pk2(s[2 * 33], s[3 * 33]); o.z = pk2(s[4 * 33], s[5 * 33]); o.w = pk2(s[6 * 33], s[7 * 33]);
        const int ng = d.n0 + n, drow = d.row_off + (d.ilv ? ((ng >> 7) * 256 + (ng & 127)) : ng);
        __builtin_nontemporal_store(o, (u32x4*)(d.dst + (size_t)drow * d.K + d.k0 + 8 * c)); }
    asm volatile("s_waitcnt lgkmcnt(0)" ::: "memory");
}
constexpr int MOE_ITEMS = NE * (2 * (DM / 64) * (FE / 32) + (FE / 64) * (DM / 32));
__device__ __forceinline__ void convert_moe_items(const Ctx& a, int layer, LAS unsigned char* lds, int it0, int it1, int widx, int nw, int wave, int lane) {
    LAS float* scr = (LAS float*)(lds + wave * 16384);
    bf16_t* WGU = (bf16_t*)(a.ws() + WS_WGU + (size_t)layer * WGU_BYTES); bf16_t* WD = (bf16_t*)(a.ws() + WS_WD + (size_t)layer * WD_BYTES);
    constexpr int I_G = (DM / 64) * (FE / 32), I_D = (FE / 64) * (DM / 32);
    constexpr int PER_E = 2 * I_G + I_D;
    const float *wg = a.w_gate(), *wu = a.w_up(), *wd = a.w_down();
    auto decode = [&](int it) { CvtItem d; const int e = it / PER_E; int r = it % PER_E; const size_t eo = ((size_t)layer * NE + e) * (size_t)DM * FE;
        if (r < I_G)          { d.src = wg + eo; d.dst = WGU; d.N = FE; d.K = DM; d.row_off = e * 2048; d.ilv = 1; }
        else if (r < 2 * I_G) { r -= I_G; d.src = wu + eo; d.dst = WGU; d.N = FE; d.K = DM; d.row_off = e * 2048 + 128; d.ilv = 1; }
        else                  { r -= 2 * I_G; d.src = wd + eo; d.dst = WD; d.N = DM; d.K = FE; d.row_off = e * 2048; d.ilv = 0; }
        const int nblk = d.N / 32; d.k0 = 64 * (r / nblk); d.n0 = 32 * (r % nblk); return d; };
    int it = it0 + widx;
    if (it >= it1) return;
    f32x4 va[8], vb[8]; CvtItem da = decode(it), db = da; bool hb = (it + nw < it1);
    cvt_load(da, va, lane);
    if (hb) { db = decode(it + nw); cvt_load(db, vb, lane); }
    for (;;) {
        cvt_store(da, va, scr, lane);
        it += 2 * nw; const bool ha = (it < it1);
        if (ha) { da = decode(it); cvt_load(da, va, lane); }
        if (!hb) break;
        cvt_store(db, vb, scr, lane);
        hb = (it + nw < it1);
        if (hb) { db = decode(it + nw); cvt_load(db, vb, lane); }
        if (!ha) break;
    }
}
constexpr int L0_A = 12288, L0_B = 20480, L1_A = 45056;
__device__ __forceinline__ void p0_prologue(const Ctx& a, LAS unsigned char* lds, int G) {
    const int tid = threadIdx.x, lane = tid & 63, wave = __builtin_amdgcn_readfirstlane(tid >> 6);
    float* MODL = (float*)(a.ws() + WS_MODL); float* MODC = (float*)(a.ws() + WS_MODC);
    {
        LAS float* s_l = (LAS float*)lds; LAS float* s_c = s_l + 2048; LAS float* red = s_c + 2048;
        for (int k = tid; k < 2048; k += NTHR) { const float v = a.c()[k], w = a.c_ctx()[k]; s_l[k] = v / (1.0f + __expf(-v)); s_c[k] = w / (1.0f + __expf(-w)); }
        __syncthreads();
        const int cg = tid % 24, kg = tid / 24;
        for (int u = blockIdx.x; u < 256; u += G) {
            const int layer = u >> 7, n0 = (u & 127) * 96;
            f32x4 al = (f32x4){0.f, 0.f, 0.f, 0.f}, ac = al;
            if (kg < 21) {
                const float* W = a.w_mod() + (size_t)layer * DM * 12288 + n0 + 4 * cg;
#pragma unroll 8
                for (int k = kg; k < 2048; k += 21) { const f32x4 w = __builtin_nontemporal_load((const f32x4*)(W + (size_t)k * 12288)); al += s_l[k] * w; ac += s_c[k] * w; }
#pragma unroll
                for (int j = 0; j < 4; ++j) { red[(kg * 96 + 4 * cg + j) * 2] = al[j]; red[(kg * 96 + 4 * cg + j) * 2 + 1] = ac[j]; }
            }
            __syncthreads();
            if (tid < 96) { float sl = 0.f, sc = 0.f;
                for (int q = 0; q < 21; ++q) { sl += red[(q * 96 + tid) * 2]; sc += red[(q * 96 + tid) * 2 + 1]; }
                const float b = a.b_mod()[layer * 12288 + n0 + tid];
                MODL[layer * 12288 + n0 + tid] = sl + b;
                if (layer == 0 && n0 + tid < 4096) MODC[n0 + tid] = sc + b; }
            __syncthreads();
        }
    }
    {
        LAS float* tab = (LAS float*)lds;
        for (int j = tid; j < 8192; j += NTHR) tab[j] = cospif((float)j * (1.0f / 4096.0f));
        __syncthreads();
        const int gt = blockIdx.x * NTHR + tid, NT_ = G * NTHR;
        float* RC = (float*)(a.ws() + WS_ROPE); float* RS = RC + 128 * 16;
        for (int i = gt; i < 128 * 16; i += NT_) { const int pos = i >> 4, j = i & 15; const float inv = powf(10000.0f, -(float)j * (1.0f / 16.0f)); const float ang = (float)pos * inv; RC[i] = cosf(ang); RS[i] = sinf(ang); }
        bf16_t* CS = (bf16_t*)(a.ws() + WS_CS);
        for (int i = gt; i < 512 * 512; i += NT_) { const int r = i >> 9, d = i & 511, m = r >> 1, ri = r & 1; const int j = (((m * d) & 511) * 16 + (ri ? 2048 : 0)) & 8191; CS[i] = (bf16_t)f2bf(tab[j]); }
        bf16_t* A1 = (bf16_t*)(a.ws() + WS_A1);
        for (int i = gt; i < 128 * 128; i += NT_) { const int m1 = i >> 7, k = i & 127, k1 = m1 >> 1, rp = m1 & 1, ri = k >> 6, t1 = k & 63; int j = ((t1 * k1) & 63) * 128;
            if (rp == 0 && ri == 1) j -= 2048; if (rp == 1 && ri == 0) j += 2048; A1[i] = (bf16_t)f2bf(tab[j & 8191]); }
        bf16_t* A2 = (bf16_t*)(a.ws() + WS_A2);
        for (int i = gt; i < 128 * 256; i += NT_) { const int k2 = i >> 8, k = i & 255, ri = k >> 7, t2 = k & 127; int j = ((t2 * k2) & 127) * 64; if (ri) j -= 2048; A2[i] = (bf16_t)f2bf(tab[j & 8191]); }
        float* TW = (float*)(a.ws() + WS_TW);
        for (int i = gt; i < 64 * 128; i += NT_) { const int k1 = i >> 7, t2 = i & 127, j = t2 * k1; TW[2 * i] = tab[j]; TW[2 * i + 1] = tab[(j - 2048) & 8191]; }
        __syncthreads();
    }
    {
        const int gw = blockIdx.x * NWAVES + wave, NGW = G * NWAVES;
        LAS float* scr = (LAS float*)(lds + wave * 16384);
        constexpr int I_IN = (DM / 64) * (INC / 32), I_SQ = (DM / 64) * (DM / 32);
        for (int it = gw; it < I_IN + 2 * I_SQ; it += NGW) {
            int r = it;
            if (r < I_IN) { transpose_item(a.w_in(), DM, INC, (bf16_t*)(a.ws() + WS_WIN), 0, 0, scr, r, lane); continue; } r -= I_IN;
            if (r < I_SQ) { transpose_item(a.w_out(), DM, DM, (bf16_t*)(a.ws() + WS_WOUT), 0, 0, scr, r, lane); continue; } r -= I_SQ;
            transpose_item(a.w_fo(), DM, DM, (bf16_t*)(a.ws() + WS_WFO), 0, 0, scr, r, lane);
        }
        convert_moe_items(a, 0, lds, 0, L0_A, gw, NGW, wave, lane);
    }
}

__device__ __forceinline__ void norm_mod_row(const float* xrow, const float* gain, const float* shift, const float* scale, bf16_t* orow, int lane) {
    f32x4 v[8]; float ss = 0.f;
#pragma unroll
    for (int j = 0; j < 8; ++j) { v[j] = *(const f32x4*)(xrow + j * 256 + lane * 4); ss += (v[j].x * v[j].x + v[j].y * v[j].y) + (v[j].z * v[j].z + v[j].w * v[j].w); }
    const float rstd = 1.0f / sqrtf(wave_sum(ss) * (1.0f / DM) + EPS);
#pragma unroll
    for (int j = 0; j < 8; ++j) { const int c = j * 256 + lane * 4; const f32x4 g = *(const f32x4*)(gain + c), sh = *(const f32x4*)(shift + c), sc = *(const f32x4*)(scale + c);
        const f32x4 y = v[j] * rstd * g * (1.0f + sc) + sh;
        u32x2 w; w.x = pk2(y.x, y.y); w.y = pk2(y.z, y.w); *(u32x2*)(orow + c) = w; }
}

__device__ __forceinline__ void router_phase(const Ctx& a, int layer, LAS unsigned char* lds, int G) {
    const int tid = threadIdx.x, lane = tid & 63, wave = __builtin_amdgcn_readfirstlane(tid >> 6);
    constexpr int ROWB = 4112;
    LAS unsigned char* XT = lds; LAS float* RS = (LAS float*)(lds + 32 * ROWB); LAS float* PART = (LAS float*)lds;
    const _Float16* X = (const _Float16*)(a.ws() + WS_X); bf16_t* H2 = (bf16_t*)(a.ws() + WS_H2); float* AFF = (float*)(a.ws() + WS_AFF);
    const float* mod = (const float*)(a.ws() + WS_MODL) + layer * 12288; const float* gain = a.g_ffn() + layer * DM;
    const int m = lane & 15, kq = lane >> 4;
    int unit = blockIdx.x;
    f16x4 nx[4][8];
    if (unit < SEQ / 32) {
#pragma unroll
        for (int i = 0; i < 4; ++i) {
#pragma unroll
            for (int j = 0; j < 8; ++j) nx[i][j] = *(const f16x4*)(X + (size_t)(unit * 32 + wave * 4 + i) * DM + ((j >> 1) * 512 + lane * 8 + (j & 1) * 4)); } }
    f32x4 ca[8], cb[8];
#pragma unroll
    for (int j = 0; j < 8; ++j) { const int c = ((j >> 1) * 512 + lane * 8 + (j & 1) * 4); ca[j] = *(const f32x4*)(gain + c) * (1.0f + *(const f32x4*)(mod + 4 * DM + c)); cb[j] = *(const f32x4*)(mod + 3 * DM + c); }
    const float bias = ((const float*)(a.ws() + WS_WRB))[layer * 16 + m];
    for (; unit < SEQ / 32; unit += G) {
        const int r0 = unit * 32 + wave * 4;
#pragma unroll
        for (int i = 0; i < 4; ++i) {
            const int row = r0 + i; f32x4 v[8]; float ss = 0.f;
            LAS unsigned char* xt = XT + (wave * 4 + i) * ROWB;
#pragma unroll
            for (int j = 0; j < 8; ++j) { *(LAS f16x4*)(xt + 2 * ((j >> 1) * 512 + lane * 8 + (j & 1) * 4)) = nx[i][j]; v[j] = __builtin_convertvector(nx[i][j], f32x4);
                ss += (v[j].x * v[j].x + v[j].y * v[j].y) + (v[j].z * v[j].z + v[j].w * v[j].w); }
            { const int nrow = (unit + G) * 32 + wave * 4 + i;
              if (nrow < SEQ) {
#pragma unroll
                for (int j = 0; j < 8; ++j) nx[i][j] = *(const f16x4*)(X + (size_t)nrow * DM + ((j >> 1) * 512 + lane * 8 + (j & 1) * 4)); } }
            asm volatile("" ::: "memory");
            const float rstd = 1.0f / sqrtf(wave_sum(ss) * (1.0f / DM) + EPS);
            if (lane == 0) RS[wave * 4 + i] = rstd;
#pragma unroll
            for (int q = 0; q < 4; ++q) {
                const f32x4 h0 = v[2 * q] * rstd * ca[2 * q] + cb[2 * q], h1 = v[2 * q + 1] * rstd * ca[2 * q + 1] + cb[2 * q + 1];
                u32x4 w; w.x = pk2(h0.x, h0.y); w.y = pk2(h0.z, h0.w); w.z = pk2(h1.x, h1.y); w.w = pk2(h1.z, h1.w); *(u32x4*)(H2 + (size_t)row * DM + q * 512 + lane * 8) = w; }
        }
        f16x8 bh[8], bl[8];
        { const f16x8* WRP = (const f16x8*)(a.ws() + WS_WRP) + (size_t)layer * 2 * 4096 + wave * 512 + lane;
#pragma unroll
          for (int s = 0; s < 8; ++s) { bh[s] = WRP[s * 64]; bl[s] = WRP[4096 + s * 64]; } }
        __syncthreads();
        f32x4 acc0 = {0.f, 0.f, 0.f, 0.f}, acc1 = {0.f, 0.f, 0.f, 0.f};
        { const LAS unsigned char* ap = XT + m * ROWB + (wave * 256 + kq * 8) * 2;
#pragma unroll
          for (int s = 0; s < 8; ++s) { const f16x8 a0 = *(const LAS f16x8*)(ap + s * 64), a1 = *(const LAS f16x8*)(ap + 16 * ROWB + s * 64);
            acc0 = __builtin_amdgcn_mfma_f32_16x16x32_f16(a0, bh[s], acc0, 0, 0, 0); acc0 = __builtin_amdgcn_mfma_f32_16x16x32_f16(a0, bl[s], acc0, 0, 0, 0);
            acc1 = __builtin_amdgcn_mfma_f32_16x16x32_f16(a1, bh[s], acc1, 0, 0, 0); acc1 = __builtin_amdgcn_mfma_f32_16x16x32_f16(a1, bl[s], acc1, 0, 0, 0); } }
        __syncthreads();
        *(LAS f32x4*)(PART + ((wave * 2 + 0) * 64 + lane) * 4) = acc0; *(LAS f32x4*)(PART + ((wave * 2 + 1) * 64 + lane) * 4) = acc1;
        __syncthreads();
        { const int mt = wave >> 2, r = wave & 3; float sum = 0.f;
#pragma unroll
          for (int w = 0; w < 8; ++w) sum += PART[((w * 2 + mt) * 64 + lane) * 4 + r];
          const int lr = 16 * mt + 4 * kq + r;
          const float lg = sum * (RS[lr] * (1.0f / 64.0f)) + bias;
          float mx = lg; mx = fmaxf(mx, dpp_f(mx, 0)); mx = fmaxf(mx, dpp_f(mx, 1)); mx = fmaxf(mx, dpp_f(mx, 2)); mx = fmaxf(mx, dpp_f(mx, 3));
          const float pe = expf(lg - mx); float sm = pe; sm += dpp_f(sm, 0); sm += dpp_f(sm, 1); sm += dpp_f(sm, 2); sm += dpp_f(sm, 3);
          AFF[(size_t)m * SEQ + unit * 32 + lr] = pe * (1.0f / sm); }
        __syncthreads();
    }
}

__device__ __forceinline__ void topk_expert(const Ctx& a, int e, LAS unsigned char* lds) {
    const int tid = threadIdx.x, lane = tid & 63;
    LAS unsigned* hist = (LAS unsigned*)lds; LAS unsigned* bc = hist + 256; LAS unsigned* cg = bc + 16; LAS unsigned* ce = cg + 512;
    const float* aff = (const float*)(a.ws() + WS_AFF) + (size_t)e * SEQ;
    int* IDX = (int*)(a.ws() + WS_IDX) + e * CAP; float* GATE = (float*)(a.ws() + WS_GATE) + e * CAP; int* POS = (int*)(a.ws() + WS_POS) + (size_t)e * SEQ;
    unsigned key[16];
#pragma unroll
    for (int j = 0; j < 4; ++j) { const u32x4 v = *(const u32x4*)(aff + tid * 16 + j * 4); key[4 * j] = v.x; key[4 * j + 1] = v.y; key[4 * j + 2] = v.z; key[4 * j + 3] = v.w; }
    unsigned prefix = 0u, mask = 0u, remaining = CAP;
    for (int pass = 0; pass < 4; ++pass) {
        const int shift = 24 - 8 * pass;
        if (tid < 256) hist[tid] = 0u;
        __syncthreads();
#pragma unroll
        for (int j = 0; j < 16; ++j) if ((key[j] & mask) == prefix) __hip_atomic_fetch_add(&hist[(key[j] >> shift) & 255u], 1u, __ATOMIC_RELAXED, __HIP_MEMORY_SCOPE_WORKGROUP);
        __syncthreads();
        if (tid < 64) {
            const unsigned h0 = hist[255 - 4 * lane], h1 = hist[254 - 4 * lane], h2 = hist[253 - 4 * lane], h3 = hist[252 - 4 * lane];
            const unsigned s = h0 + h1 + h2 + h3; unsigned inc = s;
#pragma unroll
            for (int o = 1; o < 64; o <<= 1) { const unsigned v = __shfl_up(inc, o); if (lane >= o) inc += v; }
            const unsigned exc = inc - s;
            if (exc < remaining && remaining <= inc) {
                unsigned c = exc; unsigned b;
                if (c + h0 >= remaining) b = 255 - 4 * lane;
                else { c += h0; if (c + h1 >= remaining) b = 254 - 4 * lane; else { c += h1; if (c + h2 >= remaining) b = 253 - 4 * lane; else { c += h2; b = 252 - 4 * lane; } } }
                bc[0] = b; bc[1] = remaining - c;
            }
        }
        __syncthreads();
        prefix |= bc[0] << shift; mask |= 255u << shift; remaining = bc[1];
        __syncthreads();
    }
    const unsigned T = prefix, need = remaining;
    unsigned ngt = 0u, neq = 0u;
#pragma unroll
    for (int j = 0; j < 16; ++j) { ngt += key[j] > T ? 1u : 0u; neq += key[j] == T ? 1u : 0u; }
    cg[tid] = ngt; ce[tid] = neq;
    __syncthreads();
    if (tid < 64) {
        unsigned av[8], bv[8], sa = 0u, sb = 0u;
#pragma unroll
        for (int q = 0; q < 8; ++q) { av[q] = cg[lane * 8 + q]; bv[q] = ce[lane * 8 + q]; sa += av[q]; sb += bv[q]; }
        unsigned ia = sa, ib = sb;
#pragma unroll
        for (int o = 1; o < 64; o <<= 1) { const unsigned va = __shfl_up(ia, o), vb = __shfl_up(ib, o); if (lane >= o) { ia += va; ib += vb; } }
        unsigned ea = ia - sa, eb = ib - sb;
#pragma unroll
        for (int q = 0; q < 8; ++q) { cg[lane * 8 + q] = ea; ea += av[q]; ce[lane * 8 + q] = eb; eb += bv[q]; }
        if (lane == 63) bc[2] = ia;
    }
    __syncthreads();
    unsigned og = cg[tid], oe = ce[tid]; const unsigned tg = bc[2];
#pragma unroll
    for (int j = 0; j < 16; ++j) { const int token = tid * 16 + j; int slot = -1;
        if (key[j] > T) slot = (int)(og++);
        else if (key[j] == T) { if (oe < need) slot = (int)(tg + oe); ++oe; }
        POS[token] = slot;
        if (slot >= 0) { IDX[slot] = token; GATE[slot] = __uint_as_float(key[j]); } }
    __syncthreads();
}

__device__ __forceinline__ void combine_phase(const Ctx& a, int layer, int G) {
    const int tid = threadIdx.x, lane = tid & 63, wave = __builtin_amdgcn_readfirstlane(tid >> 6);
    _Float16* X = (_Float16*)(a.ws() + WS_X); const bf16_t* Y = (const bf16_t*)(a.ws() + WS_Y); const int* POS = (const int*)(a.ws() + WS_POS);
    const float* modl = (const float*)(a.ws() + WS_MODL);
    const float* gf = modl + layer * 12288 + 5 * DM;
    const int gw = blockIdx.x * NWAVES + wave, NGW = G * NWAVES;
    int pl[4]; f16x4 nx[4][8];
#pragma unroll
    for (int i = 0; i < 4; ++i) { const int row = gw + i * NGW; pl[i] = -1;
        if (row < SEQ) { pl[i] = (lane < NE) ? POS[(size_t)lane * SEQ + row] : -1;
#pragma unroll
            for (int j = 0; j < 8; ++j) nx[i][j] = *(const f16x4*)(X + (size_t)row * DM + ((j >> 1) * 512 + lane * 8 + (j & 1) * 4)); } }
    for (int base = gw; base < SEQ; base += 4 * NGW) {
#pragma unroll
      for (int i = 0; i < 4; ++i) { const int row = base + i * NGW;
       if (row < SEQ) {
        _Float16* xr = X + (size_t)row * DM; f32x4 v[8], sum[8];
        const int plc = pl[i]; unsigned long long sel = __ballot(plc >= 0);
#pragma unroll
        for (int j = 0; j < 8; ++j) { v[j] = __builtin_convertvector(nx[i][j], f32x4); sum[j] = (f32x4){0.f, 0.f, 0.f, 0.f}; }
        { const int nrow = row + 4 * NGW;
          if (nrow < SEQ) { pl[i] = (lane < NE) ? POS[(size_t)lane * SEQ + nrow] : -1;
#pragma unroll
            for (int j = 0; j < 8; ++j) nx[i][j] = *(const f16x4*)(X + (size_t)nrow * DM + ((j >> 1) * 512 + lane * 8 + (j & 1) * 4)); } }
        while (sel) { const int e0 = __builtin_ctzll(sel); sel &= sel - 1;
            const bf16_t* y0 = Y + (size_t)(e0 * CAP + __builtin_amdgcn_readlane(plc, e0)) * DM;
            u32x2 w0[8];
#pragma unroll
            for (int j = 0; j < 8; ++j) w0[j] = *(const u32x2*)(y0 + ((j >> 1) * 512 + lane * 8 + (j & 1) * 4));
#pragma unroll
            for (int j = 0; j < 8; ++j) sum[j] += (f32x4){bflo(w0[j].x), bfhi(w0[j].x), bflo(w0[j].y), bfhi(w0[j].y)}; }
        float ss = 0.f;
#pragma unroll
        for (int j = 0; j < 8; ++j) { const int c = ((j >> 1) * 512 + lane * 8 + (j & 1) * 4); v[j] = v[j] + *(const f32x4*)(gf + c) * sum[j];
            ss += (v[j].x * v[j].x + v[j].y * v[j].y) + (v[j].z * v[j].z + v[j].w * v[j].w); }
        const float rstd = 1.0f / sqrtf(wave_sum(ss) * (1.0f / DM) + EPS);
        if (layer == 0) {
            bf16_t* orow = (bf16_t*)(a.ws() + WS_HCAT) + (size_t)row * DM; const float* m1 = modl + 12288; const float* gain = a.g_mix() + DM;
            float nyq[4] = {0.f, 0.f, 0.f, 0.f};
#pragma unroll
            for (int q = 0; q < 4; ++q) { const int c = q * 512 + lane * 8;
                { const f16x4 r0 = __builtin_convertvector(v[2 * q], f16x4), r1 = __builtin_convertvector(v[2 * q + 1], f16x4); *(f16x8*)(xr + c) = __builtin_shufflevector(r0, r1, 0, 1, 2, 3, 4, 5, 6, 7); }
                const f32x4 y0 = v[2 * q] * rstd * *(const f32x4*)(gain + c) * (1.0f + *(const f32x4*)(m1 + DM + c)) + *(const f32x4*)(m1 + c);
                const f32x4 y1 = v[2 * q + 1] * rstd * *(const f32x4*)(gain + c + 4) * (1.0f + *(const f32x4*)(m1 + DM + c + 4)) + *(const f32x4*)(m1 + c + 4);
                u32x4 w; w.x = pk2(y0.x, y0.y); w.y = pk2(y0.z, y0.w); w.z = pk2(y1.x, y1.y); w.w = pk2(y1.z, y1.w); *(u32x4*)(orow + c) = w;
                nyq[q] += ((bflo(w.x) - bfhi(w.x)) + (bflo(w.y) - bfhi(w.y))) + ((bflo(w.z) - bfhi(w.z)) + (bflo(w.w) - bfhi(w.w))); }
            { bf16_t* WCT = (bf16_t*)(a.ws() + WS_WCT); const int n = (row & 127) * 64 + (row >> 7);
                float mine = 0.f;
#pragma unroll
                for (int g = 0; g < 4; ++g) { const float sg = wave_sum(nyq[g]); mine = (lane == g) ? sg : mine; }
                if (lane < 4) { WCT[(size_t)(2048 + 2 * lane) * 8192 + n] = (bf16_t)f2bf(mine); WCT[(size_t)(2049 + 2 * lane) * 8192 + n] = 0; } }
        } else {
            float* orow = a.out() + (size_t)row * DM;
#pragma unroll
            for (int j = 0; j < 8; ++j) { const int c = ((j >> 1) * 512 + lane * 8 + (j & 1) * 4); *(f32x4*)(orow + c) = v[j] * rstd * *(const f32x4*)(a.g_final() + c); }
        }
       } }
    }
}

#define PHASE_FN static __device__ __forceinline__ void
#define PH_PRO extern __shared__ __attribute__((aligned(16))) unsigned char lds_raw[]; LAS unsigned char* lds = (LAS unsigned char*)lds_raw; (void)lds; \
    const int tid = threadIdx.x, lane = tid & 63, wave = __builtin_amdgcn_readfirstlane(tid >> 6), G = gridDim.x; (void)lane; (void)wave; \
    Ctx a; a.PT = (const LAS unsigned long long*)(lds + LDSCTL_OFF + 64); const int gw = blockIdx.x * NWAVES + wave, NGW = G * NWAVES; (void)gw; (void)NGW;

__device__ __forceinline__ void router_prep(const Ctx& a, int nb, int tid, int lane, int wave) {
    const float* MODL = (const float*)(a.ws() + WS_MODL);
    for (int it = blockIdx.x * NTHR + tid; it < 2 * 4096; it += nb * NTHR) { const int layer = it >> 12, kc = (it >> 4) & 255, n = it & 15;
        const float* w_r = a.w_r() + (size_t)layer * DM * NE; const float* gain = a.g_ffn() + layer * DM; const float* sc = MODL + layer * 12288 + 4 * DM;
        f16x8 hi, lo;
#pragma unroll
        for (int i = 0; i < 8; ++i) { const int c = kc * 8 + i; const float wv = 64.0f * gain[c] * (1.0f + sc[c]) * w_r[c * NE + n];
            const _Float16 h = (_Float16)wv; hi[i] = h; lo[i] = (_Float16)(wv - (float)h); }
        f16x8* WRP = (f16x8*)(a.ws() + WS_WRP) + (size_t)layer * 2 * 4096;
        WRP[kc * 16 + n] = hi; WRP[4096 + kc * 16 + n] = lo; }
    const int gwb = blockIdx.x * NWAVES + wave, ngw = nb * NWAVES;
    if (gwb >= ngw - 32 && gwb < ngw) { const int q = gwb - (ngw - 32), layer = q >> 4, e = q & 15;
        const float* w_r = a.w_r() + (size_t)layer * DM * NE; const float* sh = MODL + layer * 12288 + 3 * DM; float acc = 0.f;
#pragma unroll 8
        for (int i = 0; i < 32; ++i) { const int c = lane + 64 * i; acc = fmaf(sh[c], w_r[c * NE + e], acc); }
        acc = wave_sum(acc);
        if (lane == 0) ((float*)(a.ws() + WS_WRB))[q] = acc; }
}
PHASE_FN ph_prologue() { PH_PRO; p0_prologue(a, lds, G); }
PHASE_FN ph_hcat() { PH_PRO;
    const float* MODL = (const float*)(a.ws() + WS_MODL); const float* MODC = (const float*)(a.ws() + WS_MODC); bf16_t* HCAT = (bf16_t*)(a.ws() + WS_HCAT);
    const float* ctx = a.ctx(); const float* x = a.x(); const float* gm = a.g_mix();
    f32x4 nx[4][8];
#pragma unroll
    for (int i = 0; i < 4; ++i) { const int row = gw + i * NGW;
        if (row < SEQ) {
#pragma unroll
            for (int j = 0; j < 8; ++j) nx[i][j] = __builtin_nontemporal_load((const f32x4*)(x + (size_t)row * DM + ((j >> 1) * 512 + lane * 8 + (j & 1) * 4))); } }
    for (int r = blockIdx.x; r < CTXL; r += G) { LAS float* red = (LAS float*)lds; const int c = wave * 256 + lane * 4;
        const f32x4 cv = *(const f32x4*)(ctx + (size_t)r * DM + c), g4 = *(const f32x4*)(gm + c), s4 = *(const f32x4*)(MODC + DM + c), h4 = *(const f32x4*)(MODC + c);
        const float ps = wave_sum((cv.x * cv.x + cv.y * cv.y) + (cv.z * cv.z + cv.w * cv.w));
        if (lane == 0) red[wave] = ps;
        __syncthreads();
        float tot = 0.f;
#pragma unroll
        for (int w = 0; w < NWAVES; ++w) tot += red[w];
        const float rstd = 1.0f / sqrtf(tot * (1.0f / DM) + EPS);
        const f32x4 y = cv * rstd * g4 * (1.0f + s4) + h4;
        u32x2 w; w.x = pk2(y.x, y.y); w.y = pk2(y.z, y.w); *(u32x2*)(HCAT + (size_t)r * DM + c) = w;
        __syncthreads(); }
    for (int base = gw; base < SEQ; base += 4 * NGW) {
#pragma unroll
        for (int i = 0; i < 4; ++i) { const int row = base + i * NGW;
            if (row < SEQ) {
                float ss = 0.f;
#pragma unroll
                for (int j = 0; j < 8; ++j) { const f32x4 t = nx[i][j]; ss += (t.x * t.x + t.y * t.y) + (t.z * t.z + t.w * t.w); }
                const float rstd = 1.0f / sqrtf(wave_sum(ss) * (1.0f / DM) + EPS);
                bf16_t* orow = HCAT + (size_t)(CTXL + row) * DM;
#pragma unroll
                for (int q = 0; q < 4; ++q) { const int c = q * 512 + lane * 8;
                    const f32x4 y0 = nx[i][2 * q] * rstd * (*(const f32x4*)(gm + c) * (1.0f + *(const f32x4*)(MODL + DM + c))) + *(const f32x4*)(MODL + c);
                    const f32x4 y1 = nx[i][2 * q + 1] * rstd * (*(const f32x4*)(gm + c + 4) * (1.0f + *(const f32x4*)(MODL + DM + c + 4))) + *(const f32x4*)(MODL + c + 4);
                    u32x4 w; w.x = pk2(y0.x, y0.y); w.y = pk2(y0.z, y0.w); w.z = pk2(y1.x, y1.y); w.w = pk2(y1.z, y1.w); *(u32x4*)(orow + c) = w; }
                const int nrow = row + 4 * NGW;
                if (nrow < SEQ) {
#pragma unroll
                    for (int j = 0; j < 8; ++j) nx[i][j] = __builtin_nontemporal_load((const f32x4*)(x + (size_t)nrow * DM + ((j >> 1) * 512 + lane * 8 + (j & 1) * 4))); }
            } }
    }
}
PHASE_FN ph_win() { PH_PRO;
    unsigned char* ws = a.ws();
    const pg8::Geo g = pg8::geo_rowmajor(ws + WS_HCAT, DM, ws + WS_WIN, DM, DM);
    pg8::WinOrder S; S.init_win(G, (int)blockIdx.x);
    pg8::EpiWin E{(bf16_t*)(ws + WS_Q), (bf16_t*)(ws + WS_K), (bf16_t*)(ws + WS_V), (bf16_t*)(ws + WS_UV), (const float*)(ws + WS_ROPE), (const float*)(ws + WS_ROPE) + 128 * 16};
    pg8::gemm_phase<pg8::EpiWin, pg8::WinOrder, true, true>(lds, g, S, E);
    { const int nu = S.total(), maxu = (nu + G - 1) / G, nfull = nu - (maxu - 1) * G;
      if ((int)blockIdx.x >= nfull && nfull < G) convert_moe_items(a, 0, lds, L0_B, MOE_ITEMS, ((int)blockIdx.x - nfull) * NWAVES + wave, (G - nfull) * NWAVES, wave, lane);
      else if (nfull >= G) { convert_moe_items(a, 0, lds, L0_B, MOE_ITEMS, gw, NGW, wave, lane); router_prep(a, G, tid, lane, wave); }
      else router_prep(a, nfull, tid, lane, wave); }
}
PHASE_FN ph_attn() { PH_PRO;
    unsigned char* ws = a.ws();
    float lam;
    { const float q1 = a.lq1()[lane] * a.lk1()[lane], q2 = a.lq2()[lane] * a.lk2()[lane]; lam = expf(wave_sum(q1)) - expf(wave_sum(q2)) + 0.2f; }
    const float* gs = a.g_subln();
    for (int i = blockIdx.x; i < 512; i += G)
        att2::attn_unit<8>((const bf16_t*)(ws + WS_Q), (const bf16_t*)(ws + WS_K), (const bf16_t*)(ws + WS_V), (bf16_t*)(ws + WS_CAT), i & 7, i >> 3, lam, 0.8f, gs, lds);
}
PHASE_FN ph_sgu() { PH_PRO;
    unsigned char* ws = a.ws();
    const float *w_sp = a.w_sp(), *b_sp = a.b_sp(), *ln_g = a.ln_g(), *ln_b = a.ln_b();
    for (int i = blockIdx.x; i < 512; i += G)
        att::sgu_unit((const bf16_t*)(ws + WS_UV), (bf16_t*)(ws + WS_CAT), w_sp, b_sp, ln_g, ln_b, i >> 3, i & 7, (char*)lds_raw);
}
PHASE_FN ph_wout() { PH_PRO;
    unsigned char* ws = a.ws();
    const int GH = (G >= 2) ? G / 2 : G;
    if ((int)blockIdx.x < GH) {
        const pg8::Geo g = pg8::geo_rowmajor(ws + WS_CAT, DM, ws + WS_WOUT, DM, DM);
        pg8::StaticOrder S; S.init(SEQ, DM, GH, (int)blockIdx.x);
        pg8::EpiResidN<true> E{a.x(), (_Float16*)(ws + WS_X), (const float*)(ws + WS_MODL) + 2 * DM};
        pg8::gemm_phase<pg8::EpiResidN<true>, pg8::StaticOrder, true, true>(lds, g, S, E);
        if (GH == G) convert_moe_items(a, 1, lds, 0, L1_A, gw, NGW, wave, lane);
    } else convert_moe_items(a, 1, lds, 0, L1_A, ((int)blockIdx.x - GH) * NWAVES + wave, (G - GH) * NWAVES, wave, lane);
}
PHASE_FN ph_stepa() { PH_PRO;
    unsigned char* ws = a.ws();
    pg8::Geo g = pg8::geo_rowmajor(ws + WS_CS, 512, ws + WS_HCAT, DM, 512);
    g.aB = 1024;
    g.bmode = 1; g.hB = (size_t)2 * g.ldb2; g.tB = (size_t)4 * g.ldb2;
    pg8::StepAOrder S{G, (int)blockIdx.x};
    pg8::EpiBf16 E{(bf16_t*)(ws + WS_WCT), SEQ, 512};
    pg8::gemm_phase<pg8::EpiBf16, pg8::StepAOrder, true, true>(lds, g, S, E);
}
PHASE_FN ph_dft() { PH_PRO;
    unsigned char* ws = a.ws();
    fft::fft_phase((const bf16_t*)(ws + WS_WCT), (bf16_t*)(ws + WS_F), (const bf16_t*)(ws + WS_A1), (const bf16_t*)(ws + WS_A2), (const float*)(ws + WS_TW), (char*)lds_raw, G);
}
PHASE_FN ph_wfo() { PH_PRO;
    unsigned char* ws = a.ws();
    pg8::Geo g = pg8::geo_rowmajor(ws + WS_F, DM, ws + WS_WFO, DM, DM);
    g.amode = 1; g.kA = 8 * 131072; g.hA = 2048; g.tA = 4096;
    pg8::StaticOrder S; S.init(SEQ, DM, G, (int)blockIdx.x);
    pg8::EpiResid<false> E{(const void*)(ws + WS_X), (_Float16*)(ws + WS_X), (const float*)(ws + WS_MODL) + 12288 + 2 * DM};
    pg8::gemm_phase<pg8::EpiResid<false>, pg8::StaticOrder, true, true>(lds, g, S, E);
}
PHASE_FN ph_router(int layer) { PH_PRO; router_phase(a, layer, lds, G); }
PHASE_FN ph_topk(int layer) { PH_PRO; for (int e = blockIdx.x; e < NE; e += G) topk_expert(a, e, lds);
    if ((int)blockIdx.x >= NE || G <= NE) { const int widx = (G <= NE) ? gw : ((int)blockIdx.x - NE) * NWAVES + wave, nw = (G <= NE) ? NGW : (G - NE) * NWAVES;
        if (layer == 0) convert_moe_items(a, 0, lds, L0_A, L0_B, widx, nw, wave, lane); else convert_moe_items(a, 1, lds, L1_A, MOE_ITEMS, widx, nw, wave, lane); } }
PHASE_FN ph_gather() { PH_PRO;
    unsigned char* ws = a.ws();
    const int* IDX = (const int*)(ws + WS_IDX); const bf16_t* H2 = (const bf16_t*)(ws + WS_H2); bf16_t* XS = (bf16_t*)(ws + WS_XS);
    for (int r = gw; r < MR; r += NGW) { const int t = IDX[r]; const u32x4* s = (const u32x4*)(H2 + (size_t)t * DM) + lane; u32x4* d = (u32x4*)(XS + (size_t)r * DM) + lane;
#pragma unroll
        for (int j = 0; j < 4; ++j) d[64 * j] = s[64 * j]; }
}
PHASE_FN ph_gateup(int layer) { PH_PRO;
    unsigned char* ws = a.ws();
    pg8::Geo g = pg8::geo_rowmajor(ws + WS_H2, DM, ws + WS_WGU + (size_t)layer * WGU_BYTES, DM, DM);
    g.aB = (size_t)2048 * DM * 2; g.hA = 0; g.tA = 0;
    pg8::MoeOrder S; S.init(MR, 2048, G, (int)blockIdx.x);
    pg8::EpiGateUp E{(bf16_t*)(ws + WS_ACT)};
    pg8::gemm_phase<pg8::EpiGateUp, pg8::MoeOrder, true, true, true>(lds, g, S, E, (const int*)(ws + WS_IDX));
}
PHASE_FN ph_down(int layer) { PH_PRO;
    unsigned char* ws = a.ws();
    pg8::Geo g = pg8::geo_rowmajor(ws + WS_ACT, FE, ws + WS_WD + (size_t)layer * WD_BYTES, FE, FE);
    g.aB = (size_t)2048 * FE * 2;
    pg8::MoeOrder S; S.init(MR, DM, G, (int)blockIdx.x);
    pg8::EpiDown E{(bf16_t*)(ws + WS_Y), (const float*)(ws + WS_GATE)};
    pg8::gemm_phase<pg8::EpiDown, pg8::MoeOrder, true, true>(lds, g, S, E);
}
PHASE_FN ph_combine(int layer) { PH_PRO; combine_phase(a, layer, G); }

__global__ void __launch_bounds__(NTHR, 2) fwd(Args ka) {
    extern __shared__ __attribute__((aligned(16))) unsigned char lds_raw[];
    LAS unsigned char* lds = (LAS unsigned char*)lds_raw;
    const int tid = threadIdx.x;
    const int lo = ka.lo, hi = ka.hi;
    for (int u = tid; u < 16; u += NTHR) ((LAS unsigned*)(lds + LDSCTL_OFF))[u] = 0u;
    LAS unsigned long long* PTW = (LAS unsigned long long*)(lds + LDSCTL_OFF + 64);
    if (tid == 0) {
        PTW[0] = (unsigned long long)ka.x;
        PTW[1] = (unsigned long long)ka.c;
        PTW[2] = (unsigned long long)ka.ctx;
        PTW[3] = (unsigned long long)ka.c_ctx;
        PTW[4] = (unsigned long long)ka.w_mod;
        PTW[5] = (unsigned long long)ka.b_mod;
        PTW[6] = (unsigned long long)ka.g_mix;
        PTW[7] = (unsigned long long)ka.g_ffn;
        PTW[8] = (unsigned long long)ka.w_in;
        PTW[9] = (unsigned long long)ka.w_out;
        PTW[10] = (unsigned long long)ka.lq1;
        PTW[11] = (unsigned long long)ka.lk1;
        PTW[12] = (unsigned long long)ka.lq2;
        PTW[13] = (unsigned long long)ka.lk2;
        PTW[14] = (unsigned long long)ka.g_subln;
        PTW[15] = (unsigned long long)ka.ln_g;
        PTW[16] = (unsigned long long)ka.ln_b;
        PTW[17] = (unsigned long long)ka.w_sp;
        PTW[18] = (unsigned long long)ka.b_sp;
        PTW[19] = (unsigned long long)ka.w_fo;
        PTW[20] = (unsigned long long)ka.w_r;
        PTW[21] = (unsigned long long)ka.w_gate;
        PTW[22] = (unsigned long long)ka.w_up;
        PTW[23] = (unsigned long long)ka.w_down;
        PTW[24] = (unsigned long long)ka.g_final;
        PTW[25] = (unsigned long long)ka.out; PTW[26] = (unsigned long long)ka.ws;
    }
    __syncthreads();
    XcdBarrier bar; bar.bar = (unsigned*)(ka.ws + WS_CTL); bar.x = 0; bar.st = nullptr;
    if (hi - lo > 1) bar = xcd_barrier_post((unsigned*)(ka.ws + WS_CTL), (volatile LAS unsigned*)(lds + LDSCTL_OFF));
#ifndef PHMASK
#define PHMASK 0xFFFFFFu
#endif
#define IN(k) (((PHMASK >> ((k) == 21 ? 3 : (k) == 22 ? 10 : (k))) & 1u) && lo <= ((k) == 21 ? 3 : (k) == 22 ? 10 : (k)) && ((k) == 21 ? 3 : (k) == 22 ? 10 : (k)) < hi)
#define SEAM(k) do { if (IN(k) && IN((k) + 1)) xcd_barrier(bar); } while (0)
#ifndef TPROBE
#define TPROBE -1
#endif
#ifndef TSIDE
#define TSIDE 0
#endif
#ifndef TAMP
#define TAMP 9
#endif
#define RUNPH(k, call) do { if (IN(k)) { if (TPROBE == (k)) { const unsigned long long t0_ = __builtin_amdgcn_s_memrealtime(); call; __syncthreads(); \
        const unsigned long long t1_ = __builtin_amdgcn_s_memrealtime(); const bool on_ = TSIDE == 0 || (TSIDE == 1 ? (int)blockIdx.x < (int)gridDim.x / 2 : (int)blockIdx.x >= (int)gridDim.x / 2); \
        if (on_) { const unsigned long long end_ = t1_ + (unsigned long long)TAMP * (t1_ - t0_); while (__builtin_amdgcn_s_memrealtime() < end_) __builtin_amdgcn_s_sleep(8); } } else { call; } } } while (0)
    RUNPH(0, ph_prologue());             SEAM(0);
    RUNPH(1, ph_hcat());                 SEAM(1);
    RUNPH(2, ph_win());                  SEAM(2);
    RUNPH(3, ph_attn());                 RUNPH(21, ph_sgu()); SEAM(3);
    RUNPH(4, ph_wout());                 SEAM(4);
    RUNPH(5, ph_router(0));              SEAM(5);
    RUNPH(6, ph_topk(0));                if (IN(6) && IN(8)) xcd_barrier(bar);
    RUNPH(8, ph_gateup(0));              SEAM(8);
    RUNPH(9, ph_down(0));                SEAM(9);
    RUNPH(10, ph_combine(0));            SEAM(10);
    RUNPH(11, ph_stepa());               SEAM(11);
    RUNPH(12, ph_dft());                 SEAM(12);
    RUNPH(13, ph_wfo());                 SEAM(13);
    RUNPH(14, ph_router(1));             SEAM(14);
    RUNPH(15, ph_topk(1));               if (IN(15) && IN(17)) xcd_barrier(bar);
    RUNPH(17, ph_gateup(1));             SEAM(17);
    RUNPH(18, ph_down(1));               SEAM(18);
    RUNPH(19, ph_combine(1));
#undef RUNPH
#undef IN
#undef SEAM
}

extern "C" void kernel_launch(void* const* d_in, const int* in_sizes, int n_in, void* d_out, int out_size, void* d_ws, size_t ws_size, hipStream_t stream) {
    static int grid = 0;
    if (grid == 0) {
        if (n_in != 25 || in_sizes[0] != SEQ * DM || out_size != SEQ * DM || ws_size < WS_END) {
            fprintf(stderr, "kernel_launch: unexpected shapes: n_in %d in0 %d out %d ws %zu (need %zu)\n", n_in, n_in > 0 ? in_sizes[0] : -1, out_size, ws_size, (size_t)WS_END); grid = -1; return; }
        int dev = 0, cus = 0, per_cu = 0;
        if (hipGetDevice(&dev) != hipSuccess || hipDeviceGetAttribute(&cus, hipDeviceAttributeMultiprocessorCount, dev) != hipSuccess) { grid = -1; return; }
        if (hipFuncSetAttribute((const void*)fwd, hipFuncAttributeMaxDynamicSharedMemorySize, LDS_BYTES) != hipSuccess) { fprintf(stderr, "kernel_launch: hipFuncSetAttribute failed\n"); grid = -1; return; }
        if (hipOccupancyMaxActiveBlocksPerMultiprocessor(&per_cu, (const void*)fwd, NTHR, LDS_BYTES) != hipSuccess || per_cu < 1) fprintf(stderr, "kernel_launch: occupancy query says %d\n", per_cu);
        (void)hipGetLastError();
        grid = cus;
    }
    if (grid < 0) return;
    (void)hipMemsetAsync((char*)d_ws + WS_CTL, 0, CTL_BYTES, stream);
    Args a{};
    const float** p = (const float**)&a;
    for (int i = 0; i < 25; ++i) p[i] = (const float*)d_in[i];
    a.out = (float*)d_out; a.ws = (unsigned char*)d_ws;
#ifndef ONE_LAUNCH
    for (int ph = 0; ph < NPH; ++ph) { a.lo = ph; a.hi = ph + 1; hipLaunchKernelGGL(fwd, dim3(grid), dim3(NTHR), LDS_BYTES, stream, a); }
#else
    a.lo = 0; a.hi = NPH; hipLaunchKernelGGL(fwd, dim3(grid), dim3(NTHR), LDS_BYTES, stream, a);
#endif
    const hipError_t le = hipPeekAtLastError();
    if (le != hipSuccess) fprintf(stderr, "kernel_launch: launch failed: %s\n", hipGetErrorName(le));
}
```

```cpp
#include <hip/hip_runtime.h>
#include <hip/hip_bf16.h>
#include <cstdio>
#include <cstdint>
#define ONE_LAUNCH 1

#define GAS __attribute__((address_space(1)))
#define LAS __attribute__((address_space(3)))
typedef unsigned short bf16_t;
typedef short bf16x8 __attribute__((ext_vector_type(8)));
typedef short s16x4 __attribute__((ext_vector_type(4)));
typedef float f32x2 __attribute__((ext_vector_type(2)));
typedef float f32x4 __attribute__((ext_vector_type(4)));
typedef float f32x16 __attribute__((ext_vector_type(16)));
typedef unsigned u32x2 __attribute__((ext_vector_type(2)));
typedef _Float16 f16x4 __attribute__((ext_vector_type(4)));
typedef unsigned u32x4 __attribute__((ext_vector_type(4)));
typedef _Float16 f16x8 __attribute__((ext_vector_type(8)));

constexpr int DM = 2048, SEQ = 8192, CTXL = 256, MC = SEQ + CTXL, INC = 5120, NE = 16, CAP = 1024, FE = 1024, MR = NE * CAP;
constexpr float EPS = 1e-6f;
constexpr int NWAVES = 8, NTHR = 512;
constexpr int NPH = 20;

constexpr size_t al256(size_t x) { return (x + 255) / 256 * 256; }
constexpr size_t WS_CTL = 0, CTL_BYTES = 65536;
constexpr size_t WS_MODL = WS_CTL + CTL_BYTES;
constexpr size_t WS_MODC = WS_MODL + 2 * 12288 * 4;
constexpr size_t WS_ROPE = WS_MODC + 4096 * 4;
constexpr size_t WS_CS = WS_ROPE + 2 * 128 * 16 * 4;
constexpr size_t WS_WIN = WS_CS + 1024 * 512 * 2;
constexpr size_t WS_WOUT = WS_WIN + (size_t)INC * DM * 2;
constexpr size_t WS_WFO = WS_WOUT + (size_t)DM * DM * 2;
constexpr size_t WGU_BYTES = (size_t)NE * 2048 * DM * 2, WD_BYTES = (size_t)NE * DM * FE * 2;
constexpr size_t WS_WGU = WS_WFO + (size_t)DM * DM * 2;
constexpr size_t WS_WD = WS_WGU + 2 * WGU_BYTES;
constexpr size_t WS_HCAT = WS_WD + 2 * WD_BYTES;
constexpr size_t WS_Q = WS_HCAT + (size_t)MC * DM * 2;
constexpr size_t WS_K = WS_Q + (size_t)MC * 1024 * 2;
constexpr size_t WS_V = WS_K + (size_t)MC * 1024 * 2;
constexpr size_t WS_UV = WS_V + (size_t)MC * 1024 * 2;
constexpr size_t WS_CAT = WS_UV + (size_t)MC * DM * 2;
constexpr size_t WS_X = WS_CAT + (size_t)SEQ * DM * 2;
constexpr size_t WS_H2 = WS_X + (size_t)SEQ * DM * 4;
constexpr size_t WS_AFF = WS_H2 + (size_t)SEQ * DM * 2;
constexpr size_t WS_IDX = WS_AFF + (size_t)NE * SEQ * 4;
constexpr size_t WS_GATE = WS_IDX + (size_t)MR * 4;
constexpr size_t WS_POS = WS_GATE + (size_t)MR * 4;
constexpr size_t WS_XS = WS_POS + (size_t)NE * SEQ * 4;
constexpr size_t WS_WRP = WS_XS;
constexpr size_t WS_WRB = WS_WRP + 2 * 2 * 4096 * 16;
constexpr size_t WS_ACT = WS_XS + (size_t)MR * DM * 2;
constexpr size_t WS_Y = WS_ACT + (size_t)MR * FE * 2;
constexpr size_t WS_WCT = WS_Y + (size_t)MR * DM * 2;
constexpr size_t WS_F = WS_WCT + (size_t)4096 * 8192 * 2;
constexpr size_t WS_A1 = WS_F + (size_t)SEQ * DM * 2;
constexpr size_t WS_A2 = WS_A1 + 128 * 128 * 2;
constexpr size_t WS_TW = WS_A2 + 128 * 256 * 2;
constexpr size_t WS_END = WS_TW + 64 * 128 * 2 * 4;

constexpr int LDS_BYTES = 147456, LDSCTL_OFF = 146944;

__device__ __forceinline__ unsigned f2bf(float f) { unsigned u = __builtin_bit_cast(unsigned, f); return (u + 0x7fffu + ((u >> 16) & 1u)) >> 16; }
__device__ __forceinline__ unsigned pk2(float lo, float hi) { return f2bf(lo) | (f2bf(hi) << 16); }
__device__ __forceinline__ float bflo(unsigned w) { return __builtin_bit_cast(float, w << 16); }
__device__ __forceinline__ float bfhi(unsigned w) { return __builtin_bit_cast(float, w & 0xffff0000u); }
__device__ __forceinline__ unsigned cvt2_bf16(float lo, float hi) { unsigned r; asm("v_cvt_pk_bf16_f32 %0, %1, %2" : "=v"(r) : "v"(lo), "v"(hi)); return r; }
__device__ __forceinline__ unsigned cvt_pk_bf16(float lo, float hi) { unsigned r; asm volatile("v_cvt_pk_bf16_f32 %0, %1, %2" : "=v"(r) : "v"(lo), "v"(hi)); return r; }
__device__ __forceinline__ float dpp_f(float v, int ctrl_sel) {
    const int x = __builtin_bit_cast(int, v);
    int r;
    switch (ctrl_sel) {
        case 0: r = __builtin_amdgcn_update_dpp(0, x, 0xB1, 0xF, 0xF, true); break;
        case 1: r = __builtin_amdgcn_update_dpp(0, x, 0x4E, 0xF, 0xF, true); break;
        case 2: r = __builtin_amdgcn_update_dpp(0, x, 0x141, 0xF, 0xF, true); break;
        default: r = __builtin_amdgcn_update_dpp(0, x, 0x140, 0xF, 0xF, true); break;
    }
    return __builtin_bit_cast(float, r);
}
__device__ __forceinline__ float wave_sum(float v) {
    v += dpp_f(v, 0); v += dpp_f(v, 1); v += dpp_f(v, 2); v += dpp_f(v, 3);
    { auto rr = __builtin_amdgcn_permlane16_swap(__float_as_uint(v), __float_as_uint(v), false, false); v = __uint_as_float(rr[0]) + __uint_as_float(rr[1]); }
    { auto rr = __builtin_amdgcn_permlane32_swap(__float_as_uint(v), __float_as_uint(v), false, false); v = __uint_as_float(rr[0]) + __uint_as_float(rr[1]); }
    return v;
}
__device__ __forceinline__ f32x4 ldx4(const _Float16* p) { return __builtin_convertvector(*(const f16x4*)p, f32x4); }
__device__ __forceinline__ void stx4(_Float16* p, f32x4 v) { *(f16x4*)p = __builtin_convertvector(v, f16x4); }
__device__ __forceinline__ float wave_max(float v) {
#pragma unroll
    for (int o = 1; o < 64; o <<= 1) v = fmaxf(v, __shfl_xor(v, o));
    return v;
}

#define XB_TMO      128
#define XB_XCNT(j)  (256  + 64 * (j))
#define XB_XSUB(j)  (1280 + 64 * (j))
#define XB_XGEN(j)  (2304 + 64 * (j))
#define XB_TOP      3328
#define XB_TOPGEN   3392
#define XCD_BAR_WORDS 3456
#define XB_SPIN_CAP (1u << 18)
__device__ __forceinline__ unsigned xb_ld(unsigned* p)              { return __hip_atomic_load(p, __ATOMIC_RELAXED, __HIP_MEMORY_SCOPE_AGENT); }
__device__ __forceinline__ unsigned xb_add(unsigned* p, unsigned v) { return __hip_atomic_fetch_add(p, v, __ATOMIC_RELAXED, __HIP_MEMORY_SCOPE_AGENT); }
__device__ __forceinline__ unsigned xb_xcc_id() { return (unsigned)__builtin_amdgcn_s_getreg((3 << 11) | 20) & 0xFu; }
#define XB_SPIN(cond, bar) do { unsigned _sp = 0; while (cond) { __builtin_amdgcn_s_sleep(1); \
    if ((++_sp & 255u) == 0u) { if (xb_ld(&(bar)[XB_TMO])) break; if (_sp > XB_SPIN_CAP) { atomicAdd(&(bar)[XB_TMO], 1u); break; } } } } while (0)
struct XcdBarrier { unsigned* bar; unsigned x; volatile LAS unsigned* st; };
__device__ __forceinline__ XcdBarrier xcd_barrier_post(unsigned* bar, volatile LAS unsigned* st) {
    XcdBarrier b; b.bar = bar; b.x = xb_xcc_id(); b.st = st;
    if (threadIdx.x == 0) (void)xb_add(&bar[XB_XCNT(b.x)], 1u);
    return b;
}
__device__ __forceinline__ void xcd_barrier_complete(unsigned* bar, unsigned x, unsigned& nloc, unsigned& nx) {
    const unsigned G = gridDim.x * gridDim.y * gridDim.z;
    unsigned sum, cnt, mine, sp = 0u;
    for (;;) {
        sum = 0u; cnt = 0u; mine = 0u;
#pragma unroll
        for (unsigned j = 0; j < 16; ++j) { const unsigned c = xb_ld(&bar[XB_XCNT(j)]); sum += c; cnt += (c > 0u) ? 1u : 0u; mine = (j == x) ? c : mine; }
        if (sum == G) break;
        __builtin_amdgcn_s_sleep(1);
        if ((++sp & 255u) == 0u) { if (xb_ld(&bar[XB_TMO])) break; if (sp > XB_SPIN_CAP) { atomicAdd(&bar[XB_TMO], 1u); break; } }
    }
    nloc = mine > 0u ? mine : 1u; nx = cnt > 0u ? cnt : 1u;
}
__device__ __forceinline__ void xcd_barrier(const XcdBarrier& b) {
    asm volatile("s_waitcnt vmcnt(0)" ::: "memory");
    __syncthreads();
    if (threadIdx.x == 0) {
        unsigned* bar = b.bar;
        __builtin_amdgcn_s_waitcnt(0);
        unsigned nloc = b.st[0], nx = b.st[1];
        if (nloc == 0u) { xcd_barrier_complete(bar, b.x, nloc, nx); b.st[0] = nloc; b.st[1] = nx; }
        const unsigned old = xb_add(&bar[XB_XSUB(b.x)], 1u);
        const unsigned gen = old / nloc;
        if (old + 1u == (gen + 1u) * nloc) {
            __builtin_amdgcn_fence(__ATOMIC_RELEASE, "agent");
            asm volatile("s_waitcnt vmcnt(0)" ::: "memory");
            const unsigned og = xb_add(&bar[XB_TOP], 1u);
            const unsigned tg = og / nx;
            if (og + 1u == (tg + 1u) * nx) xb_add(&bar[XB_TOPGEN], 1u);
            else XB_SPIN(xb_ld(&bar[XB_TOPGEN]) == tg, bar);
            __builtin_amdgcn_fence(__ATOMIC_ACQUIRE, "agent");
            asm volatile("s_waitcnt vmcnt(0)" ::: "memory");
            xb_add(&bar[XB_XGEN(b.x)], 1u);
            asm volatile("s_waitcnt vmcnt(0)" ::: "memory");
        } else {
            XB_SPIN(xb_ld(&bar[XB_XGEN(b.x)]) == gen, bar);
            asm volatile("buffer_inv sc0\n\ts_waitcnt vmcnt(0)" ::: "memory");
        }
    }
    __syncthreads();
}

#define DEP_WORDS(i) (4096 + 512 * (i))
__device__ __forceinline__ void dep_arrive(unsigned* dep, const XcdBarrier& b) {
    asm volatile("s_waitcnt vmcnt(0)" ::: "memory");
    __syncthreads();
    if (threadIdx.x == 0) {
        const unsigned nloc = b.st[0];
        const unsigned old = xb_add(&dep[16 * b.x], 1u);
        if (old + 1u == nloc) { __builtin_amdgcn_fence(__ATOMIC_RELEASE, "agent"); asm volatile("s_waitcnt vmcnt(0)" ::: "memory"); (void)xb_add(&dep[256], 1u); }
    }
}
__device__ __forceinline__ void dep_wait(unsigned* dep, const XcdBarrier& b) {
    if (threadIdx.x == 0) { const unsigned nx = b.st[1]; XB_SPIN(xb_ld(&dep[256]) < nx, b.bar); __builtin_amdgcn_fence(__ATOMIC_ACQUIRE, "agent"); asm volatile("s_waitcnt vmcnt(0)" ::: "memory"); }
    __syncthreads();
}

namespace pg8 {
constexpr int BM = 256, BK = 64, HALF = 128, HTB = HALF * BK * 2, STAGE_BYTES = 8 * HTB, NXCD = 8, WGM = 8;
__host__ __device__ __forceinline__ int lds_byte(int r, int c) { const int st = (r >> 4) * 2 + (c >> 5), rr = r & 15, cc = c & 31, ob = rr * 64 + cc * 2; return st * 1024 + (ob ^ (((ob >> 9) & 1) << 5)); }
__host__ __device__ __forceinline__ void stage_rc(int b, int& R, int& C) { const int st = b / 1024, sb = b % 1024, swz = sb ^ (((sb >> 9) & 1) << 5); R = (st >> 1) * 16 + swz / 64; C = (st & 1) * 32 + (swz % 64) / 2; }
__host__ __device__ __forceinline__ int perm32(int rho) { const int n = rho >> 4, i = rho & 15; return 8 * (i >> 2) + 4 * n + (i & 3); }

struct Unit { int pm, pn, aux; };
struct Geo {
    const char* A; const char* B;
    unsigned lda2, ldb2, kA, kB;
    size_t hA, hB, tA, tB, aA, aB;
    int nt, amode, bmode;
    __device__ __forceinline__ size_t offA(const Unit& u) const { return (size_t)u.pm * tA + (size_t)u.aux * aA; }
    __device__ __forceinline__ size_t offB(const Unit& u) const { return (size_t)u.pn * tB + (size_t)u.aux * aB; }
};
__device__ __forceinline__ Geo geo_rowmajor(const void* A, int lda, const void* B, int ldb, int K) {
    Geo g; g.A = (const char*)A; g.B = (const char*)B; g.lda2 = lda * 2; g.ldb2 = ldb * 2; g.kA = 128; g.kB = 128;
    g.hA = (size_t)128 * lda * 2; g.hB = (size_t)128 * ldb * 2; g.tA = 2 * g.hA; g.tB = 2 * g.hB; g.aA = 0; g.aB = 0; g.nt = K / 64; g.amode = 0; g.bmode = 0; return g;
}

struct StaticOrder {
    int nM, nN, nwg, G, c;
    __device__ void init(int M, int N, int G_, int c_) { nM = M / BM; nN = N / BM; nwg = nM * nN; G = G_; c = c_; }
    __device__ bool next(int i, Unit& u) const {
        const long L = (long)i * G + c; if (L >= nwg) return false;
        int wgid = (int)L; { const int q = nwg / NXCD, r = nwg % NXCD, xcd = wgid % NXCD, off = wgid / NXCD; wgid = (xcd < r ? xcd * (q + 1) : r * (q + 1) + (xcd - r) * q) + off; }
        const int nig = WGM * nN, gid = wgid / nig, fm = gid * WGM, gsz = (nM - fm) < WGM ? (nM - fm) : WGM;
        u.pm = fm + ((wgid % nig) % gsz); u.pn = (wgid % nig) / gsz; u.aux = 0; return true;
    }
    __device__ __forceinline__ void a_ready(const Unit&) const {}
    __device__ __forceinline__ void done(const Unit&) const {}
};
struct WinOrder : StaticOrder {
    __device__ void init_win(int G_, int c_) { init(SEQ, INC, G_, c_); }
    __device__ int total() const { return nwg + 8; }
    __device__ bool next(int i, Unit& u) const {
        const long L = (long)i * G + c;
        if (L < nwg) { StaticOrder::next(i, u); u.pm += 1; return true; }
        if (L < nwg + 8) { u.pm = 0; u.pn = 4 + (int)(L - nwg); u.aux = 0; return true; }
        return false; }
};
struct MoeOrder : StaticOrder {
    __device__ bool next(int i, Unit& u) const { if (!StaticOrder::next(i, u)) return false; u.aux = u.pm >> 2; return true; }
};
struct StepAOrder {
    int G, c;
    __device__ bool next(int i, Unit& u) const { const int L = i * G + c; if (L >= 256) return false; u.aux = L >> 6; const int r = L & 63; u.pm = r & 1; u.pn = r >> 1; return true; }
    __device__ __forceinline__ void a_ready(const Unit&) const {}
    __device__ __forceinline__ void done(const Unit&) const {}
};

template <class Epi, class Sched, bool ALIGN_EPI, bool SP2, bool GATHER = false>
__device__ __forceinline__ void gemm_phase(LAS unsigned char* lds, const Geo g, const Sched& S, const Epi& E, const int* gidx = nullptr) {
    const int tid = threadIdx.x, wid = __builtin_amdgcn_readfirstlane(tid >> 6), lane = tid & 63, wr = wid >> 2, wc = wid & 3, fr = lane & 15, fq = lane >> 4;
    const int nt = g.nt;
    unsigned voffA[2], voffB[2], voffA1[2], nvA0[2], nvA1[2]; int gR[2]; unsigned gC[2];
#pragma unroll
    for (int i = 0; i < 2; ++i) { int R, C; stage_rc(tid * 16 + i * 8192, R, C); const int Rb = Epi::PERM ? ((R & ~31) + perm32(R & 31)) : R; gR[i] = R; gC[i] = (unsigned)C * 2u;
        voffA[i] = g.amode ? (unsigned)(C >> 3) * 131072u + (unsigned)R * 16u : (unsigned)R * g.lda2 + (unsigned)C * 2u;
        voffB[i] = (unsigned)(g.bmode ? ((Rb & 63) * 128 + (Rb >> 6)) : Rb) * g.ldb2 + (unsigned)C * 2u; }
    const size_t kA = g.kA, kB = g.kB, hA = g.hA, hB = g.hB;
    const unsigned ldsw = (unsigned)wid * 1024u;
    const int aoff = lds_byte(wr * 64 + fr, fq * 8), boff = lds_byte(wc * 32 + fr, fq * 8);
#define PG8_GIDX(dst0, dst1, u) do { _Pragma("unroll") for (int _i = 0; _i < 2; ++_i) { \
        dst0[_i] = (unsigned)gidx[(u).pm * BM + gR[_i]] * g.lda2 + gC[_i]; dst1[_i] = (unsigned)gidx[(u).pm * BM + HALF + gR[_i]] * g.lda2 + gC[_i]; } } while (0)
#define PG8_SA(b, h) (((b) * 2 + (h)) * HTB)
#define PG8_SB(b, h) ((4 + (b) * 2 + (h)) * HTB)
#define PG8_STAGE(bufoff, gbase, voff) do { _Pragma("unroll") for (int _i = 0; _i < 2; ++_i) \
        __builtin_amdgcn_global_load_lds((const unsigned*)((const char*)(gbase) + (voff)[_i]), (LAS unsigned*)(lds + (bufoff) + ldsw + _i * 8192), 16, 0, 0); } while (0)
#define PG8_LDA(dst, b, h) do { _Pragma("unroll") for (int m = 0; m < 4; ++m) _Pragma("unroll") for (int k = 0; k < 2; ++k) dst[m][k] = *(const LAS bf16x8*)(lds + PG8_SA(b, h) + aoff + m * 2048 + k * 1024); } while (0)
#define PG8_LDB(dst, b, h) do { _Pragma("unroll") for (int n = 0; n < 2; ++n) _Pragma("unroll") for (int k = 0; k < 2; ++k) dst[n][k] = *(const LAS bf16x8*)(lds + PG8_SB(b, h) + boff + n * 2048 + k * 1024); } while (0)
#define PG8_MMA(ai, bj, At, Bt) do { __builtin_amdgcn_s_setprio(1); _Pragma("unroll") for (int m = 0; m < 4; ++m) _Pragma("unroll") for (int n = 0; n < 2; ++n) _Pragma("unroll") for (int k = 0; k < 2; ++k) \
        acc[ai][bj][m][n] = __builtin_amdgcn_mfma_f32_16x16x32_bf16(Bt[n][k], At[m][k], acc[ai][bj][m][n], 0, 0, 0); __builtin_amdgcn_s_setprio(0); } while (0)
#define PG8_WAIT_V(n) asm volatile("s_waitcnt vmcnt(" #n ")" ::: "memory")
#define PG8_WAIT_L(n) asm volatile("s_waitcnt lgkmcnt(" #n ")" ::: "memory")
#define PG8_BAR __builtin_amdgcn_s_barrier()
#define PG8_SCHED __builtin_amdgcn_sched_barrier(0)
    Unit cur, nxt; int ui = 0;
    if (!S.next(0, cur)) return;
    f32x4 acc[2][2][4][2];
#pragma unroll
    for (int a = 0; a < 2; ++a)
#pragma unroll
        for (int b = 0; b < 2; ++b)
#pragma unroll
            for (int m = 0; m < 4; ++m)
#pragma unroll
                for (int n = 0; n < 2; ++n) acc[a][b][m][n] = (f32x4){0.f, 0.f, 0.f, 0.f};
    bf16x8 At[4][2], B0[2][2], B1[2][2];
    const char* cA = g.A + g.offA(cur); const char* cB = g.B + g.offB(cur);
    S.a_ready(cur);
    if constexpr (GATHER) { PG8_GIDX(voffA, voffA1, cur); } else { voffA1[0] = voffA[0]; voffA1[1] = voffA[1]; }
    if constexpr (SP2) {
        PG8_STAGE(PG8_SB(0, 0), cB, voffB); PG8_STAGE(PG8_SB(0, 1), cB + hB, voffB); PG8_STAGE(PG8_SA(0, 0), cA, voffA); PG8_STAGE(PG8_SA(0, 1), cA + hA, voffA1);
        if (wr == 1) PG8_BAR;
        PG8_WAIT_V(2); PG8_BAR;
        PG8_STAGE(PG8_SB(1, 0), cB + kB, voffB); PG8_STAGE(PG8_SA(1, 0), cA + kA, voffA); PG8_STAGE(PG8_SB(1, 1), cB + hB + kB, voffB);
        PG8_WAIT_V(6); PG8_BAR;
    } else {
        PG8_STAGE(PG8_SB(0, 0), cB, voffB); PG8_STAGE(PG8_SA(0, 0), cA, voffA); PG8_STAGE(PG8_SB(0, 1), cB + hB, voffB); PG8_STAGE(PG8_SA(0, 1), cA + hA, voffA1);
        if (wr == 1) PG8_BAR;
        PG8_WAIT_V(4); PG8_BAR;
        PG8_STAGE(PG8_SB(1, 0), cB + kB, voffB); PG8_STAGE(PG8_SA(1, 0), cA + kA, voffA); PG8_STAGE(PG8_SB(1, 1), cB + hB + kB, voffB);
        PG8_WAIT_V(6); PG8_BAR;
    }
    for (;;) {
        const bool has_next = S.next(ui + 1, nxt);
        const char* nA = has_next ? g.A + g.offA(nxt) : cA; const char* nB = has_next ? g.B + g.offB(nxt) : cB;
        if constexpr (GATHER) { if (has_next) { PG8_GIDX(nvA0, nvA1, nxt); } else { nvA0[0] = voffA[0]; nvA0[1] = voffA[1]; nvA1[0] = voffA1[0]; nvA1[1] = voffA1[1]; } }
        for (int t = 0; t < nt; t += 2) {
            const bool last = (t == nt - 2);
            unsigned sA0[2], sA1[2];
            if constexpr (GATHER) { sA0[0] = last ? nvA0[0] : voffA[0]; sA0[1] = last ? nvA0[1] : voffA[1]; sA1[0] = last ? nvA1[0] : voffA1[0]; sA1[1] = last ? nvA1[1] : voffA1[1]; }
            else { sA0[0] = voffA[0]; sA0[1] = voffA[1]; sA1[0] = voffA[0]; sA1[1] = voffA[1]; }
            const char* a1 = cA + (size_t)(t + 1) * kA;
            const char* a2 = last ? nA : cA + (size_t)(t + 2) * kA; const char* b2 = last ? nB : cB + (size_t)(t + 2) * kB;
            const char* a3 = a2 + kA; const char* b3 = b2 + kB;
            if (last && has_next) S.a_ready(nxt);
            if constexpr (SP2) {
            PG8_LDB(B0, 0, 0); PG8_LDB(B1, 0, 1); PG8_SCHED; PG8_LDA(At, 0, 0); PG8_STAGE(PG8_SA(1, 1), a1 + hA, voffA1);
            PG8_WAIT_V(8); PG8_WAIT_L(0); PG8_BAR; PG8_MMA(0, 0, At, B0); PG8_MMA(0, 1, At, B1); PG8_BAR; PG8_SCHED;
            PG8_LDA(At, 0, 1); PG8_STAGE(PG8_SB(0, 0), b2, voffB); PG8_STAGE(PG8_SB(0, 1), b2 + hB, voffB); PG8_STAGE(PG8_SA(0, 0), a2, sA0);
            PG8_WAIT_V(8); PG8_WAIT_L(0); PG8_BAR; PG8_MMA(1, 0, At, B0); PG8_MMA(1, 1, At, B1); PG8_BAR; PG8_SCHED;
            PG8_LDB(B0, 1, 0); PG8_LDB(B1, 1, 1); PG8_SCHED; PG8_LDA(At, 1, 0); PG8_STAGE(PG8_SA(0, 1), a2 + hA, sA1);
            PG8_WAIT_V(8); PG8_WAIT_L(0); PG8_BAR; PG8_MMA(0, 0, At, B0); PG8_MMA(0, 1, At, B1); PG8_BAR; PG8_SCHED;
            PG8_LDA(At, 1, 1); PG8_STAGE(PG8_SB(1, 0), b3, voffB); PG8_STAGE(PG8_SB(1, 1), b3 + hB, voffB); PG8_STAGE(PG8_SA(1, 0), a3, sA0);
            PG8_WAIT_V(8); PG8_WAIT_L(0); PG8_BAR; PG8_MMA(1, 0, At, B0); PG8_MMA(1, 1, At, B1); PG8_BAR; PG8_SCHED;
            } else {
            PG8_LDB(B0, 0, 0); PG8_SCHED; PG8_LDA(At, 0, 0); PG8_STAGE(PG8_SA(1, 1), a1 + hA, voffA1);
            PG8_WAIT_L(8); PG8_BAR; PG8_WAIT_L(0); PG8_MMA(0, 0, At, B0); PG8_BAR; PG8_SCHED;
            PG8_LDB(B1, 0, 1); PG8_STAGE(PG8_SB(0, 0), b2, voffB);
            PG8_BAR; PG8_WAIT_L(0); PG8_MMA(0, 1, At, B1); PG8_BAR;
            PG8_LDA(At, 0, 1); PG8_STAGE(PG8_SA(0, 0), a2, sA0);
            PG8_BAR; PG8_WAIT_L(0); PG8_MMA(1, 0, At, B0); PG8_BAR; PG8_SCHED;
            PG8_STAGE(PG8_SB(0, 1), b2 + hB, voffB);
            PG8_WAIT_V(6); PG8_BAR; PG8_MMA(1, 1, At, B1); PG8_BAR;
            PG8_LDB(B0, 1, 0); PG8_SCHED; PG8_LDA(At, 1, 0); PG8_STAGE(PG8_SA(0, 1), a2 + hA, sA1);
            PG8_WAIT_L(8); PG8_BAR; PG8_WAIT_L(0); PG8_MMA(0, 0, At, B0); PG8_BAR; PG8_SCHED;
            PG8_LDB(B1, 1, 1); PG8_STAGE(PG8_SB(1, 0), b3, voffB);
            PG8_BAR; PG8_WAIT_L(0); PG8_MMA(0, 1, At, B1); PG8_BAR;
            PG8_LDA(At, 1, 1); PG8_STAGE(PG8_SA(1, 0), a3, sA0);
            PG8_BAR; PG8_WAIT_L(0); PG8_MMA(1, 0, At, B0); PG8_BAR; PG8_SCHED;
            PG8_STAGE(PG8_SB(1, 1), b3 + hB, voffB);
            PG8_WAIT_V(6); PG8_BAR; PG8_MMA(1, 1, At, B1); PG8_BAR;
            }
        }
        if constexpr (ALIGN_EPI) { if (wr == 0) PG8_BAR; }
        E(acc, cur, wr, wc, fr, fq); S.done(cur);
        if (!has_next) break;
#pragma unroll
        for (int a = 0; a < 2; ++a)
#pragma unroll
            for (int b = 0; b < 2; ++b)
#pragma unroll
                for (int m = 0; m < 4; ++m)
#pragma unroll
                    for (int n = 0; n < 2; ++n) acc[a][b][m][n] = (f32x4){0.f, 0.f, 0.f, 0.f};
        cur = nxt; cA = nA; cB = nB; ++ui;
        if constexpr (GATHER) { voffA[0] = nvA0[0]; voffA[1] = nvA0[1]; voffA1[0] = nvA1[0]; voffA1[1] = nvA1[1]; }
        if constexpr (ALIGN_EPI) { if (wr == 1) PG8_BAR; }
    }
    PG8_WAIT_V(0);
    if constexpr (!ALIGN_EPI) { if (wr == 0) PG8_BAR; }
    PG8_BAR;
#undef PG8_GIDX
#undef PG8_SA
#undef PG8_SB
#undef PG8_STAGE
#undef PG8_LDA
#undef PG8_LDB
#undef PG8_MMA
#undef PG8_WAIT_V
#undef PG8_WAIT_L
#undef PG8_BAR
#undef PG8_SCHED
}

typedef f32x4 AccT[2][2][4][2];

__device__ __forceinline__ float gelu_tanh(float x) {
    const float z = x * (1.5957691216f + 0.0713548163f * x * x);
    return x * __builtin_amdgcn_rcpf(1.0f + __builtin_amdgcn_exp2f(-1.4426950409f * z));
}
__device__ __forceinline__ u32x2 pack4(f32x4 v) { u32x2 w; w.x = cvt_pk_bf16(v[0], v[1]); w.y = cvt_pk_bf16(v[2], v[3]); return w; }

constexpr float QSCALE = 0.125f * 1.4426950408889634f;
struct EpiWin {
    static constexpr bool PERM = true;
    bf16_t *Q, *K, *V, *UV; const float* ropec; const float* ropes;
    __device__ __forceinline__ void operator()(const AccT& acc, const Unit& u, int wr, int wc, int fr, int fq) const {
        const int sec = u.pn >> 2, row0 = u.pm * BM + wr * 64 + fr;
        if (sec < 2) {
            bf16_t* O = sec == 0 ? Q : K;
            const int colb = (u.pn & 3) * 256 + wc * 32 + 8 * fq; const bool rope = u.pm >= 1; const bool upper = fq >= 2;
#pragma unroll
            for (int ai = 0; ai < 2; ++ai)
#pragma unroll
                for (int m = 0; m < 4; ++m) { const int r = row0 + ai * HALF + m * 16;
                    f32x4 cs[2], sn[2];
#pragma unroll
                    for (int n = 0; n < 2; ++n) { cs[n] = (f32x4){1.f, 1.f, 1.f, 1.f}; sn[n] = (f32x4){0.f, 0.f, 0.f, 0.f}; }
                    if (rope) { const int t = r - CTXL, pos = (wc & 1) ? (t & 63) : (t >> 6);
#pragma unroll
                        for (int n = 0; n < 2; ++n) { cs[n] = *(const f32x4*)(ropec + pos * 16 + 8 * (fq & 1) + 4 * n); const f32x4 s4 = *(const f32x4*)(ropes + pos * 16 + 8 * (fq & 1) + 4 * n); sn[n] = upper ? s4 : -s4; } }
                    bf16_t* rowp = O + (size_t)r * 1024 + colb;
#pragma unroll
                    for (int bj = 0; bj < 2; ++bj) { f32x4 o[2];
#pragma unroll
                        for (int n = 0; n < 2; ++n) { const f32x4 own = acc[ai][bj][m][n]; f32x4 par;
#pragma unroll
                            for (int i = 0; i < 4; ++i) { const auto rr = __builtin_amdgcn_permlane32_swap(__float_as_uint(own[i]), __float_as_uint(own[i]), false, false);
                                par[i] = __uint_as_float(upper ? rr[0] : rr[1]); }
                            o[n] = own * cs[n] + par * sn[n];
                            if (sec == 0) o[n] = o[n] * QSCALE; }
                        const u32x2 w0 = pack4(o[0]), w1 = pack4(o[1]); u32x4 w; w.x = w0.x; w.y = w0.y; w.z = w1.x; w.w = w1.y;
                        *(u32x4*)(rowp + bj * HALF) = w; } }
        } else if (sec == 2) {
            const int colb = (u.pn & 3) * 256 + wc * 32 + 8 * fq;
#pragma unroll
            for (int ai = 0; ai < 2; ++ai)
#pragma unroll
                for (int m = 0; m < 4; ++m) { bf16_t* rowp = V + (size_t)(row0 + ai * HALF + m * 16) * 1024 + colb;
#pragma unroll
                    for (int bj = 0; bj < 2; ++bj) { const u32x2 w0 = pack4(acc[ai][bj][m][0]), w1 = pack4(acc[ai][bj][m][1]); u32x4 w; w.x = w0.x; w.y = w0.y; w.z = w1.x; w.w = w1.y;
                        *(u32x4*)(rowp + bj * HALF) = w; } }
        } else {
            const int colb = (u.pn - 12) * 256 + wc * 32 + 8 * fq;
#pragma unroll
            for (int ai = 0; ai < 2; ++ai)
#pragma unroll
                for (int m = 0; m < 4; ++m) { bf16_t* rowp = UV + (size_t)(row0 + ai * HALF + m * 16) * 2048 + colb;
#pragma unroll
                    for (int bj = 0; bj < 2; ++bj) { f32x4 v0 = acc[ai][bj][m][0], v1 = acc[ai][bj][m][1];
#pragma unroll
                        for (int j = 0; j < 4; ++j) { v0[j] = gelu_tanh(v0[j]); v1[j] = gelu_tanh(v1[j]); }
                        const u32x2 w0 = pack4(v0), w1 = pack4(v1); u32x4 w; w.x = w0.x; w.y = w0.y; w.z = w1.x; w.w = w1.y;
                        *(u32x4*)(rowp + bj * HALF) = w; } }
        }
    }
};
template <bool XIN_F32> struct EpiResidN {
    static constexpr bool PERM = false;
    const void* Xin; _Float16* Xout; const float* gate;
    __device__ __forceinline__ void operator()(const AccT& acc, const Unit& u, int wr, int wc, int fr, int fq) const {
        const int row0 = u.pm * BM + wr * 64 + fr, col0 = u.pn * BM + wc * 32 + 4 * fq;
        f32x4 gv[2][2];
#pragma unroll
        for (int bj = 0; bj < 2; ++bj)
#pragma unroll
            for (int n = 0; n < 2; ++n) gv[bj][n] = *(const f32x4*)(gate + col0 + bj * HALF + n * 16);
#pragma unroll
        for (int ai = 0; ai < 2; ++ai)
#pragma unroll
            for (int m = 0; m < 4; ++m) { const size_t ro = (size_t)(row0 + ai * HALF + m * 16) * DM + col0;
#pragma unroll
                for (int bj = 0; bj < 2; ++bj)
#pragma unroll
                    for (int n = 0; n < 2; ++n) { const size_t o = ro + bj * HALF + n * 16;
                        const f32x4 xi = XIN_F32 ? *(const f32x4*)((const float*)Xin + o) : ldx4((const _Float16*)Xin + o);
                        stx4(Xout + o, xi + gv[bj][n] * acc[ai][bj][m][n]); } }
    }
};
template <bool XIN_F32> struct EpiResid {
    static constexpr bool PERM = true;
    const void* Xin; _Float16* Xout; const float* gate;
    __device__ __forceinline__ void operator()(const AccT& acc, const Unit& u, int wr, int wc, int fr, int fq) const {
        const int row0 = u.pm * BM + wr * 64 + fr, col0 = u.pn * BM + wc * 32 + 8 * fq;
        f32x4 gv[2][2];
#pragma unroll
        for (int bj = 0; bj < 2; ++bj)
#pragma unroll
            for (int n = 0; n < 2; ++n) gv[bj][n] = *(const f32x4*)(gate + col0 + bj * HALF + n * 4);
#pragma unroll
        for (int ai = 0; ai < 2; ++ai)
#pragma unroll
            for (int m = 0; m < 4; ++m) { const size_t ro = (size_t)(row0 + ai * HALF + m * 16) * DM + col0;
#pragma unroll
                for (int bj = 0; bj < 2; ++bj) { const size_t o = ro + bj * HALF; f32x4 x0, x1;
                    if (XIN_F32) { x0 = *(const f32x4*)((const float*)Xin + o); x1 = *(const f32x4*)((const float*)Xin + o + 4); }
                    else { const f16x8 h = *(const f16x8*)((const _Float16*)Xin + o);
                        x0 = __builtin_convertvector(__builtin_shufflevector(h, h, 0, 1, 2, 3), f32x4); x1 = __builtin_convertvector(__builtin_shufflevector(h, h, 4, 5, 6, 7), f32x4); }
                    const f16x4 r0 = __builtin_convertvector(x0 + gv[bj][0] * acc[ai][bj][m][0], f16x4), r1 = __builtin_convertvector(x1 + gv[bj][1] * acc[ai][bj][m][1], f16x4);
                    *(f16x8*)(Xout + o) = __builtin_shufflevector(r0, r1, 0, 1, 2, 3, 4, 5, 6, 7); } }
    }
};
struct EpiBf16 {
    static constexpr bool PERM = true;
    bf16_t* O; int ldc; int aux_rows;
    __device__ __forceinline__ void operator()(const AccT& acc, const Unit& u, int wr, int wc, int fr, int fq) const {
        const int row0 = u.aux * aux_rows + u.pm * BM + wr * 64 + fr, col0 = u.pn * BM + wc * 32 + 8 * fq;
#pragma unroll
        for (int ai = 0; ai < 2; ++ai)
#pragma unroll
            for (int m = 0; m < 4; ++m) { bf16_t* rowp = O + (size_t)(row0 + ai * HALF + m * 16) * ldc + col0;
#pragma unroll
                for (int bj = 0; bj < 2; ++bj) { const f32x4 v0 = acc[ai][bj][m][0], v1 = acc[ai][bj][m][1];
                    u32x4 w; w.x = cvt_pk_bf16(v0[0], v0[1]); w.y = cvt_pk_bf16(v0[2], v0[3]); w.z = cvt_pk_bf16(v1[0], v1[1]); w.w = cvt_pk_bf16(v1[2], v1[3]);
                    *(u32x4*)(rowp + bj * HALF) = w; } }
    }
};
struct EpiGateUp {
    static constexpr bool PERM = true;
    bf16_t* ACT;
    __device__ __forceinline__ void operator()(const AccT& acc, const Unit& u, int wr, int wc, int fr, int fq) const {
        const int row0 = u.pm * BM + wr * 64 + fr, col0 = u.pn * 128 + wc * 32 + 8 * fq;
#pragma unroll
        for (int ai = 0; ai < 2; ++ai)
#pragma unroll
            for (int m = 0; m < 4; ++m) { bf16_t* rowp = ACT + (size_t)(row0 + ai * HALF + m * 16) * FE + col0;
                f32x4 o[2];
#pragma unroll
                for (int n = 0; n < 2; ++n) { const f32x4 gt = acc[ai][0][m][n], up = acc[ai][1][m][n];
#pragma unroll
                    for (int j = 0; j < 4; ++j) o[n][j] = gt[j] * up[j] * __builtin_amdgcn_rcpf(1.0f + __builtin_amdgcn_exp2f(-1.4426950409f * gt[j])); }
                u32x4 w; w.x = cvt_pk_bf16(o[0][0], o[0][1]); w.y = cvt_pk_bf16(o[0][2], o[0][3]); w.z = cvt_pk_bf16(o[1][0], o[1][1]); w.w = cvt_pk_bf16(o[1][2], o[1][3]);
                *(u32x4*)rowp = w; }
    }
};
struct EpiDown {
    static constexpr bool PERM = true;
    bf16_t* Y; const float* gate;
    __device__ __forceinline__ void operator()(const AccT& acc, const Unit& u, int wr, int wc, int fr, int fq) const {
        const int row0 = u.pm * BM + wr * 64 + fr, col0 = u.pn * BM + wc * 32 + 8 * fq;
#pragma unroll
        for (int ai = 0; ai < 2; ++ai)
#pragma unroll
            for (int m = 0; m < 4; ++m) { const int r = row0 + ai * HALF + m * 16; const float gr = gate[r]; bf16_t* rowp = Y + (size_t)r * DM + col0;
#pragma unroll
                for (int bj = 0; bj < 2; ++bj) { const f32x4 v0 = acc[ai][bj][m][0] * gr, v1 = acc[ai][bj][m][1] * gr;
                    u32x4 w; w.x = cvt_pk_bf16(v0[0], v0[1]); w.y = cvt_pk_bf16(v0[2], v0[3]); w.z = cvt_pk_bf16(v1[0], v1[1]); w.w = cvt_pk_bf16(v1[2], v1[3]);
                    *(u32x4*)(rowp + bj * HALF) = w; } }
    }
};
}

namespace att {
__device__ __forceinline__ int crow(int r, int hi) { return (r & 3) + 8 * (r >> 2) + 4 * hi; }
__device__ __forceinline__ void sgu_request(const bf16_t* __restrict__ UV, int chunk, int g, unsigned (&pkv)[16], u32x4 (&uwv)[4]) {
  const int tid = threadIdx.x, wid = tid >> 6, lane = tid & 63;
#pragma unroll
  for (int i = 0; i < 16; ++i) pkv[i] = *(const unsigned*)(UV + (size_t)(CTXL + chunk * 128 + wid * 16 + i) * DM + 1024 + g * 128 + 2 * lane);
#pragma unroll
  for (int i = 0; i < 4; ++i) { const int ch = tid + 512 * i, p = ch >> 4, d0 = (ch & 15) * 8; uwv[i] = *(const u32x4*)(UV + (size_t)(CTXL + chunk * 128 + p) * DM + g * 128 + d0); }
}
__device__ __forceinline__ void sgu_weights(const float* __restrict__ w_sp, int g, f32x4 (&wsv)[16]) {
  const int tid = threadIdx.x, wid = tid >> 6, lane = tid & 63, r32 = lane & 31, hi = lane >> 5, wp = wid >> 1;
  const float* Wg = w_sp + (size_t)g * 128 * 128 + (size_t)(wp * 32 + r32) * 128 + hi * 8;
#pragma unroll
  for (int ks = 0; ks < 8; ++ks) { wsv[2 * ks] = *(const f32x4*)(Wg + ks * 16); wsv[2 * ks + 1] = *(const f32x4*)(Wg + ks * 16 + 4); }
}
__device__ __forceinline__ void sgu_unit(const unsigned (&pkv)[16], const u32x4 (&uwv)[4], const f32x4 (&wsv)[16], bf16_t* __restrict__ CAT, const float* __restrict__ b_sp,
                                         const float* __restrict__ ln_g, const float* __restrict__ ln_b, int chunk, int g, char* lds) {
  const int tid = threadIdx.x, wid = tid >> 6, lane = tid & 63, r32 = lane & 31, hi = lane >> 5;
  bf16_t* vT = (bf16_t*)lds;
  const int wp = wid >> 1, wd = wid & 1;
  { const float lg0 = ln_g[g * 128 + 2 * lane], lg1 = ln_g[g * 128 + 2 * lane + 1], lb0 = ln_b[g * 128 + 2 * lane], lb1 = ln_b[g * 128 + 2 * lane + 1];
#pragma unroll
    for (int i = 0; i < 16; ++i) { const int pos = wid * 16 + i;
      const unsigned pk = pkv[i];
      const float a = bflo(pk), b = bfhi(pk);
      const float mean = wave_sum(a + b) * (1.0f / 128.0f); const float da = a - mean, db = b - mean;
      const float var = wave_sum(da * da + db * db) * (1.0f / 128.0f); const float rstd = 1.0f / sqrtf(var + EPS);
      vT[(2 * lane) * 136 + pos] = (bf16_t)f2bf(da * rstd * lg0 + lb0); vT[(2 * lane + 1) * 136 + pos] = (bf16_t)f2bf(db * rstd * lg1 + lb1); } }
  __syncthreads();
  f32x16 acc[2]; acc[0] = f32x16{}; acc[1] = f32x16{};
#pragma unroll
  for (int ks = 0; ks < 8; ++ks) { const f32x4 w0 = wsv[2 * ks], w1 = wsv[2 * ks + 1];
    u32x4 aw; aw.x = pk2(w0[0], w0[1]); aw.y = pk2(w0[2], w0[3]); aw.z = pk2(w1[0], w1[1]); aw.w = pk2(w1[2], w1[3]);
    const bf16x8 af = __builtin_bit_cast(bf16x8, aw);
#pragma unroll
    for (int nb = 0; nb < 2; ++nb) { const bf16x8 bf = *(const bf16x8*)(vT + (wd * 64 + nb * 32 + r32) * 136 + ks * 16 + hi * 8);
      acc[nb] = __builtin_amdgcn_mfma_f32_32x32x16_bf16(af, bf, acc[nb], 0, 0, 0); } }
  __syncthreads();
  float* mt = (float*)lds;
#pragma unroll
  for (int nb = 0; nb < 2; ++nb) { const int d = wd * 64 + nb * 32 + r32;
#pragma unroll
    for (int r = 0; r < 16; ++r) { const int p = wp * 32 + crow(r, hi); mt[p * 132 + d] = acc[nb][r] + b_sp[g * 128 + p]; } }
  __syncthreads();
#pragma unroll
  for (int i = 0; i < 4; ++i) { const int ch = tid + 512 * i, p = ch >> 4, d0 = (ch & 15) * 8, t = chunk * 128 + p;
    const u32x4 uw = uwv[i];
    const f32x4 m0 = *(const f32x4*)(mt + p * 132 + d0), m1 = *(const f32x4*)(mt + p * 132 + d0 + 4);
    u32x4 o; o.x = pk2(bflo(uw.x) * m0.x, bfhi(uw.x) * m0.y); o.y = pk2(bflo(uw.y) * m0.z, bfhi(uw.y) * m0.w);
    o.z = pk2(bflo(uw.z) * m1.x, bfhi(uw.z) * m1.y); o.w = pk2(bflo(uw.w) * m1.z, bfhi(uw.w) * m1.w);
    *(u32x4*)(CAT + (size_t)t * DM + 1024 + g * 128 + d0) = o; }
  __syncthreads();
}
}


namespace att2 {
using bf16x8_t = bf16x8;
constexpr int NW = 8, QBLK = 32, KVBLK = 64, NSLOT = 3, SLOTB = 16384, DMK = 1024, NT = MC / KVBLK;
constexpr int LDS_K = 0, LDS_V = NSLOT * SLOTB, LDS_WS = 2 * NSLOT * SLOTB, LDS_Q = LDS_WS + NW * 64 * 4, LDS_BYTES_ATT = LDS_Q + NW * 4096;
__device__ __forceinline__ int crow(int r, int hi) { return (r & 3) + 8 * (r >> 2) + 4 * hi; }
#define SBAR() __builtin_amdgcn_sched_barrier(0)
template <int IMM> __device__ __forceinline__ void glds16(const void* sbase, unsigned voff, unsigned lds_dst) { unsigned keep;
  asm volatile("s_mov_b32 %0, m0\n\ts_mov_b32 m0, %3\n\ts_nop 0\n\tglobal_load_lds_dwordx4 %1, %2 offset:%c4\n\ts_mov_b32 m0, %0" : "=&s"(keep) : "v"(voff), "s"(sbase), "s"(lds_dst), "i"(IMM) : "memory"); }
__device__ __forceinline__ float max3f(float a, float b, float c) { float r; asm("v_max3_f32 %0, %1, %2, %3" : "=v"(r) : "v"(a), "v"(b), "v"(c)); return r; }
__device__ __forceinline__ float max2f(float a, float b) { float r; asm("v_max_f32_e32 %0, %1, %2" : "=v"(r) : "v"(a), "v"(b)); return r; }
__device__ __forceinline__ float fadd_s(float a, float b) { float r; asm("v_add_f32_e32 %0, %1, %2" : "=v"(r) : "v"(a), "v"(b)); return r; }
__device__ __forceinline__ float fsub_s(float a, float b) { float r; asm("v_sub_f32_e32 %0, %1, %2" : "=v"(r) : "v"(a), "v"(b)); return r; }
typedef __bf16 bf16x2_t __attribute__((ext_vector_type(2)));
__device__ __forceinline__ unsigned cvtpk_s(float lo, float hi) { f32x2 v = {lo, hi}; bf16x2_t b = __builtin_convertvector(v, bf16x2_t); return __builtin_bit_cast(unsigned, b); }
#define WAIT_BAR(N) asm volatile("s_waitcnt vmcnt(" #N ") lgkmcnt(0)\n\ts_barrier" ::: "memory")
typedef LAS const char* lds_cptr;
typedef short v4i16_t __attribute__((ext_vector_type(4)));
__device__ __forceinline__ void kload8(bf16x8* kf, lds_cptr kp) {
  kf[0] = *(const LAS bf16x8*)(kp);        kf[1] = *(const LAS bf16x8*)(kp + 512);
  kf[2] = *(const LAS bf16x8*)(kp + 2048); kf[3] = *(const LAS bf16x8*)(kp + 2560);
  kf[4] = *(const LAS bf16x8*)(kp + 4096); kf[5] = *(const LAS bf16x8*)(kp + 4608);
  kf[6] = *(const LAS bf16x8*)(kp + 6144); kf[7] = *(const LAS bf16x8*)(kp + 6656);
}
__device__ __forceinline__ void kload2(bf16x8* kf, lds_cptr kp, int j) { kf[2 * j] = *(const LAS bf16x8*)(kp + j * 2048); kf[2 * j + 1] = *(const LAS bf16x8*)(kp + j * 2048 + 512); }
__device__ __forceinline__ s16x4 vtr(lds_cptr p) { return __builtin_bit_cast(s16x4, __builtin_amdgcn_ds_read_tr16_b64_v4i16((LAS v4i16_t*)p)); }
__device__ __forceinline__ float rowmax(const f32x16& p0, const f32x16& p1) {
  float a = max3f(p0[0], p0[1], p1[0]), b = max3f(p0[2], p0[3], p1[1]); a = max3f(a, p1[2], p1[3]);
#pragma unroll
  for (int r = 4; r < 16; r += 4) { a = max3f(a, p0[r], p0[r + 1]); b = max3f(b, p0[r + 2], p0[r + 3]); a = max3f(a, p1[r], p1[r + 1]); b = max3f(b, p1[r + 2], p1[r + 3]); }
  const float m = max2f(a, b);
  auto rr = __builtin_amdgcn_permlane32_swap(__float_as_uint(m), __float_as_uint(m), false, false);
  return max2f(__uint_as_float(rr[0]), __uint_as_float(rr[1]));
}
__device__ __forceinline__ void qkt(f32x16& p0, f32x16& p1, lds_cptr kb, const bf16x8* qr, const f32x16& negm) {
#pragma unroll
  for (int d0 = 0; d0 < 4; ++d0) {
    const bf16x8 b0 = *(const LAS bf16x8*)(kb + d0 * 2048);
    const bf16x8 b1 = *(const LAS bf16x8*)(kb + d0 * 2048 + 512);
    if (d0 == 0) { p0 = __builtin_amdgcn_mfma_f32_32x32x16_bf16(b0, qr[0], negm, 0, 0, 0); p1 = __builtin_amdgcn_mfma_f32_32x32x16_bf16(b1, qr[0], negm, 0, 0, 0); }
    else { p0 = __builtin_amdgcn_mfma_f32_32x32x16_bf16(b0, qr[d0], p0, 0, 0, 0); p1 = __builtin_amdgcn_mfma_f32_32x32x16_bf16(b1, qr[d0], p1, 0, 0, 0); } }
}
__device__ __forceinline__ void pv_last(f32x16* o, int vb, bf16x8 pa0, bf16x8 pa1, bf16x8 pa2, bf16x8 pa3) {
#pragma unroll
  for (int d0 = 0; d0 < 4; ++d0) { s16x4 lo[4], hi[4];
#pragma unroll
    for (int ks = 0; ks < 4; ++ks) {
      asm volatile("ds_read_b64_tr_b16 %0,%1 offset:%c2" : "=&v"(lo[ks]) : "v"(vb), "i"(d0 * 4096 + ks * 1024) : "memory");
      asm volatile("ds_read_b64_tr_b16 %0,%1 offset:%c2" : "=&v"(hi[ks]) : "v"(vb), "i"(d0 * 4096 + ks * 1024 + 512) : "memory"); }
    asm volatile("s_waitcnt lgkmcnt(0)" ::: "memory"); SBAR();
#define PK(k) (bf16x8){lo[k][0], lo[k][1], lo[k][2], lo[k][3], hi[k][0], hi[k][1], hi[k][2], hi[k][3]}
    o[d0] = __builtin_amdgcn_mfma_f32_32x32x16_bf16(pa0, PK(0), o[d0], 0, 0, 0);
    o[d0] = __builtin_amdgcn_mfma_f32_32x32x16_bf16(pa1, PK(1), o[d0], 0, 0, 0);
    o[d0] = __builtin_amdgcn_mfma_f32_32x32x16_bf16(pa2, PK(2), o[d0], 0, 0, 0);
    o[d0] = __builtin_amdgcn_mfma_f32_32x32x16_bf16(pa3, PK(3), o[d0], 0, 0, 0);
#undef PK
  }
}

template <int THRL>
__device__ __forceinline__ void attn_unit(const bf16_t* Q, const bf16_t* __restrict__ K, const bf16_t* __restrict__ V, bf16_t* __restrict__ CAT,
                                          int head, int qb, float lam, float out_scale, const float* __restrict__ g_subln, LAS unsigned char* shm) {
  const int tid = threadIdx.x, lane = tid & 63, r32 = lane & 31, hi = lane >> 5; const int wid = __builtin_amdgcn_readfirstlane(tid >> 6);
  const int comp = wid >> 2, wq = wid & 3;
  if (wid >= 4) __builtin_amdgcn_s_setprio(1);
  const bf16_t* Qw = Q + (size_t)(CTXL + qb * 128 + wq * QBLK) * DMK + head * 128 + comp * 64;
  const bf16_t* Kh = K + head * 128; const bf16_t* Vh = V + head * 128;
  const unsigned lds0 = (unsigned)(uintptr_t)shm;
  LAS float* wsf = (LAS float*)(shm + LDS_WS) + wid * 64;
  const unsigned kvoff = (unsigned)(lane * DMK + wid * 8) * 2u;
  const unsigned vvoff = (unsigned)((16 * (wid & 3) + (lane >> 2)) * DMK + (wid >> 2) * 32 + (lane & 3) * 8) * 2u;
  const unsigned kdst = lds0 + LDS_K + wid * 1024, vdst = lds0 + LDS_V + wid * 1024;
#define DMA_K(t, slot) do { const bf16_t* sb_ = Kh + (long)(t) * KVBLK * DMK; glds16<0>(sb_, kvoff, (unsigned)__builtin_amdgcn_readfirstlane(kdst + (slot))); glds16<0>(sb_ + 64, kvoff, (unsigned)__builtin_amdgcn_readfirstlane(kdst + 8192 + (slot))); } while (0)
#define DMAK1(t, slot) do { glds16<0>(Kh + (long)(t) * KVBLK * DMK, kvoff, (unsigned)__builtin_amdgcn_readfirstlane(kdst + (slot))); SBAR(); } while (0)
#define DMAK2(t, slot) do { glds16<0>(Kh + (long)(t) * KVBLK * DMK + 64, kvoff, (unsigned)__builtin_amdgcn_readfirstlane(kdst + 8192 + (slot))); SBAR(); } while (0)
#define DMAV1(t, slot) do { glds16<0>(Vh + (long)(t) * KVBLK * DMK, vvoff, (unsigned)__builtin_amdgcn_readfirstlane(vdst + (slot))); SBAR(); } while (0)
#define DMAV2(t, slot) do { glds16<0>(Vh + (long)(t) * KVBLK * DMK + 64, vvoff, (unsigned)__builtin_amdgcn_readfirstlane(vdst + 8192 + (slot))); SBAR(); } while (0)
#define DMA_V(t, slot) do { const bf16_t* sb_ = Vh + (long)(t) * KVBLK * DMK; glds16<0>(sb_, vvoff, (unsigned)__builtin_amdgcn_readfirstlane(vdst + (slot))); glds16<0>(sb_ + 64, vvoff, (unsigned)__builtin_amdgcn_readfirstlane(vdst + 8192 + (slot))); } while (0)
  const int vb0 = (int)(lds0 + LDS_V) + ((lane >> 4) & 1) * 32 + (lane & 3) * 8 + (4 * hi + ((lane & 15) >> 2)) * 64;
  bf16x8 kf[8];
  const lds_cptr shm3 = (lds_cptr)shm; const lds_cptr kp0 = shm3 + LDS_K + comp * 8192 + hi * 1024 + r32 * 16;
  const lds_cptr vp0 = shm3 + LDS_V + ((lane >> 4) & 1) * 32 + (lane & 3) * 8 + (4 * hi + ((lane & 15) >> 2)) * 64;
  DMA_K(0, 0); DMA_V(0, 0); DMA_K(1, SLOTB);
  bf16x8 qr[4];
#pragma unroll
  for (int d0 = 0; d0 < 4; ++d0) qr[d0] = *reinterpret_cast<const bf16x8*>(&Qw[(long)r32 * DMK + d0 * 16 + hi * 8]);
  float mhat = 0.f, l_reg = 0.f; f32x16 o[4]; o[0] = f32x16{}; o[1] = f32x16{}; o[2] = f32x16{}; o[3] = f32x16{}; f32x16 negm = f32x16{}; asm volatile("" : "+v"(negm));
  bool resc = false;
#define START(P0, P1) do { const float rm = rowmax(P0, P1); resc = false; \
    { const float dl = rm; mhat = fadd_s(mhat, dl); \
      _Pragma("unroll") for (int r = 0; r < 16; ++r) { P0[r] = fsub_s(P0[r], dl); P1[r] = fsub_s(P1[r], dl); } \
      _Pragma("unroll") for (int r = 0; r < 16; ++r) negm[r] = -mhat; asm volatile("" : "+v"(negm)); } \
    _Pragma("unroll") for (int r = 0; r < 16; ++r) P0[r] = __builtin_amdgcn_exp2f(P0[r]); } while (0)
#define RESC() do { if (resc) { asm volatile("s_waitcnt lgkmcnt(0)" ::: "memory"); \
      _Pragma("unroll") for (int d_ = 0; d_ < 4; ++d_) _Pragma("unroll") for (int r = 0; r < 16; ++r) o[d_][r] *= wsf[crow(r, hi)]; } } while (0)
  f32x16 pA0, pA1, pB0, pB1;
  int sl_prev = 0, sl_cur = 0, sl_next = SLOTB;
#define ROT() do { sl_prev = sl_cur; sl_cur = sl_next; sl_next = (sl_next == (NSLOT - 1) * SLOTB) ? 0 : sl_next + SLOTB; } while (0)
  DMA_K(2, 2 * SLOTB);
  WAIT_BAR(6);
  qkt(pA0, pA1, kp0, qr, negm); asm volatile("s_nop 15\n\ts_nop 7" : "+v"(pA0), "+v"(pA1));
  const lds_cptr qp = shm3 + LDS_Q + wid * 4096 + lane * 16;
#pragma unroll
  for (int d0 = 0; d0 < 4; ++d0) *(LAS bf16x8*)(shm + LDS_Q + wid * 4096 + lane * 16 + d0 * 1024) = qr[d0];
  START(pA0, pA1);
#pragma unroll
  for (int r = 0; r < 16; ++r) pA1[r] = __builtin_amdgcn_exp2f(pA1[r]);
  WAIT_BAR(0);
  DMA_K(3, 0); DMA_V(1, SLOTB);
  ROT();
  kload8(kf, kp0 + sl_cur);
  WAIT_BAR(4);
  s16x4 vlo[4], vhi[4]; u32x4 pw0, pw1, pw2, pw3;
#define PKW(P, B) cvtpk_s(P[B], P[B + 1])
#define PAF(k) __builtin_bit_cast(bf16x8, pw##k)
#define VFR(i) (bf16x8){vlo[i][0], vlo[i][1], vlo[i][2], vlo[i][3], vhi[i][0], vhi[i][1], vhi[i][2], vhi[i][3]}
#define PIN(x) asm volatile("" : "+v"(x))
#define MX3(a, b, c) __builtin_fmaxf(__builtin_fmaxf((a), (b)), (c))
#define GAPA(MF, A0, A1, A2, A3, W0, W1, PW) do { MF; sacc += A0; sacc += A1; sacc += A2; sacc += A3; PIN(sacc); W0; W1; PIN(PW); SBAR(); } while (0)
#define EX(v) __builtin_amdgcn_exp2f(v)
#define GAPB(MF, X, B) do { MF; X[B] = EX(X[B]); X[B + 1] = EX(X[B + 1]); PIN(X); } while (0)
#define VRD(s) do { vlo[(s) & 3] = vtr(vp_ + (((s) & 3) * 4096 + ((s) >> 2) * 1024)); vhi[(s) & 3] = vtr(vp_ + (((s) & 3) * 4096 + ((s) >> 2) * 1024 + 512)); } while (0)
#define KRD(G, j) do { if (G) { kload2(kf, kp0 + sl_next, j); SBAR(); } } while (0)
#define PVS(s, PA, X, B) do { GAPB(o[(s) & 3] = __builtin_amdgcn_mfma_f32_32x32x16_bf16(PA, VFR((s) & 3), o[(s) & 3], 0, 0, 0), X, B); if ((s) + 4 < 16) { VRD((s) + 4); } SBAR(); } while (0)
#define STEP(C0, C1, P0, P1, t, GK, GV, GL) do { SBAR(); \
    const lds_cptr vp_ = vp0 + sl_prev; \
    float sacc = (P0[0] + P0[1]); bf16x8 qa = *(const LAS bf16x8*)(qp), qb_; \
    GAPA(C0 = __builtin_amdgcn_mfma_f32_32x32x16_bf16(kf[0], qa, negm, 0, 0, 0), P0[2], P0[3], P0[4], P0[5],     pw0[0] = PKW(P0, 0), pw0[1] = PKW(P0, 2), pw0); \
    GAPA(C1 = __builtin_amdgcn_mfma_f32_32x32x16_bf16(kf[1], qa, negm, 0, 0, 0), P0[6], P0[7], P0[8], P0[9],     pw0[2] = PKW(P0, 4), pw0[3] = PKW(P0, 6), pw0); qb_ = *(const LAS bf16x8*)(qp + 1024); \
    GAPA(C0 = __builtin_amdgcn_mfma_f32_32x32x16_bf16(kf[2], qb_, C0, 0, 0, 0),   P0[10], P0[11], P0[12], P0[13], pw1[0] = PKW(P0, 8), pw1[1] = PKW(P0, 10), pw1); \
    GAPA(C1 = __builtin_amdgcn_mfma_f32_32x32x16_bf16(kf[3], qb_, C1, 0, 0, 0),   P0[14], P0[15], P1[0], P1[1],   pw1[2] = PKW(P0, 12), pw1[3] = PKW(P0, 14), pw1); qa = *(const LAS bf16x8*)(qp + 2048); \
    VRD(0); SBAR(); GAPA(C0 = __builtin_amdgcn_mfma_f32_32x32x16_bf16(kf[4], qa, C0, 0, 0, 0),   P1[2], P1[3], P1[4], P1[5],     pw2[0] = PKW(P1, 0), pw2[1] = PKW(P1, 2), pw2); \
    VRD(1); SBAR(); GAPA(C1 = __builtin_amdgcn_mfma_f32_32x32x16_bf16(kf[5], qa, C1, 0, 0, 0),   P1[6], P1[7], P1[8], P1[9],     pw2[2] = PKW(P1, 4), pw2[3] = PKW(P1, 6), pw2); qb_ = *(const LAS bf16x8*)(qp + 3072); \
    VRD(2); SBAR(); GAPA(C0 = __builtin_amdgcn_mfma_f32_32x32x16_bf16(kf[6], qb_, C0, 0, 0, 0),   P1[10], P1[11], P1[12], P1[13], pw3[0] = PKW(P1, 8), pw3[1] = PKW(P1, 10), pw3); \
    VRD(3); SBAR(); GAPA(C1 = __builtin_amdgcn_mfma_f32_32x32x16_bf16(kf[7], qb_, C1, 0, 0, 0),   P1[14], P1[15], 0.f, 0.f,       pw3[2] = PKW(P1, 12), pw3[3] = PKW(P1, 14), pw3); \
    l_reg += sacc; \
    { float a = MX3(C0[0], C0[1], C1[0]), b = MX3(C0[2], C0[3], C1[1]); a = MX3(a, C1[2], C1[3]); \
      _Pragma("unroll") for (int r = 4; r < 16; r += 4) { a = MX3(a, C0[r], C0[r + 1]); b = MX3(b, C0[r + 2], C0[r + 3]); a = MX3(a, C1[r], C1[r + 1]); b = MX3(b, C1[r + 2], C1[r + 3]); } \
      float rm = __builtin_fmaxf(a, b); { auto rr = __builtin_amdgcn_permlane32_swap(__float_as_uint(rm), __float_as_uint(rm), false, false); rm = __builtin_fmaxf(__uint_as_float(rr[0]), __uint_as_float(rr[1])); } \
      resc = false; \
      if (__builtin_expect(__any(rm > (float)THRL), 0)) { const float dl = __builtin_fmaxf(rm, 0.f); mhat += dl; \
        _Pragma("unroll") for (int r = 0; r < 16; ++r) { C0[r] -= dl; C1[r] -= dl; } \
        _Pragma("unroll") for (int r = 0; r < 16; ++r) negm[r] = -mhat; asm volatile("" : "+v"(negm)); \
        const float f = __builtin_amdgcn_exp2f(-dl); l_reg *= f; if (hi == 0) wsf[r32] = f; resc = true; } } \
    SBAR(); \
    PVS(0, PAF(0), C0, 0);  if (GK) { DMAK1((t) + 3, sl_cur); } PVS(1, PAF(0), C0, 2);  PVS(2, PAF(0), C0, 4);  if (GK) { DMAK2((t) + 3, sl_cur); } PVS(3, PAF(0), C0, 6); \
    KRD(GL, 0); PVS(4, PAF(1), C0, 8);  if (GV) { DMAV1((t) + 1, sl_next); } PVS(5, PAF(1), C0, 10); KRD(GL, 1); PVS(6, PAF(1), C0, 12); if (GV) { DMAV2((t) + 1, sl_next); } PVS(7, PAF(1), C0, 14); \
    KRD(GL, 2); PVS(8, PAF(2), C1, 0);  PVS(9, PAF(2), C1, 2);  KRD(GL, 3); PVS(10, PAF(2), C1, 4); PVS(11, PAF(2), C1, 6); \
    PVS(12, PAF(3), C1, 8); PVS(13, PAF(3), C1, 10); PVS(14, PAF(3), C1, 12); PVS(15, PAF(3), C1, 14); \
    } while (0)
  int t = 1;
  for (; t + 5 < NT; t += 2) {
    STEP(pB0, pB1, pA0, pA1, t, true, true, true);     WAIT_BAR(4); RESC(); ROT();
    STEP(pA0, pA1, pB0, pB1, t + 1, true, true, true); WAIT_BAR(4); RESC(); ROT();
  }
#define ENDW(tt) do { if ((tt) + 3 < NT) { WAIT_BAR(4); } else if ((tt) + 2 < NT) { WAIT_BAR(2); } else { WAIT_BAR(0); } } while (0)
  for (; t + 1 < NT; t += 2) {
    STEP(pB0, pB1, pA0, pA1, t, (t + 3 < NT), (t + 1 < NT), (t + 1 < NT));         ENDW(t);     RESC(); ROT();
    STEP(pA0, pA1, pB0, pB1, t + 1, (t + 4 < NT), (t + 2 < NT), (t + 2 < NT));     ENDW(t + 1); RESC(); ROT();
  }
  STEP(pB0, pB1, pA0, pA1, NT - 1, false, false, false); RESC();
  { float sacc = pB0[0] + pB0[1];
#pragma unroll
    for (int r = 2; r < 16; ++r) sacc += pB0[r];
#pragma unroll
    for (int r = 0; r < 16; ++r) sacc += pB1[r];
    l_reg += sacc;
    pw0 = (u32x4){PKW(pB0, 0), PKW(pB0, 2), PKW(pB0, 4), PKW(pB0, 6)}; pw1 = (u32x4){PKW(pB0, 8), PKW(pB0, 10), PKW(pB0, 12), PKW(pB0, 14)};
    pw2 = (u32x4){PKW(pB1, 0), PKW(pB1, 2), PKW(pB1, 4), PKW(pB1, 6)}; pw3 = (u32x4){PKW(pB1, 8), PKW(pB1, 10), PKW(pB1, 12), PKW(pB1, 14)};
    SBAR(); pv_last(o, vb0 + sl_cur, PAF(0), PAF(1), PAF(2), PAF(3)); }
  { auto rr = __builtin_amdgcn_permlane32_swap(__float_as_uint(l_reg), __float_as_uint(l_reg), false, false); l_reg = __uint_as_float(rr[0]) + __uint_as_float(rr[1]); }
  if (hi == 0) wsf[32 + r32] = l_reg; asm volatile("s_waitcnt lgkmcnt(0)" ::: "memory");
  float rli[16];
#pragma unroll
  for (int r = 0; r < 16; ++r) rli[r] = __builtin_amdgcn_rcpf(wsf[32 + crow(r, hi)]);
  asm volatile("s_waitcnt lgkmcnt(0)\n\ts_barrier" ::: "memory");
  LAS float* buf = (LAS float*)shm;
  if (comp == 1) {
#pragma unroll
    for (int r = 0; r < 16; ++r) { const int orow = wq * QBLK + crow(r, hi);
#pragma unroll
      for (int d0 = 0; d0 < 4; ++d0) buf[orow * 128 + d0 * 32 + r32] = o[d0][r] * rli[r] * lam; }
  }
  asm volatile("s_waitcnt lgkmcnt(0)\n\ts_barrier" ::: "memory");
  if (comp == 0) {
#pragma unroll
    for (int r = 0; r < 16; ++r) { const int orow = wq * QBLK + crow(r, hi);
#pragma unroll
      for (int d0 = 0; d0 < 4; ++d0) { const int ix = orow * 128 + d0 * 32 + r32; buf[ix] = o[d0][r] * rli[r] - buf[ix]; } }
  }
  asm volatile("s_waitcnt lgkmcnt(0)\n\ts_barrier" ::: "memory");
  { const int rsub = lane >> 4, c8 = (lane & 15) * 8;
    const f32x4 ga = *(const f32x4*)(g_subln + c8) * out_scale, gb = *(const f32x4*)(g_subln + c8 + 4) * out_scale;
#pragma unroll
    for (int i = 0; i < 4; ++i) { const int row = wid * 16 + i * 4 + rsub;
      const f32x4 va = *(const LAS f32x4*)(buf + row * 128 + c8), vb = *(const LAS f32x4*)(buf + row * 128 + c8 + 4);
      float ss = ((va.x * va.x + va.y * va.y) + (va.z * va.z + va.w * va.w)) + ((vb.x * vb.x + vb.y * vb.y) + (vb.z * vb.z + vb.w * vb.w));
      ss += dpp_f(ss, 0); ss += dpp_f(ss, 1); ss += dpp_f(ss, 2); ss += dpp_f(ss, 3);
      const float rstd = 1.0f / sqrtf(ss * (1.0f / 128.0f) + EPS);
      const f32x4 ya = va * rstd * ga, yb = vb * rstd * gb;
      u32x4 w; w.x = pk2(ya.x, ya.y); w.y = pk2(ya.z, ya.w); w.z = pk2(yb.x, yb.y); w.w = pk2(yb.z, yb.w);
      *(u32x4*)(CAT + (size_t)(qb * 128 + row) * DM + head * 128 + c8) = w; } }
  asm volatile("s_waitcnt vmcnt(0) lgkmcnt(0)\n\ts_barrier" ::: "memory");
  if (wid >= 4) __builtin_amdgcn_s_setprio(0);
#undef DMA_K
#undef DMA_V
#undef DMAK1
#undef DMAK2
#undef DMAV1
#undef DMAV2
#undef START
#undef RESC
#undef ROT
#undef PKW
#undef PAF
#undef VFR
#undef PIN
#undef MX3
#undef GAPA
#undef GAPB
#undef EX
#undef VRD
#undef KRD
#undef PVS
#undef STEP
#undef ENDW
}
#undef SBAR
#undef WAIT_BAR
}

namespace fft {
constexpr int XST = 72, ZST = 136, LDS_X = 0, LDS_Z = 2 * 128 * XST * 2, LDS_A1 = LDS_Z + 2 * 64 * ZST * 2, LDS_A2 = LDS_A1 + 128 * 136 * 2;
__device__ __forceinline__ int crow(int r, int hi) { return (r & 3) + 8 * (r >> 2) + 4 * hi; }
__device__ __forceinline__ void fft_phase(const bf16_t* __restrict__ WCT, bf16_t* __restrict__ FB, const bf16_t* __restrict__ A1T, const bf16_t* __restrict__ A2T, const float* __restrict__ TW, char* lds, int G) {
  const int tid = threadIdx.x, wid = tid >> 6, lane = tid & 63, r32 = lane & 31, hi = lane >> 5;
  bf16_t* Xs = (bf16_t*)(lds + LDS_X); bf16_t* Zs = (bf16_t*)(lds + LDS_Z);
  const int mb = wid & 3, nbp = wid >> 2;
  bf16x8 a2[8];
  bf16_t* A1s = (bf16_t*)(lds + LDS_A1);
#pragma unroll
  for (int q = 0; q < 4; ++q) { const int i = tid + 512 * q, row = i >> 4, c8 = (i & 15) * 8; *(u32x4*)(A1s + row * 136 + c8) = *(const u32x4*)(A1T + row * 128 + c8); }
#pragma unroll
  for (int ks = 0; ks < 8; ++ks) a2[ks] = *(const bf16x8*)(A2T + (32 * mb + r32) * 256 + 16 * (ks + 8) + 8 * hi);
  bf16_t* A2s = (bf16_t*)(lds + LDS_A2);
#pragma unroll
  for (int q = 0; q < 4; ++q) { const int i = tid + 512 * q, row = i >> 4, c8 = (i & 15) * 8; *(u32x4*)(A2s + row * 136 + c8) = *(const u32x4*)(A2T + row * 256 + c8); }
  f32x2 tw[2][8];
#pragma unroll
  for (int nbi = 0; nbi < 2; ++nbi)
#pragma unroll
    for (int q = 0; q < 8; ++q) { const int k1 = 16 * mb + 4 * (q >> 1) + 2 * hi + (q & 1), t2 = 32 * (2 * nbp + nbi) + r32; tw[nbi][q] = *(const f32x2*)(TW + 2 * (k1 * 128 + t2)); }
  const int k1o = 32 * nbp + r32;
#define FFT_LOADX(cp) do { const bf16_t* src = WCT + (size_t)(2 * (cp)) * 8192; \
        _Pragma("unroll") for (int pass = 0; pass < 4; ++pass) { const int p = tid + 512 * pass, ri = p >> 10, e = (p & 1023) * 8; pv[pass] = *(const u32x4*)(src + (size_t)ri * 8192 + e); } } while (0)
#define FFT_COLUMN(ncp, hasn, neg, OUT) do { \
      { _Pragma("unroll") for (int pass = 0; pass < 4; ++pass) { const int p = tid + 512 * pass, ri = p >> 10, e = (p & 1023) * 8, t2 = e >> 6, t1 = e & 63; \
          *(u32x4*)(Xs + (ri * 128 + t2) * XST + t1) = pv[pass]; } } \
      const unsigned sgn = (neg) ? 0x80008000u : 0u; \
      __syncthreads(); \
      if (hasn) FFT_LOADX(ncp); \
      f32x16 acc[2]; acc[0] = f32x16{}; acc[1] = f32x16{}; \
      _Pragma("unroll") for (int ks = 0; ks < 8; ++ks) \
        _Pragma("unroll") for (int nbi = 0; nbi < 2; ++nbi) { const int t2 = 32 * (2 * nbp + nbi) + r32; \
          u32x4 bw = *(const u32x4*)(Xs + ((ks >> 2) * 128 + t2) * XST + (ks & 3) * 16 + 8 * hi); if (ks >= 4) { bw.x ^= sgn; bw.y ^= sgn; bw.z ^= sgn; bw.w ^= sgn; } const bf16x8 bfr = __builtin_bit_cast(bf16x8, bw); \
          acc[nbi] = __builtin_amdgcn_mfma_f32_32x32x16_bf16(*(const bf16x8*)(A1s + (32 * mb + r32) * 136 + 16 * ks + 8 * hi), bfr, acc[nbi], 0, 0, 0); } \
      _Pragma("unroll") for (int nbi = 0; nbi < 2; ++nbi) { const int t2 = 32 * (2 * nbp + nbi) + r32; \
        _Pragma("unroll") for (int q = 0; q < 8; ++q) { const float yr = acc[nbi][2 * q], yi = acc[nbi][2 * q + 1]; const f32x2 cs = tw[nbi][q]; \
          const int k1 = 16 * mb + 4 * (q >> 1) + 2 * hi + (q & 1); \
          const unsigned zz = cvt2_bf16(yr * cs.x + yi * cs.y, yi * cs.x - yr * cs.y); Zs[k1 * ZST + t2] = (bf16_t)zz; Zs[(64 + k1) * ZST + t2] = (bf16_t)(zz >> 16); } } \
      __syncthreads(); \
      OUT = f32x16{}; \
      _Pragma("unroll") for (int ks = 0; ks < 16; ++ks) { const bf16x8 bfr = *(const bf16x8*)(Zs + ((ks >> 3) * 64 + k1o) * ZST + (ks & 7) * 16 + 8 * hi); \
        OUT = __builtin_amdgcn_mfma_f32_32x32x16_bf16(ks < 8 ? *(const bf16x8*)(A2s + (32 * mb + r32) * 136 + 16 * ks + 8 * hi) : a2[ks & 7], bfr, OUT, 0, 0, 0); } } while (0)
#define FB_AT(col, k) (FB + ((size_t)((col) >> 3) * 8192 + (k)) * 8 + ((col) & 7))
  constexpr float SC = 1.0f / 2048.0f;
  for (int unit = blockIdx.x; unit < 256; unit += G) {
    const int g = unit >> 6, cb = unit & 63;
    bf16_t* fb = FB + (size_t)(g * 64 + cb) * 8192 * 8;
    auto cpof = [&](int c) { return (c <= 255) ? g * 256 + c : (c == 256 ? 1024 + g : g * 256 + (512 - c)); };
    u32x4 pv[4];
    FFT_LOADX(cpof(8 * cb));
#pragma unroll 1
    for (int half = 0; half < 2; ++half) { u32x2 o[16];
#pragma unroll
      for (int jp = 0; jp < 2; ++jp) { f32x16 ea, eb;
        { const int c = 8 * cb + 4 * half + 2 * jp; const bool ng = c > 256; FFT_COLUMN(cpof(c + 1), true, ng, ea); }
        { const int c = 8 * cb + 4 * half + 2 * jp + 1; const bool ng = c > 256; const bool hn = (c & 7) != 7; FFT_COLUMN(cpof(c + 1), hn, ng, eb); }
#pragma unroll
        for (int r = 0; r < 16; ++r) o[r][jp] = pk2(ea[r] * SC, eb[r] * SC); }
#pragma unroll
      for (int r = 0; r < 16; ++r) { const int k = k1o + 64 * (32 * mb + crow(r, hi)); *(u32x2*)(fb + (size_t)k * 8 + 4 * half) = o[r]; } }
  }
#undef FFT_LOADX
#undef FFT_COLUMN
#undef FB_AT
  __syncthreads();
}
constexpr int R_X0 = 0, R_X1 = 36864, R_Z0 = 73728, R_Z1 = 73728 + 34816;
__device__ __forceinline__ void fft_phase_split(const bf16_t* __restrict__ WCT, bf16_t* __restrict__ FB, const bf16_t* __restrict__ A1T, const bf16_t* __restrict__ A2T, const float* __restrict__ TW, char* lds, int G) {
  const int tid = threadIdx.x, wid = __builtin_amdgcn_readfirstlane(tid >> 6), lane = tid & 63, r32 = lane & 31, hi = lane >> 5, mb = wid & 3;
  constexpr float SC = 1.0f / 2048.0f;
  if (wid < 4) {
    bf16x8 a1[8]; f32x2 tw[4][8];
#pragma unroll
    for (int ks = 0; ks < 8; ++ks) a1[ks] = *(const bf16x8*)(A1T + (32 * mb + r32) * 128 + 16 * ks + 8 * hi);
#pragma unroll
    for (int nb = 0; nb < 4; ++nb)
#pragma unroll
      for (int q = 0; q < 8; ++q) { const int k1 = 16 * mb + 4 * (q >> 1) + 2 * hi + (q & 1), t2 = 32 * nb + r32; tw[nb][q] = *(const f32x2*)(TW + 2 * (k1 * 128 + t2)); }
    for (int unit = blockIdx.x; unit < 256; unit += G) {
      const int g = unit >> 6, cb = unit & 63;
      auto cpof = [&](int c) { return (c <= 255) ? g * 256 + c : (c == 256 ? 1024 + g : g * 256 + (512 - c)); };
      u32x4 pv[8];
#define FS_LOADX(cp) do { const bf16_t* src = WCT + (size_t)(2 * (cp)) * 8192; \
        _Pragma("unroll") for (int pass = 0; pass < 8; ++pass) { const int p = tid + 256 * pass, ri = p >> 10, e = (p & 1023) * 8; pv[pass] = *(const u32x4*)(src + (size_t)ri * 8192 + e); } } while (0)
#define FS_PUTX(xb) do { bf16_t* Xw = (bf16_t*)(lds + (xb)); \
        _Pragma("unroll") for (int pass = 0; pass < 8; ++pass) { const int p = tid + 256 * pass, ri = p >> 10, e = (p & 1023) * 8, t2 = e >> 6, t1 = e & 63; *(u32x4*)(Xw + (ri * 128 + t2) * XST + t1) = pv[pass]; } } while (0)
      FS_LOADX(cpof(8 * cb)); FS_PUTX(R_X0); FS_LOADX(cpof(8 * cb + 1));
      __syncthreads();
#pragma unroll 1
      for (int s = 0; s < 9; ++s) {
        if (s < 8) {
          if (s + 1 < 8) FS_PUTX(((s + 1) & 1) ? R_X1 : R_X0);
          if (s + 2 < 8) FS_LOADX(cpof(8 * cb + s + 2));
          const bf16_t* Xs = (const bf16_t*)(lds + ((s & 1) ? R_X1 : R_X0)); bf16_t* Zs = (bf16_t*)(lds + ((s & 1) ? R_Z1 : R_Z0));
          const unsigned sgn = (8 * cb + s > 256) ? 0x80008000u : 0u;
#pragma unroll
          for (int nh = 0; nh < 2; ++nh) {
            f32x16 acc[2]; acc[0] = f32x16{}; acc[1] = f32x16{};
#pragma unroll
            for (int ks = 0; ks < 8; ++ks)
#pragma unroll
              for (int ni = 0; ni < 2; ++ni) { const int t2 = 32 * (2 * nh + ni) + r32;
                u32x4 bw = *(const u32x4*)(Xs + ((ks >> 2) * 128 + t2) * XST + (ks & 3) * 16 + 8 * hi); if (ks >= 4) { bw.x ^= sgn; bw.y ^= sgn; bw.z ^= sgn; bw.w ^= sgn; }
                acc[ni] = __builtin_amdgcn_mfma_f32_32x32x16_bf16(a1[ks], __builtin_bit_cast(bf16x8, bw), acc[ni], 0, 0, 0); }
#pragma unroll
            for (int ni = 0; ni < 2; ++ni) { const int nb = 2 * nh + ni, t2 = 32 * nb + r32;
#pragma unroll
              for (int q = 0; q < 8; ++q) { const float yr = acc[ni][2 * q], yi = acc[ni][2 * q + 1]; const f32x2 cs = tw[nb][q];
                const int k1 = 16 * mb + 4 * (q >> 1) + 2 * hi + (q & 1);
                const unsigned zz = cvt2_bf16(yr * cs.x + yi * cs.y, yi * cs.x - yr * cs.y); Zs[k1 * ZST + t2] = (bf16_t)zz; Zs[(64 + k1) * ZST + t2] = (bf16_t)(zz >> 16); } } }
        }
        __syncthreads();
      }
#undef FS_LOADX
#undef FS_PUTX
    }
  } else {
    bf16x8 a2[16];
#pragma unroll
    for (int ks = 0; ks < 16; ++ks) a2[ks] = *(const bf16x8*)(A2T + (32 * mb + r32) * 256 + 16 * ks + 8 * hi);
    for (int unit = blockIdx.x; unit < 256; unit += G) {
      const int g = unit >> 6, cb = unit & 63;
      bf16_t* fb = FB + (size_t)(g * 64 + cb) * 8192 * 8;
      __syncthreads();
      __syncthreads();
      u32x4 o[2][16];
#pragma unroll
      for (int c = 0; c < 8; ++c) {
          const bf16_t* Zs = (const bf16_t*)(lds + ((c & 1) ? R_Z1 : R_Z0));
#pragma unroll
          for (int nbp = 0; nbp < 2; ++nbp) { const int k1o = 32 * nbp + r32; f32x16 out = f32x16{};
#pragma unroll
            for (int ks = 0; ks < 16; ++ks) { const bf16x8 bfr = *(const bf16x8*)(Zs + ((ks >> 3) * 64 + k1o) * ZST + (ks & 7) * 16 + 8 * hi);
              out = __builtin_amdgcn_mfma_f32_32x32x16_bf16(a2[ks], bfr, out, 0, 0, 0); }
#pragma unroll
            for (int r = 0; r < 16; ++r) { const unsigned w = cvt2_bf16(out[r] * SC, out[r] * SC);
              if ((c & 1) == 0) o[nbp][r][c >> 1] = w & 0xffffu; else o[nbp][r][c >> 1] |= w & 0xffff0000u; } }
          if (c == 7) {
#pragma unroll
            for (int nbp = 0; nbp < 2; ++nbp)
#pragma unroll
              for (int r = 0; r < 16; ++r) { const int k = 32 * nbp + r32 + 64 * (32 * mb + crow(r, hi)); *(u32x4*)(fb + (size_t)k * 8) = o[nbp][r]; } }
          __syncthreads();
      }
    }
  }
  __syncthreads();
}
}

struct Args {
    const float *x, *c, *ctx, *c_ctx, *w_mod, *b_mod, *g_mix, *g_ffn, *w_in, *w_out, *lq1, *lk1, *lq2, *lk2, *g_subln, *ln_g, *ln_b, *w_sp, *b_sp, *w_fo, *w_r, *w_gate, *w_up, *w_down, *g_final;
    float* out; unsigned char* ws; int lo, hi;
};


struct Ctx {
    const LAS unsigned long long* PT;
    __device__ __forceinline__ const void* ld(int i) const { const unsigned long long v = PT[i]; const unsigned l = __builtin_amdgcn_readfirstlane((unsigned)v), h = __builtin_amdgcn_readfirstlane((unsigned)(v >> 32));
        return (const void*)(const GAS void*)(((unsigned long long)h << 32) | l); }
    __device__ __forceinline__ const float* x() const { return (const float*)ld(0); }
    __device__ __forceinline__ const float* c() const { return (const float*)ld(1); }
    __device__ __forceinline__ const float* ctx() const { return (const float*)ld(2); }
    __device__ __forceinline__ const float* c_ctx() const { return (const float*)ld(3); }
    __device__ __forceinline__ const float* w_mod() const { return (const float*)ld(4); }
    __device__ __forceinline__ const float* b_mod() const { return (const float*)ld(5); }
    __device__ __forceinline__ const float* g_mix() const { return (const float*)ld(6); }
    __device__ __forceinline__ const float* g_ffn() const { return (const float*)ld(7); }
    __device__ __forceinline__ const float* w_in() const { return (const float*)ld(8); }
    __device__ __forceinline__ const float* w_out() const { return (const float*)ld(9); }
    __device__ __forceinline__ const float* lq1() const { return (const float*)ld(10); }
    __device__ __forceinline__ const float* lk1() const { return (const float*)ld(11); }
    __device__ __forceinline__ const float* lq2() const { return (const float*)ld(12); }
    __device__ __forceinline__ const float* lk2() const { return (const float*)ld(13); }
    __device__ __forceinline__ const float* g_subln() const { return (const float*)ld(14); }
    __device__ __forceinline__ const float* ln_g() const { return (const float*)ld(15); }
    __device__ __forceinline__ const float* ln_b() const { return (const float*)ld(16); }
    __device__ __forceinline__ const float* w_sp() const { return (const float*)ld(17); }
    __device__ __forceinline__ const float* b_sp() const { return (const float*)ld(18); }
    __device__ __forceinline__ const float* w_fo() const { return (const float*)ld(19); }
    __device__ __forceinline__ const float* w_r() const { return (const float*)ld(20); }
    __device__ __forceinline__ const float* w_gate() const { return (const float*)ld(21); }
    __device__ __forceinline__ const float* w_up() const { return (const float*)ld(22); }
    __device__ __forceinline__ const float* w_down() const { return (const float*)ld(23); }
    __device__ __forceinline__ const float* g_final() const { return (const float*)ld(24); }
    __device__ __forceinline__ float* out() const { return (float*)ld(25); }
    __device__ __forceinline__ unsigned char* ws() const { return (unsigned char*)ld(26); }
};

__device__ __forceinline__ void transpose_item(const float* W, int K, int N, bf16_t* WT, int row_off, int ilv, LAS float* scr, int item, int lane) {
    const int nblk = N / 32, kb = item / nblk, nb = item % nblk, k0 = 64 * kb, n0 = 32 * nb;
#pragma unroll 8
    for (int i = 0; i < 32; ++i) { const int kk = 2 * i + (lane >> 5); scr[kk * 33 + (lane & 31)] = __builtin_nontemporal_load(W + (size_t)(k0 + kk) * N + n0 + (lane & 31)); }
    asm volatile("s_waitcnt lgkmcnt(0)" ::: "memory");
    const int c = lane & 7;
#pragma unroll
    for (int j = 0; j < 4; ++j) { const int n = (lane >> 3) + 8 * j; const LAS float* s = scr + (8 * c) * 33 + n;
        u32x4 o; o.x = pk2(s[0 * 33], s[1 * 33]); o.y = pk2(s[2 * 33], s[3 * 33]); o.z = pk2(s[4 * 33], s[5 * 33]); o.w = pk2(s[6 * 33], s[7 * 33]);
        const int ng = n0 + n, drow = row_off + (ilv ? ((ng >> 7) * 256 + (ng & 127)) : ng);
        *(u32x4*)(WT + (size_t)drow * K + k0 + 8 * c) = o; }
    asm volatile("s_waitcnt lgkmcnt(0)" ::: "memory");
}
struct CvtItem { const float* src; bf16_t* dst; int N, K, row_off, ilv, k0, n0; };
__device__ __forceinline__ void cvt_load(const CvtItem& d, f32x4 (&v)[8], int lane) {
    const float* p = d.src + (size_t)(d.k0 + (lane >> 3)) * d.N + d.n0 + (lane & 7) * 4;
#pragma unroll
    for (int q = 0; q < 8; ++q) v[q] = __builtin_nontemporal_load((const f32x4*)(p + (size_t)(8 * q) * d.N));
}
template <bool NT = true> __device__ __forceinline__ void cvt_store(const CvtItem& d, const f32x4 (&v)[8], LAS float* scr, int lane) {
    const int rr = lane >> 3, c4 = (lane & 7) * 4;
#pragma unroll
    for (int q = 0; q < 8; ++q) { LAS float* t = scr + (8 * q + rr) * 33 + c4; t[0] = v[q].x; t[1] = v[q].y; t[2] = v[q].z; t[3] = v[q].w; }
    asm volatile("s_waitcnt lgkmcnt(0)" ::: "memory");
    const int c = lane & 7;
#pragma unroll
    for (int j = 0; j < 4; ++j) { const int n = (lane >> 3) + 8 * j; const LAS float* s = scr + (8 * c) * 33 + n;
        u32x4 o; o.x = pk2(s[0 * 33], s[1 * 33]); o.y = pk2(s[2 * 33], s[3 * 33]); o.z = pk2(s[4 * 33], s[5 * 33]); o.w = pk2(s[6 * 33], s[7 * 33]);
        const int ng = d.n0 + n, drow = d.row_off + (d.ilv ? ((ng >> 7) * 256 + (ng & 127)) : ng);
        if (NT) __builtin_nontemporal_store(o, (u32x4*)(d.dst + (size_t)drow * d.K + d.k0 + 8 * c)); else *(u32x4*)(d.dst + (size_t)drow * d.K + d.k0 + 8 * c) = o; }
    asm volatile("s_waitcnt lgkmcnt(0)" ::: "memory");
}
constexpr int MOE_ITEMS = NE * (2 * (DM / 64) * (FE / 32) + (FE / 64) * (DM / 32));
__device__ __forceinline__ void convert_moe_items(const Ctx& a, int layer, LAS unsigned char* lds, int it0, int it1, int widx, int nw, int wave, int lane) {
    LAS float* scr = (LAS float*)(lds + wave * 16384);
    bf16_t* WGU = (bf16_t*)(a.ws() + WS_WGU + (size_t)layer * WGU_BYTES); bf16_t* WD = (bf16_t*)(a.ws() + WS_WD + (size_t)layer * WD_BYTES);
    constexpr int I_G = (DM / 64) * (FE / 32), I_D = (FE / 64) * (DM / 32);
    constexpr int PER_E = 2 * I_G + I_D;
    const float *wg = a.w_gate(), *wu = a.w_up(), *wd = a.w_down();
    auto decode = [&](int it) { CvtItem d; const int e = it / PER_E; int r = it % PER_E; const size_t eo = ((size_t)layer * NE + e) * (size_t)DM * FE;
        if (r < I_G)          { d.src = wg + eo; d.dst = WGU; d.N = FE; d.K = DM; d.row_off = e * 2048; d.ilv = 1; }
        else if (r < 2 * I_G) { r -= I_G; d.src = wu + eo; d.dst = WGU; d.N = FE; d.K = DM; d.row_off = e * 2048 + 128; d.ilv = 1; }
        else                  { r -= 2 * I_G; d.src = wd + eo; d.dst = WD; d.N = DM; d.K = FE; d.row_off = e * 2048; d.ilv = 0; }
        const int nblk = d.N / 32; d.k0 = 64 * (r / nblk); d.n0 = 32 * (r % nblk); return d; };
    int it = it0 + widx;
    if (it >= it1) return;
    f32x4 va[8], vb[8]; CvtItem da = decode(it), db = da; bool hb = (it + nw < it1);
    cvt_load(da, va, lane);
    if (hb) { db = decode(it + nw); cvt_load(db, vb, lane); }
    for (;;) {
        cvt_store(da, va, scr, lane);
        it += 2 * nw; const bool ha = (it < it1);
        if (ha) { da = decode(it); cvt_load(da, va, lane); }
        if (!hb) break;
        cvt_store(db, vb, scr, lane);
        hb = (it + nw < it1);
        if (hb) { db = decode(it + nw); cvt_load(db, vb, lane); }
        if (!ha) break;
    }
}
constexpr int L0_A = 12288, L0_B = 20480, L1_A = 43008;
__device__ __forceinline__ void p0_prologue(const Ctx& a, LAS unsigned char* lds, int G) {
    const int tid = threadIdx.x, lane = tid & 63, wave = __builtin_amdgcn_readfirstlane(tid >> 6);
    float* MODL = (float*)(a.ws() + WS_MODL); float* MODC = (float*)(a.ws() + WS_MODC);
    {
        LAS float* s_l = (LAS float*)lds; LAS float* s_c = s_l + 2048; LAS float* red = s_c + 2048;
        for (int k = tid; k < 2048; k += NTHR) { const float v = a.c()[k], w = a.c_ctx()[k]; s_l[k] = v / (1.0f + __expf(-v)); s_c[k] = w / (1.0f + __expf(-w)); }
        __syncthreads();
        const int cg = tid % 24, kg = tid / 24;
        for (int u = blockIdx.x; u < 256; u += G) {
            const int layer = u >> 7, n0 = (u & 127) * 96;
            f32x4 al = (f32x4){0.f, 0.f, 0.f, 0.f}, ac = al;
            if (kg < 21) {
                const float* W = a.w_mod() + (size_t)layer * DM * 12288 + n0 + 4 * cg;
#pragma unroll 8
                for (int k = kg; k < 2048; k += 21) { const f32x4 w = __builtin_nontemporal_load((const f32x4*)(W + (size_t)k * 12288)); al += s_l[k] * w; ac += s_c[k] * w; }
#pragma unroll
                for (int j = 0; j < 4; ++j) { red[(kg * 96 + 4 * cg + j) * 2] = al[j]; red[(kg * 96 + 4 * cg + j) * 2 + 1] = ac[j]; }
            }
            __syncthreads();
            if (tid < 96) { float sl = 0.f, sc = 0.f;
                for (int q = 0; q < 21; ++q) { sl += red[(q * 96 + tid) * 2]; sc += red[(q * 96 + tid) * 2 + 1]; }
                const float b = a.b_mod()[layer * 12288 + n0 + tid];
                MODL[layer * 12288 + n0 + tid] = sl + b;
                if (layer == 0 && n0 + tid < 4096) MODC[n0 + tid] = sc + b; }
            __syncthreads();
        }
    }
    {
        LAS float* tab = (LAS float*)lds;
        for (int j = tid; j < 8192; j += NTHR) tab[j] = cospif((float)j * (1.0f / 4096.0f));
        __syncthreads();
        const int gt = blockIdx.x * NTHR + tid, NT_ = G * NTHR;
        float* RC = (float*)(a.ws() + WS_ROPE); float* RS = RC + 128 * 16;
        for (int i = gt; i < 128 * 16; i += NT_) { const int pos = i >> 4, j = i & 15; const float inv = powf(10000.0f, -(float)j * (1.0f / 16.0f)); const float ang = (float)pos * inv; RC[i] = cosf(ang); RS[i] = sinf(ang); }
        bf16_t* CS = (bf16_t*)(a.ws() + WS_CS);
        for (int i = gt; i < 512 * 512; i += NT_) { const int r = i >> 9, d = i & 511, m = r >> 1, ri = r & 1; const int j = (((m * d) & 511) * 16 + (ri ? 2048 : 0)) & 8191; CS[i] = (bf16_t)f2bf(tab[j]); }
        bf16_t* A1 = (bf16_t*)(a.ws() + WS_A1);
        for (int i = gt; i < 128 * 128; i += NT_) { const int m1 = i >> 7, k = i & 127, k1 = m1 >> 1, rp = m1 & 1, ri = k >> 6, t1 = k & 63; int j = ((t1 * k1) & 63) * 128;
            if (rp == 0 && ri == 1) j -= 2048; if (rp == 1 && ri == 0) j += 2048; A1[i] = (bf16_t)f2bf(tab[j & 8191]); }
        bf16_t* A2 = (bf16_t*)(a.ws() + WS_A2);
        for (int i = gt; i < 128 * 256; i += NT_) { const int k2 = i >> 8, k = i & 255, ri = k >> 7, t2 = k & 127; int j = ((t2 * k2) & 127) * 64; if (ri) j -= 2048; A2[i] = (bf16_t)f2bf(tab[j & 8191]); }
        float* TW = (float*)(a.ws() + WS_TW);
        for (int i = gt; i < 64 * 128; i += NT_) { const int k1 = i >> 7, t2 = i & 127, j = t2 * k1; TW[2 * i] = tab[j]; TW[2 * i + 1] = tab[(j - 2048) & 8191]; }
        __syncthreads();
    }
    {
        const int gw = blockIdx.x * NWAVES + wave, NGW = G * NWAVES;
        LAS float* scr = (LAS float*)(lds + wave * 16384);
        constexpr int I_IN = (DM / 64) * (INC / 32), I_SQ = (DM / 64) * (DM / 32), TOT = I_IN + 2 * I_SQ;
        auto mk = [&](int it) { CvtItem d; int r = it;
            if (r < I_IN) { d.src = a.w_in(); d.dst = (bf16_t*)(a.ws() + WS_WIN); d.N = INC; }
            else if (r < I_IN + I_SQ) { r -= I_IN; d.src = a.w_out(); d.dst = (bf16_t*)(a.ws() + WS_WOUT); d.N = DM; }
            else { r -= I_IN + I_SQ; d.src = a.w_fo(); d.dst = (bf16_t*)(a.ws() + WS_WFO); d.N = DM; }
            d.K = DM; d.row_off = 0; d.ilv = 0; const int nblk = d.N / 32; d.k0 = 64 * (r / nblk); d.n0 = 32 * (r % nblk); return d; };
        { int it = gw;
          if (it < TOT) {
            f32x4 va[8], vb[8]; CvtItem da = mk(it), db = da; bool hb = (it + NGW < TOT);
            cvt_load(da, va, lane);
            if (hb) { db = mk(it + NGW); cvt_load(db, vb, lane); }
            for (;;) {
                cvt_store<false>(da, va, scr, lane);
                it += 2 * NGW; const bool ha = (it < TOT);
                if (ha) { da = mk(it); cvt_load(da, va, lane); }
                if (!hb) break;
                cvt_store<false>(db, vb, scr, lane);
                hb = (it + NGW < TOT);
                if (hb) { db = mk(it + NGW); cvt_load(db, vb, lane); }
                if (!ha) break;
            } } }
        convert_moe_items(a, 0, lds, 0, L0_A, gw, NGW, wave, lane);
    }
}

__device__ __forceinline__ void norm_mod_row(const float* xrow, const float* gain, const float* shift, const float* scale, bf16_t* orow, int lane) {
    f32x4 v[8]; float ss = 0.f;
#pragma unroll
    for (int j = 0; j < 8; ++j) { v[j] = *(const f32x4*)(xrow + j * 256 + lane * 4); ss += (v[j].x * v[j].x + v[j].y * v[j].y) + (v[j].z * v[j].z + v[j].w * v[j].w); }
    const float rstd = 1.0f / sqrtf(wave_sum(ss) * (1.0f / DM) + EPS);
#pragma unroll
    for (int j = 0; j < 8; ++j) { const int c = j * 256 + lane * 4; const f32x4 g = *(const f32x4*)(gain + c), sh = *(const f32x4*)(shift + c), sc = *(const f32x4*)(scale + c);
        const f32x4 y = v[j] * rstd * g * (1.0f + sc) + sh;
        u32x2 w; w.x = pk2(y.x, y.y); w.y = pk2(y.z, y.w); *(u32x2*)(orow + c) = w; }
}

__device__ __forceinline__ void router_phase(const Ctx& a, int layer, LAS unsigned char* lds, int G) {
    const int tid = threadIdx.x, lane = tid & 63, wave = __builtin_amdgcn_readfirstlane(tid >> 6);
    constexpr int ROWB = 4112;
    LAS unsigned char* XT = lds; LAS float* RS = (LAS float*)(lds + 32 * ROWB); LAS float* PART = (LAS float*)lds;
    const _Float16* X = (const _Float16*)(a.ws() + WS_X); bf16_t* H2 = (bf16_t*)(a.ws() + WS_H2); float* AFF = (float*)(a.ws() + WS_AFF);
    const float* mod = (const float*)(a.ws() + WS_MODL) + layer * 12288; const float* gain = a.g_ffn() + layer * DM;
    const int m = lane & 15, kq = lane >> 4;
    int unit = blockIdx.x;
    f16x4 nx[4][8];
    if (unit < SEQ / 32) {
#pragma unroll
        for (int i = 0; i < 4; ++i) {
#pragma unroll
            for (int j = 0; j < 8; ++j) nx[i][j] = *(const f16x4*)(X + (size_t)(unit * 32 + wave * 4 + i) * DM + ((j >> 1) * 512 + lane * 8 + (j & 1) * 4)); } }
    f32x4 ca[8], cb[8];
#pragma unroll
    for (int j = 0; j < 8; ++j) { const int c = ((j >> 1) * 512 + lane * 8 + (j & 1) * 4); ca[j] = *(const f32x4*)(gain + c) * (1.0f + *(const f32x4*)(mod + 4 * DM + c)); cb[j] = *(const f32x4*)(mod + 3 * DM + c); }
    const float bias = ((const float*)(a.ws() + WS_WRB))[layer * 16 + m];
    for (; unit < SEQ / 32; unit += G) {
        const int r0 = unit * 32 + wave * 4;
#pragma unroll
        for (int i = 0; i < 4; ++i) {
            const int row = r0 + i; f32x4 v[8]; float ss = 0.f;
            LAS unsigned char* xt = XT + (wave * 4 + i) * ROWB;
#pragma unroll
            for (int j = 0; j < 8; ++j) { *(LAS f16x4*)(xt + 2 * ((j >> 1) * 512 + lane * 8 + (j & 1) * 4)) = nx[i][j]; v[j] = __builtin_convertvector(nx[i][j], f32x4);
                ss += (v[j].x * v[j].x + v[j].y * v[j].y) + (v[j].z * v[j].z + v[j].w * v[j].w); }
            { const int nrow = (unit + G) * 32 + wave * 4 + i;
              if (nrow < SEQ) {
#pragma unroll
                for (int j = 0; j < 8; ++j) nx[i][j] = *(const f16x4*)(X + (size_t)nrow * DM + ((j >> 1) * 512 + lane * 8 + (j & 1) * 4)); } }
            asm volatile("" ::: "memory");
            const float rstd = 1.0f / sqrtf(wave_sum(ss) * (1.0f / DM) + EPS);
            if (lane == 0) RS[wave * 4 + i] = rstd;
#pragma unroll
            for (int q = 0; q < 4; ++q) {
                const f32x4 h0 = v[2 * q] * rstd * ca[2 * q] + cb[2 * q], h1 = v[2 * q + 1] * rstd * ca[2 * q + 1] + cb[2 * q + 1];
                u32x4 w; w.x = pk2(h0.x, h0.y); w.y = pk2(h0.z, h0.w); w.z = pk2(h1.x, h1.y); w.w = pk2(h1.z, h1.w); *(u32x4*)(H2 + (size_t)row * DM + q * 512 + lane * 8) = w; }
        }
        f16x8 bh[8], bl[8];
        { const f16x8* WRP = (const f16x8*)(a.ws() + WS_WRP) + (size_t)layer * 2 * 4096 + wave * 512 + lane;
#pragma unroll
          for (int s = 0; s < 8; ++s) { bh[s] = WRP[s * 64]; bl[s] = WRP[4096 + s * 64]; } }
        __syncthreads();
        f32x4 acc0 = {0.f, 0.f, 0.f, 0.f}, acc1 = {0.f, 0.f, 0.f, 0.f};
        { const LAS unsigned char* ap = XT + m * ROWB + (wave * 256 + kq * 8) * 2;
#pragma unroll
          for (int s = 0; s < 8; ++s) { const f16x8 a0 = *(const LAS f16x8*)(ap + s * 64), a1 = *(const LAS f16x8*)(ap + 16 * ROWB + s * 64);
            acc0 = __builtin_amdgcn_mfma_f32_16x16x32_f16(a0, bh[s], acc0, 0, 0, 0); acc0 = __builtin_amdgcn_mfma_f32_16x16x32_f16(a0, bl[s], acc0, 0, 0, 0);
            acc1 = __builtin_amdgcn_mfma_f32_16x16x32_f16(a1, bh[s], acc1, 0, 0, 0); acc1 = __builtin_amdgcn_mfma_f32_16x16x32_f16(a1, bl[s], acc1, 0, 0, 0); } }
        __syncthreads();
        *(LAS f32x4*)(PART + ((wave * 2 + 0) * 64 + lane) * 4) = acc0; *(LAS f32x4*)(PART + ((wave * 2 + 1) * 64 + lane) * 4) = acc1;
        __syncthreads();
        { const int mt = wave >> 2, r = wave & 3; float sum = 0.f;
#pragma unroll
          for (int w = 0; w < 8; ++w) sum += PART[((w * 2 + mt) * 64 + lane) * 4 + r];
          const int lr = 16 * mt + 4 * kq + r;
          const float lg = sum * (RS[lr] * (1.0f / 64.0f)) + bias;
          float mx = lg; mx = fmaxf(mx, dpp_f(mx, 0)); mx = fmaxf(mx, dpp_f(mx, 1)); mx = fmaxf(mx, dpp_f(mx, 2)); mx = fmaxf(mx, dpp_f(mx, 3));
          const float pe = expf(lg - mx); float sm = pe; sm += dpp_f(sm, 0); sm += dpp_f(sm, 1); sm += dpp_f(sm, 2); sm += dpp_f(sm, 3);
          AFF[(size_t)m * SEQ + unit * 32 + lr] = pe * (1.0f / sm); }
        __syncthreads();
    }
}

__device__ __forceinline__ void topk_expert(const Ctx& a, int e, LAS unsigned char* lds) {
    const int tid = threadIdx.x, lane = tid & 63;
    LAS unsigned* hist = (LAS unsigned*)lds; LAS unsigned* bc = hist + 256; LAS unsigned* cg = bc + 16; LAS unsigned* ce = cg + 512;
    const float* aff = (const float*)(a.ws() + WS_AFF) + (size_t)e * SEQ;
    int* IDX = (int*)(a.ws() + WS_IDX) + e * CAP; float* GATE = (float*)(a.ws() + WS_GATE) + e * CAP; int* POS = (int*)(a.ws() + WS_POS) + (size_t)e * SEQ;
    unsigned key[16];
#pragma unroll
    for (int j = 0; j < 4; ++j) { const u32x4 v = *(const u32x4*)(aff + tid * 16 + j * 4); key[4 * j] = v.x; key[4 * j + 1] = v.y; key[4 * j + 2] = v.z; key[4 * j + 3] = v.w; }
    unsigned prefix = 0u, mask = 0u, remaining = CAP;
    for (int pass = 0; pass < 4; ++pass) {
        const int shift = 24 - 8 * pass;
        if (tid < 256) hist[tid] = 0u;
        __syncthreads();
#pragma unroll
        for (int j = 0; j < 16; ++j) if ((key[j] & mask) == prefix) __hip_atomic_fetch_add(&hist[(key[j] >> shift) & 255u], 1u, __ATOMIC_RELAXED, __HIP_MEMORY_SCOPE_WORKGROUP);
        __syncthreads();
        if (tid < 64) {
            const unsigned h0 = hist[255 - 4 * lane], h1 = hist[254 - 4 * lane], h2 = hist[253 - 4 * lane], h3 = hist[252 - 4 * lane];
            const unsigned s = h0 + h1 + h2 + h3; unsigned inc = s;
#pragma unroll
            for (int o = 1; o < 64; o <<= 1) { const unsigned v = __shfl_up(inc, o); if (lane >= o) inc += v; }
            const unsigned exc = inc - s;
            if (exc < remaining && remaining <= inc) {
                unsigned c = exc; unsigned b;
                if (c + h0 >= remaining) b = 255 - 4 * lane;
                else { c += h0; if (c + h1 >= remaining) b = 254 - 4 * lane; else { c += h1; if (c + h2 >= remaining) b = 253 - 4 * lane; else { c += h2; b = 252 - 4 * lane; } } }
                bc[0] = b; bc[1] = remaining - c;
            }
        }
        __syncthreads();
        prefix |= bc[0] << shift; mask |= 255u << shift; remaining = bc[1];
        __syncthreads();
    }
    const unsigned T = prefix, need = remaining;
    unsigned ngt = 0u, neq = 0u;
#pragma unroll
    for (int j = 0; j < 16; ++j) { ngt += key[j] > T ? 1u : 0u; neq += key[j] == T ? 1u : 0u; }
    cg[tid] = ngt; ce[tid] = neq;
    __syncthreads();
    if (tid < 64) {
        unsigned av[8], bv[8], sa = 0u, sb = 0u;
#pragma unroll
        for (int q = 0; q < 8; ++q) { av[q] = cg[lane * 8 + q]; bv[q] = ce[lane * 8 + q]; sa += av[q]; sb += bv[q]; }
        unsigned ia = sa, ib = sb;
#pragma unroll
        for (int o = 1; o < 64; o <<= 1) { const unsigned va = __shfl_up(ia, o), vb = __shfl_up(ib, o); if (lane >= o) { ia += va; ib += vb; } }
        unsigned ea = ia - sa, eb = ib - sb;
#pragma unroll
        for (int q = 0; q < 8; ++q) { cg[lane * 8 + q] = ea; ea += av[q]; ce[lane * 8 + q] = eb; eb += bv[q]; }
        if (lane == 63) bc[2] = ia;
    }
    __syncthreads();
    unsigned og = cg[tid], oe = ce[tid]; const unsigned tg = bc[2];
#pragma unroll
    for (int j = 0; j < 16; ++j) { const int token = tid * 16 + j; int slot = -1;
        if (key[j] > T) slot = (int)(og++);
        else if (key[j] == T) { if (oe < need) slot = (int)(tg + oe); ++oe; }
        POS[token] = slot;
        if (slot >= 0) { IDX[slot] = token; GATE[slot] = __uint_as_float(key[j]); } }
    __syncthreads();
}

__device__ __forceinline__ void combine_phase(const Ctx& a, int layer, int G) {
    const int tid = threadIdx.x, lane = tid & 63, wave = __builtin_amdgcn_readfirstlane(tid >> 6);
    _Float16* X = (_Float16*)(a.ws() + WS_X); const bf16_t* Y = (const bf16_t*)(a.ws() + WS_Y); const int* POS = (const int*)(a.ws() + WS_POS);
    const float* modl = (const float*)(a.ws() + WS_MODL);
    const float* gf = modl + layer * 12288 + 5 * DM;
    const int gw = blockIdx.x * NWAVES + wave, NGW = G * NWAVES;
    int pl[4]; f16x4 nx[4][8];
#pragma unroll
    for (int i = 0; i < 4; ++i) { const int row = gw + i * NGW; pl[i] = -1;
        if (row < SEQ) { pl[i] = (lane < NE) ? POS[(size_t)lane * SEQ + row] : -1;
#pragma unroll
            for (int j = 0; j < 8; ++j) nx[i][j] = *(const f16x4*)(X + (size_t)row * DM + ((j >> 1) * 512 + lane * 8 + (j & 1) * 4)); } }
    for (int base = gw; base < SEQ; base += 4 * NGW) {
#pragma unroll
      for (int i = 0; i < 4; ++i) { const int row = base + i * NGW;
       if (row < SEQ) {
        _Float16* xr = X + (size_t)row * DM; f32x4 v[8], sum[8];
        const int plc = pl[i]; unsigned long long sel = __ballot(plc >= 0);
#pragma unroll
        for (int j = 0; j < 8; ++j) { v[j] = __builtin_convertvector(nx[i][j], f32x4); sum[j] = (f32x4){0.f, 0.f, 0.f, 0.f}; }
        { const int nrow = row + 4 * NGW;
          if (nrow < SEQ) { pl[i] = (lane < NE) ? POS[(size_t)lane * SEQ + nrow] : -1;
#pragma unroll
            for (int j = 0; j < 8; ++j) nx[i][j] = *(const f16x4*)(X + (size_t)nrow * DM + ((j >> 1) * 512 + lane * 8 + (j & 1) * 4)); } }
        while (sel) { const int e0 = __builtin_ctzll(sel); sel &= sel - 1;
            const bf16_t* y0 = Y + (size_t)(e0 * CAP + __builtin_amdgcn_readlane(plc, e0)) * DM;
            u32x2 w0[8];
#pragma unroll
            for (int j = 0; j < 8; ++j) w0[j] = *(const u32x2*)(y0 + ((j >> 1) * 512 + lane * 8 + (j & 1) * 4));
#pragma unroll
            for (int j = 0; j < 8; ++j) sum[j] += (f32x4){bflo(w0[j].x), bfhi(w0[j].x), bflo(w0[j].y), bfhi(w0[j].y)}; }
        float ss = 0.f;
#pragma unroll
        for (int j = 0; j < 8; ++j) { const int c = ((j >> 1) * 512 + lane * 8 + (j & 1) * 4); v[j] = v[j] + *(const f32x4*)(gf + c) * sum[j];
            ss += (v[j].x * v[j].x + v[j].y * v[j].y) + (v[j].z * v[j].z + v[j].w * v[j].w); }
        const float rstd = 1.0f / sqrtf(wave_sum(ss) * (1.0f / DM) + EPS);
        if (layer == 0) {
            bf16_t* orow = (bf16_t*)(a.ws() + WS_HCAT) + (size_t)row * DM; const float* m1 = modl + 12288; const float* gain = a.g_mix() + DM;
            float nyq[4] = {0.f, 0.f, 0.f, 0.f};
#pragma unroll
            for (int q = 0; q < 4; ++q) { const int c = q * 512 + lane * 8;
                { const f16x4 r0 = __builtin_convertvector(v[2 * q], f16x4), r1 = __builtin_convertvector(v[2 * q + 1], f16x4); *(f16x8*)(xr + c) = __builtin_shufflevector(r0, r1, 0, 1, 2, 3, 4, 5, 6, 7); }
                const f32x4 y0 = v[2 * q] * rstd * *(const f32x4*)(gain + c) * (1.0f + *(const f32x4*)(m1 + DM + c)) + *(const f32x4*)(m1 + c);
                const f32x4 y1 = v[2 * q + 1] * rstd * *(const f32x4*)(gain + c + 4) * (1.0f + *(const f32x4*)(m1 + DM + c + 4)) + *(const f32x4*)(m1 + c + 4);
                u32x4 w; w.x = pk2(y0.x, y0.y); w.y = pk2(y0.z, y0.w); w.z = pk2(y1.x, y1.y); w.w = pk2(y1.z, y1.w); *(u32x4*)(orow + c) = w;
                nyq[q] += ((bflo(w.x) - bfhi(w.x)) + (bflo(w.y) - bfhi(w.y))) + ((bflo(w.z) - bfhi(w.z)) + (bflo(w.w) - bfhi(w.w))); }
            { bf16_t* WCT = (bf16_t*)(a.ws() + WS_WCT); const int n = (row & 127) * 64 + (row >> 7);
                float mine = 0.f;
#pragma unroll
                for (int g = 0; g < 4; ++g) { const float sg = wave_sum(nyq[g]); mine = (lane == g) ? sg : mine; }
                if (lane < 4) { WCT[(size_t)(2048 + 2 * lane) * 8192 + n] = (bf16_t)f2bf(mine); WCT[(size_t)(2049 + 2 * lane) * 8192 + n] = 0; } }
        } else {
            float* orow = a.out() + (size_t)row * DM;
#pragma unroll
            for (int j = 0; j < 8; ++j) { const int c = ((j >> 1) * 512 + lane * 8 + (j & 1) * 4); *(f32x4*)(orow + c) = v[j] * rstd * *(const f32x4*)(a.g_final() + c); }
        }
       } }
    }
}

#define PHASE_FN static __device__ __forceinline__ void
#define PH_PRO extern __shared__ __attribute__((aligned(16))) unsigned char lds_raw[]; LAS unsigned char* lds = (LAS unsigned char*)lds_raw; (void)lds; \
    const int tid = threadIdx.x, lane = tid & 63, wave = __builtin_amdgcn_readfirstlane(tid >> 6), G = gridDim.x; (void)lane; (void)wave; \
    Ctx a; a.PT = (const LAS unsigned long long*)(lds + LDSCTL_OFF + 64); const int gw = blockIdx.x * NWAVES + wave, NGW = G * NWAVES; (void)gw; (void)NGW;

__device__ __forceinline__ void router_prep(const Ctx& a, int nb, int tid, int lane, int wave) {
    const float* MODL = (const float*)(a.ws() + WS_MODL);
    for (int it = blockIdx.x * NTHR + tid; it < 2 * 4096; it += nb * NTHR) { const int layer = it >> 12, kc = (it >> 4) & 255, n = it & 15;
        const float* w_r = a.w_r() + (size_t)layer * DM * NE; const float* gain = a.g_ffn() + layer * DM; const float* sc = MODL + layer * 12288 + 4 * DM;
        f16x8 hi, lo;
#pragma unroll
        for (int i = 0; i < 8; ++i) { const int c = kc * 8 + i; const float wv = 64.0f * gain[c] * (1.0f + sc[c]) * w_r[c * NE + n];
            const _Float16 h = (_Float16)wv; hi[i] = h; lo[i] = (_Float16)(wv - (float)h); }
        f16x8* WRP = (f16x8*)(a.ws() + WS_WRP) + (size_t)layer * 2 * 4096;
        WRP[kc * 16 + n] = hi; WRP[4096 + kc * 16 + n] = lo; }
    const int gwb = blockIdx.x * NWAVES + wave, ngw = nb * NWAVES;
    if (gwb >= ngw - 32 && gwb < ngw) { const int q = gwb - (ngw - 32), layer = q >> 4, e = q & 15;
        const float* w_r = a.w_r() + (size_t)layer * DM * NE; const float* sh = MODL + layer * 12288 + 3 * DM; float acc = 0.f;
#pragma unroll 8
        for (int i = 0; i < 32; ++i) { const int c = lane + 64 * i; acc = fmaf(sh[c], w_r[c * NE + e], acc); }
        acc = wave_sum(acc);
        if (lane == 0) ((float*)(a.ws() + WS_WRB))[q] = acc; }
}
PHASE_FN ph_prologue() { PH_PRO; p0_prologue(a, lds, G); }
PHASE_FN ph_hcat() { PH_PRO;
    const float* MODL = (const float*)(a.ws() + WS_MODL); const float* MODC = (const float*)(a.ws() + WS_MODC); bf16_t* HCAT = (bf16_t*)(a.ws() + WS_HCAT);
    const float* ctx = a.ctx(); const float* x = a.x(); const float* gm = a.g_mix();
    f32x4 nx[4][8];
#pragma unroll
    for (int i = 0; i < 4; ++i) { const int row = gw + i * NGW;
        if (row < SEQ) {
#pragma unroll
            for (int j = 0; j < 8; ++j) nx[i][j] = __builtin_nontemporal_load((const f32x4*)(x + (size_t)row * DM + ((j >> 1) * 512 + lane * 8 + (j & 1) * 4))); } }
    for (int r = blockIdx.x; r < CTXL; r += G) { LAS float* red = (LAS float*)lds; const int c = wave * 256 + lane * 4;
        const f32x4 cv = *(const f32x4*)(ctx + (size_t)r * DM + c), g4 = *(const f32x4*)(gm + c), s4 = *(const f32x4*)(MODC + DM + c), h4 = *(const f32x4*)(MODC + c);
        const float ps = wave_sum((cv.x * cv.x + cv.y * cv.y) + (cv.z * cv.z + cv.w * cv.w));
        if (lane == 0) red[wave] = ps;
        __syncthreads();
        float tot = 0.f;
#pragma unroll
        for (int w = 0; w < NWAVES; ++w) tot += red[w];
        const float rstd = 1.0f / sqrtf(tot * (1.0f / DM) + EPS);
        const f32x4 y = cv * rstd * g4 * (1.0f + s4) + h4;
        u32x2 w; w.x = pk2(y.x, y.y); w.y = pk2(y.z, y.w); *(u32x2*)(HCAT + (size_t)r * DM + c) = w;
        __syncthreads(); }
    for (int base = gw; base < SEQ; base += 4 * NGW) {
#pragma unroll
        for (int i = 0; i < 4; ++i) { const int row = base + i * NGW;
            if (row < SEQ) {
                float ss = 0.f;
#pragma unroll
                for (int j = 0; j < 8; ++j) { const f32x4 t = nx[i][j]; ss += (t.x * t.x + t.y * t.y) + (t.z * t.z + t.w * t.w); }
                const float rstd = 1.0f / sqrtf(wave_sum(ss) * (1.0f / DM) + EPS);
                bf16_t* orow = HCAT + (size_t)(CTXL + row) * DM;
#pragma unroll
                for (int q = 0; q < 4; ++q) { const int c = q * 512 + lane * 8;
                    const f32x4 y0 = nx[i][2 * q] * rstd * (*(const f32x4*)(gm + c) * (1.0f + *(const f32x4*)(MODL + DM + c))) + *(const f32x4*)(MODL + c);
                    const f32x4 y1 = nx[i][2 * q + 1] * rstd * (*(const f32x4*)(gm + c + 4) * (1.0f + *(const f32x4*)(MODL + DM + c + 4))) + *(const f32x4*)(MODL + c + 4);
                    u32x4 w; w.x = pk2(y0.x, y0.y); w.y = pk2(y0.z, y0.w); w.z = pk2(y1.x, y1.y); w.w = pk2(y1.z, y1.w); *(u32x4*)(orow + c) = w; }
                const int nrow = row + 4 * NGW;
                if (nrow < SEQ) {
#pragma unroll
                    for (int j = 0; j < 8; ++j) nx[i][j] = __builtin_nontemporal_load((const f32x4*)(x + (size_t)nrow * DM + ((j >> 1) * 512 + lane * 8 + (j & 1) * 4))); }
            } }
    }
}
PHASE_FN ph_win() { PH_PRO;
    unsigned char* ws = a.ws();
    const pg8::Geo g = pg8::geo_rowmajor(ws + WS_HCAT, DM, ws + WS_WIN, DM, DM);
    pg8::WinOrder S; S.init_win(G, (int)blockIdx.x);
    pg8::EpiWin E{(bf16_t*)(ws + WS_Q), (bf16_t*)(ws + WS_K), (bf16_t*)(ws + WS_V), (bf16_t*)(ws + WS_UV), (const float*)(ws + WS_ROPE), (const float*)(ws + WS_ROPE) + 128 * 16};
    pg8::gemm_phase<pg8::EpiWin, pg8::WinOrder, true, true>(lds, g, S, E);
    { const int nu = S.total(), maxu = (nu + G - 1) / G, nfull = nu - (maxu - 1) * G;
      if ((int)blockIdx.x >= nfull && nfull < G) convert_moe_items(a, 0, lds, L0_B, MOE_ITEMS, ((int)blockIdx.x - nfull) * NWAVES + wave, (G - nfull) * NWAVES, wave, lane);
      else if (nfull >= G) { convert_moe_items(a, 0, lds, L0_B, MOE_ITEMS, gw, NGW, wave, lane); router_prep(a, G, tid, lane, wave); }
      else router_prep(a, nfull, tid, lane, wave); }
}
PHASE_FN ph_attn() { PH_PRO;
    unsigned char* ws = a.ws();
    float lam;
    { const float q1 = a.lq1()[lane] * a.lk1()[lane], q2 = a.lq2()[lane] * a.lk2()[lane]; lam = expf(wave_sum(q1)) - expf(wave_sum(q2)) + 0.2f; }
    const float* gs = a.g_subln();
    for (int i = blockIdx.x; i < 512; i += G)
        att2::attn_unit<8>((const bf16_t*)(ws + WS_Q), (const bf16_t*)(ws + WS_K), (const bf16_t*)(ws + WS_V), (bf16_t*)(ws + WS_CAT), i & 7, i >> 3, lam, 0.8f, gs, lds);
}
PHASE_FN ph_sgu() { PH_PRO;
    unsigned char* ws = a.ws();
    const float *w_sp = a.w_sp(), *b_sp = a.b_sp(), *ln_g = a.ln_g(), *ln_b = a.ln_b();
    const bf16_t* UV = (const bf16_t*)(ws + WS_UV);
    for (int i = blockIdx.x; i < 512; i += 2 * G) { const int i2 = i + G; const bool two = i2 < 512;
        unsigned pa[16], pb[16]; u32x4 ua[4], ub[4]; f32x4 wsv[16];
        att::sgu_request(UV, i >> 3, i & 7, pa, ua); att::sgu_weights(w_sp, i & 7, wsv);
        if (two) att::sgu_request(UV, i2 >> 3, i2 & 7, pb, ub);
        att::sgu_unit(pa, ua, wsv, (bf16_t*)(ws + WS_CAT), b_sp, ln_g, ln_b, i >> 3, i & 7, (char*)lds_raw);
        if (two) { if ((i2 & 7) != (i & 7)) att::sgu_weights(w_sp, i2 & 7, wsv);
            att::sgu_unit(pb, ub, wsv, (bf16_t*)(ws + WS_CAT), b_sp, ln_g, ln_b, i2 >> 3, i2 & 7, (char*)lds_raw); } }
}
PHASE_FN ph_wout(unsigned* dep, const XcdBarrier& bar) { PH_PRO;
    unsigned char* ws = a.ws();
    const int GH = (G >= 2) ? G / 2 : G;
    if ((int)blockIdx.x < GH) {
        if (dep) dep_wait(dep, bar);
        const pg8::Geo g = pg8::geo_rowmajor(ws + WS_CAT, DM, ws + WS_WOUT, DM, DM);
        pg8::StaticOrder S; S.init(SEQ, DM, GH, (int)blockIdx.x);
        pg8::EpiResid<true> E{a.x(), (_Float16*)(ws + WS_X), (const float*)(ws + WS_MODL) + 2 * DM};
        pg8::gemm_phase<pg8::EpiResid<true>, pg8::StaticOrder, true, true>(lds, g, S, E);
        if (GH == G) convert_moe_items(a, 1, lds, 0, L1_A, gw, NGW, wave, lane);
    } else convert_moe_items(a, 1, lds, 0, L1_A, ((int)blockIdx.x - GH) * NWAVES + wave, (G - GH) * NWAVES, wave, lane);
}
PHASE_FN ph_stepa() { PH_PRO;
    unsigned char* ws = a.ws();
    pg8::Geo g = pg8::geo_rowmajor(ws + WS_CS, 512, ws + WS_HCAT, DM, 512);
    g.aB = 1024;
    g.bmode = 1; g.hB = (size_t)2 * g.ldb2; g.tB = (size_t)4 * g.ldb2;
    pg8::StepAOrder S{G, (int)blockIdx.x};
    pg8::EpiBf16 E{(bf16_t*)(ws + WS_WCT), SEQ, 512};
    pg8::gemm_phase<pg8::EpiBf16, pg8::StepAOrder, true, true>(lds, g, S, E);
}
PHASE_FN ph_dft() { PH_PRO;
    unsigned char* ws = a.ws();
    fft::fft_phase_split((const bf16_t*)(ws + WS_WCT), (bf16_t*)(ws + WS_F), (const bf16_t*)(ws + WS_A1), (const bf16_t*)(ws + WS_A2), (const float*)(ws + WS_TW), (char*)lds_raw, G);
}
PHASE_FN ph_wfo() { PH_PRO;
    unsigned char* ws = a.ws();
    pg8::Geo g = pg8::geo_rowmajor(ws + WS_F, DM, ws + WS_WFO, DM, DM);
    g.amode = 1; g.kA = 8 * 131072; g.hA = 2048; g.tA = 4096;
    pg8::StaticOrder S; S.init(SEQ, DM, G, (int)blockIdx.x);
    pg8::EpiResid<false> E{(const void*)(ws + WS_X), (_Float16*)(ws + WS_X), (const float*)(ws + WS_MODL) + 12288 + 2 * DM};
    pg8::gemm_phase<pg8::EpiResid<false>, pg8::StaticOrder, true, true>(lds, g, S, E);
}
PHASE_FN ph_router(int layer) { PH_PRO; router_phase(a, layer, lds, G); }
PHASE_FN ph_topk(int layer, unsigned* dep, const XcdBarrier& bar) { PH_PRO;
    if ((int)blockIdx.x < NE) { if (dep) dep_wait(dep, bar); }
    for (int e = blockIdx.x; e < NE; e += G) topk_expert(a, e, lds);
    if ((int)blockIdx.x >= NE || G <= NE) { const int widx = (G <= NE) ? gw : ((int)blockIdx.x - NE) * NWAVES + wave, nw = (G <= NE) ? NGW : (G - NE) * NWAVES;
        if (layer == 0) convert_moe_items(a, 0, lds, L0_A, L0_B, widx, nw, wave, lane); else convert_moe_items(a, 1, lds, L1_A, MOE_ITEMS, widx, nw, wave, lane); } }
PHASE_FN ph_gather() { PH_PRO;
    unsigned char* ws = a.ws();
    const int* IDX = (const int*)(ws + WS_IDX); const bf16_t* H2 = (const bf16_t*)(ws + WS_H2); bf16_t* XS = (bf16_t*)(ws + WS_XS);
    for (int r = gw; r < MR; r += NGW) { const int t = IDX[r]; const u32x4* s = (const u32x4*)(H2 + (size_t)t * DM) + lane; u32x4* d = (u32x4*)(XS + (size_t)r * DM) + lane;
#pragma unroll
        for (int j = 0; j < 4; ++j) d[64 * j] = s[64 * j]; }
}
PHASE_FN ph_gateup(int layer) { PH_PRO;
    unsigned char* ws = a.ws();
    pg8::Geo g = pg8::geo_rowmajor(ws + WS_H2, DM, ws + WS_WGU + (size_t)layer * WGU_BYTES, DM, DM);
    g.aB = (size_t)2048 * DM * 2; g.hA = 0; g.tA = 0;
    pg8::MoeOrder S; S.init(MR, 2048, G, (int)blockIdx.x);
    pg8::EpiGateUp E{(bf16_t*)(ws + WS_ACT)};
    pg8::gemm_phase<pg8::EpiGateUp, pg8::MoeOrder, true, true, true>(lds, g, S, E, (const int*)(ws + WS_IDX));
}
PHASE_FN ph_down(int layer) { PH_PRO;
    unsigned char* ws = a.ws();
    pg8::Geo g = pg8::geo_rowmajor(ws + WS_ACT, FE, ws + WS_WD + (size_t)layer * WD_BYTES, FE, FE);
    g.aB = (size_t)2048 * FE * 2;
    pg8::MoeOrder S; S.init(MR, DM, G, (int)blockIdx.x);
    pg8::EpiDown E{(bf16_t*)(ws + WS_Y), (const float*)(ws + WS_GATE)};
    pg8::gemm_phase<pg8::EpiDown, pg8::MoeOrder, true, true>(lds, g, S, E);
}
PHASE_FN ph_combine(int layer) { PH_PRO; combine_phase(a, layer, G); }

__global__ void __launch_bounds__(NTHR, 2) fwd(Args ka) {
    extern __shared__ __attribute__((aligned(16))) unsigned char lds_raw[];
    LAS unsigned char* lds = (LAS unsigned char*)lds_raw;
    const int tid = threadIdx.x;
    const int lo = ka.lo, hi = ka.hi;
    for (int u = tid; u < 16; u += NTHR) ((LAS unsigned*)(lds + LDSCTL_OFF))[u] = 0u;
    LAS unsigned long long* PTW = (LAS unsigned long long*)(lds + LDSCTL_OFF + 64);
    if (tid == 0) {
        PTW[0] = (unsigned long long)ka.x;
        PTW[1] = (unsigned long long)ka.c;
        PTW[2] = (unsigned long long)ka.ctx;
        PTW[3] = (unsigned long long)ka.c_ctx;
        PTW[4] = (unsigned long long)ka.w_mod;
        PTW[5] = (unsigned long long)ka.b_mod;
        PTW[6] = (unsigned long long)ka.g_mix;
        PTW[7] = (unsigned long long)ka.g_ffn;
        PTW[8] = (unsigned long long)ka.w_in;
        PTW[9] = (unsigned long long)ka.w_out;
        PTW[10] = (unsigned long long)ka.lq1;
        PTW[11] = (unsigned long long)ka.lk1;
        PTW[12] = (unsigned long long)ka.lq2;
        PTW[13] = (unsigned long long)ka.lk2;
        PTW[14] = (unsigned long long)ka.g_subln;
        PTW[15] = (unsigned long long)ka.ln_g;
        PTW[16] = (unsigned long long)ka.ln_b;
        PTW[17] = (unsigned long long)ka.w_sp;
        PTW[18] = (unsigned long long)ka.b_sp;
        PTW[19] = (unsigned long long)ka.w_fo;
        PTW[20] = (unsigned long long)ka.w_r;
        PTW[21] = (unsigned long long)ka.w_gate;
        PTW[22] = (unsigned long long)ka.w_up;
        PTW[23] = (unsigned long long)ka.w_down;
        PTW[24] = (unsigned long long)ka.g_final;
        PTW[25] = (unsigned long long)ka.out; PTW[26] = (unsigned long long)ka.ws;
    }
    __syncthreads();
    XcdBarrier bar; bar.bar = (unsigned*)(ka.ws + WS_CTL); bar.x = 0; bar.st = nullptr;
    if (hi - lo > 1) bar = xcd_barrier_post((unsigned*)(ka.ws + WS_CTL), (volatile LAS unsigned*)(lds + LDSCTL_OFF));
#ifndef PHMASK
#define PHMASK 0xFFFFFFu
#endif
#define IN(k) (((PHMASK >> ((k) == 21 ? 3 : (k) == 22 ? 10 : (k))) & 1u) && lo <= ((k) == 21 ? 3 : (k) == 22 ? 10 : (k)) && ((k) == 21 ? 3 : (k) == 22 ? 10 : (k)) < hi)
#define SEAM(k) do { if (IN(k) && IN((k) + 1)) xcd_barrier(bar); } while (0)
#ifndef TPROBE
#define TPROBE -1
#endif
#ifndef TSIDE
#define TSIDE 0
#endif
#ifndef TAMP
#define TAMP 9
#endif
#define RUNPH(k, call) do { if (IN(k)) { if (TPROBE == (k)) { const unsigned long long t0_ = __builtin_amdgcn_s_memrealtime(); call; __syncthreads(); \
        const unsigned long long t1_ = __builtin_amdgcn_s_memrealtime(); const bool on_ = TSIDE == 0 || (TSIDE == 1 ? (int)blockIdx.x < (int)gridDim.x / 2 : (int)blockIdx.x >= (int)gridDim.x / 2); \
        if (on_) { const unsigned long long end_ = t1_ + (unsigned long long)TAMP * (t1_ - t0_); while (__builtin_amdgcn_s_memrealtime() < end_) __builtin_amdgcn_s_sleep(8); } } else { call; } } } while (0)
    RUNPH(0, ph_prologue());             SEAM(0);
    RUNPH(1, ph_hcat());                 SEAM(1);
    RUNPH(2, ph_win());                  SEAM(2);
    RUNPH(3, ph_attn());                 RUNPH(21, ph_sgu()); const bool dp2 = IN(3) && IN(4) && (hi - lo > 1) && gridDim.x >= 2; if (dp2) dep_arrive(bar.bar + DEP_WORDS(2), bar); else SEAM(3);
    RUNPH(4, ph_wout(dp2 ? bar.bar + DEP_WORDS(2) : nullptr, bar));                 SEAM(4);
    RUNPH(5, ph_router(0));              const bool dp0 = IN(5) && IN(6) && (hi - lo > 1); if (dp0) dep_arrive(bar.bar + DEP_WORDS(0), bar); else SEAM(5);
    RUNPH(6, ph_topk(0, dp0 ? bar.bar + DEP_WORDS(0) : nullptr, bar));                if (IN(6) && IN(8)) xcd_barrier(bar);
    RUNPH(8, ph_gateup(0));              SEAM(8);
    RUNPH(9, ph_down(0));                SEAM(9);
    RUNPH(10, ph_combine(0));            SEAM(10);
    RUNPH(11, ph_stepa());               SEAM(11);
    RUNPH(12, ph_dft());                 SEAM(12);
    RUNPH(13, ph_wfo());                 SEAM(13);
    RUNPH(14, ph_router(1));             const bool dp1 = IN(14) && IN(15) && (hi - lo > 1); if (dp1) dep_arrive(bar.bar + DEP_WORDS(1), bar); else SEAM(14);
    RUNPH(15, ph_topk(1, dp1 ? bar.bar + DEP_WORDS(1) : nullptr, bar));               if (IN(15) && IN(17)) xcd_barrier(bar);
    RUNPH(17, ph_gateup(1));             SEAM(17);
    RUNPH(18, ph_down(1));               SEAM(18);
    RUNPH(19, ph_combine(1));
#undef RUNPH
#undef IN
#undef SEAM
}

extern "C" void kernel_launch(void* const* d_in, const int* in_sizes, int n_in, void* d_out, int out_size, void* d_ws, size_t ws_size, hipStream_t stream) {
    static int grid = 0;
    if (grid == 0) {
        if (n_in != 25 || in_sizes[0] != SEQ * DM || out_size != SEQ * DM || ws_size < WS_END) {
            fprintf(stderr, "kernel_launch: unexpected shapes: n_in %d in0 %d out %d ws %zu (need %zu)\n", n_in, n_in > 0 ? in_sizes[0] : -1, out_size, ws_size, (size_t)WS_END); grid = -1; return; }
        int dev = 0, cus = 0, per_cu = 0;
        if (hipGetDevice(&dev) != hipSuccess || hipDeviceGetAttribute(&cus, hipDeviceAttributeMultiprocessorCount, dev) != hipSuccess) { grid = -1; return; }
        if (hipFuncSetAttribute((const void*)fwd, hipFuncAttributeMaxDynamicSharedMemorySize, LDS_BYTES) != hipSuccess) { fprintf(stderr, "kernel_launch: hipFuncSetAttribute failed\n"); grid = -1; return; }
        if (hipOccupancyMaxActiveBlocksPerMultiprocessor(&per_cu, (const void*)fwd, NTHR, LDS_BYTES) != hipSuccess || per_cu < 1) fprintf(stderr, "kernel_launch: occupancy query says %d\n", per_cu);
        (void)hipGetLastError();
        grid = cus;
    }
    if (grid < 0) return;
    (void)hipMemsetAsync((char*)d_ws + WS_CTL, 0, CTL_BYTES, stream);
    Args a{};
    const float** p = (const float**)&a;
    for (int i = 0; i < 25; ++i) p[i] = (const float*)d_in[i];
    a.out = (float*)d_out; a.ws = (unsigned char*)d_ws;
#ifndef ONE_LAUNCH
    for (int ph = 0; ph < NPH; ++ph) { a.lo = ph; a.hi = ph + 1; hipLaunchKernelGGL(fwd, dim3(grid), dim3(NTHR), LDS_BYTES, stream, a); }
#else
    a.lo = 0; a.hi = NPH; hipLaunchKernelGGL(fwd, dim3(grid), dim3(NTHR), LDS_BYTES, stream, a);
#endif
    const hipError_t le = hipPeekAtLastError();
    if (le != hipSuccess) fprintf(stderr, "kernel_launch: launch failed: %s\n", hipGetErrorName(le));
}
```
